# Optimizing an MI355X kernel written in HIP

```python
import jax, jax.numpy as jnp
from jax import lax
import numpy as np

D_MODEL = 1024
BATCH = 16
SEQ = 2048
DEPTH = 2

GRID_W = 64
CTX_LEN = 256
D_A = D_MODEL
HEAD_A = 64
H_A = D_A // HEAD_A
R_W = 64
R_A = 64
R_G = 128
SHIFT_W = 3
GN_EPS = 64e-5
D_B = D_MODEL
CHUNK = 128
G_B = 8
C_B = D_B // G_B
N_EXP = 16
CAP_FACTOR = 2
D_FF = 2 * D_MODEL
N_RWKV = 3 * D_A + 2 * R_W + 2 * R_A + R_G
N_IN = N_RWKV + 2 * D_B + 2 * D_MODEL
ALPHA = (2 * DEPTH) ** 0.25
BETA = (8 * DEPTH) ** -0.25
LN_EPS = 1e-5

kernel_name = "hybrid_rwkv7_gmlp_ecmoe_diffusion_block"


def layer_norm(x, g=None, b=None, eps=LN_EPS):
    xf = x.astype(jnp.float32)
    mu = xf.mean(-1, keepdims=True)
    var = jnp.square(xf - mu).mean(-1, keepdims=True)
    y = (xf - mu) * lax.rsqrt(var + eps)
    if g is not None:
        y = y * g + b
    return y.astype(x.dtype)


def modulate(x, shift, scale):
    return layer_norm(x) * (1 + scale) + shift


def centred_shift(z, w):
    zp = jnp.pad(z, ((0, 0), (1, 1), (0, 0)))
    return zp[:, :-2] * w[0] + zp[:, 1:-1] * w[1] + zp[:, 2:] * w[2]


def rwkv_prep(zr, p):
    B, T, _ = zr.shape
    cuts = np.cumsum((D_A, D_A, D_A, R_W, R_W, R_A, R_A)).tolist()
    r, k, v, dwf, dwb, daf, dab, dg = jnp.split(zr, cuts, axis=-1)
    heads = lambda t: t.astype(jnp.float32).reshape(B, T, H_A, HEAD_A)

    def decay(dw, w0, w2):
        w = -jax.nn.softplus(-(w0 + jnp.tanh(dw) @ w2)) - 0.5
        return jnp.exp(-jnp.exp(heads(w)))

    d_f = decay(dwf, p["w0"][0], p["w2"][0])
    d_b = decay(dwb, p["w0"][1], p["w2"][1])
    a_f = jax.nn.sigmoid(p["a0"][0] + daf @ p["a2"][0])
    a_b = jax.nn.sigmoid(p["a0"][1] + dab @ p["a2"][1])
    kk = heads(k * p["k_k"])
    kk = kk * lax.rsqrt(jnp.maximum(jnp.sum(kk * kk, -1, keepdims=True), 1e-12))
    k_f = heads(k * (1 + (a_f - 1) * p["k_a"]))
    k_b = heads(k * (1 + (a_b - 1) * p["k_a"]))
    return heads(r), k_f, k_b, heads(v), d_f, d_b, kk, heads(a_f), heads(a_b), dg


def rwkv_scan(r, k, v, d, kk, a, s0, reverse):
    xs = tuple(jnp.moveaxis(t, 1, 0) for t in (r, k, v, d, kk, a))

    def step(S, inp):
        r_t, k_t, v_t, d_t, kk_t, a_t = inp
        s_kk = jnp.einsum('bhvk,bhk->bhv', S, kk_t)
        S_new = (S * d_t[:, :, None, :]
                 - s_kk[..., None] * (kk_t * a_t)[:, :, None, :]
                 + v_t[..., None] * k_t[:, :, None, :])
        y = jnp.einsum('bhvk,bhk->bhv', S if reverse else S_new, r_t)
        return S_new, y

    s_fin, ys = lax.scan(step, s0, xs, reverse=reverse)
    return jnp.moveaxis(ys, 0, 1), s_fin


def rwkv_readout(y, r, k, v, g, p):
    B, T = y.shape[:2]
    mu = y.mean(-1, keepdims=True)
    var = jnp.square(y - mu).mean(-1, keepdims=True)
    y = ((y - mu) * lax.rsqrt(var + GN_EPS)).reshape(B, T, D_A) * p["lnx_g"] + p["lnx_b"]
    bonus = (jnp.sum(r * k * p["r_k"], -1, keepdims=True) * v).reshape(B, T, D_A)
    return ((y + bonus) * g).astype(g.dtype)


def spatial_gating(z_sgu, p, n_chunks):
    B, T, _ = z_sgu.shape
    u, v = jnp.split(jax.nn.gelu(z_sgu, approximate=False), 2, axis=-1)
    v = layer_norm(v, p["sgu_ln_g"], p["sgu_ln_b"]).reshape(B, n_chunks, CHUNK, G_B, C_B)
    v = jnp.einsum('gpq,bnqgc->bnpgc', p["sgu_w"], v) + p["sgu_b"].T[:, :, None]
    return u * v.reshape(B, T, D_B)


def token_mixer(h, p, s0_f, s0_b, n_chunks):
    z = h @ p["w_in"]
    z_rwkv, z_sgu, z_gate = jnp.split(z, [N_RWKV, N_RWKV + 2 * D_B], axis=-1)
    r, k_f, k_b, v, d_f, d_b, kk, a_f, a_b, dg = rwkv_prep(centred_shift(z_rwkv, p["shift_conv"]), p)
    y_f, s_f = rwkv_scan(r, k_f, v, d_f, kk, a_f, s0_f, reverse=False)
    y_b, s_b = rwkv_scan(r, k_b, v, d_b, kk, a_b, s0_b, reverse=True)
    y_a = rwkv_readout(y_f + y_b, r, k_f, v, jax.nn.sigmoid(dg) @ p["g2"], p)
    y_s = spatial_gating(z_sgu, p, n_chunks)
    g_a, g_s = jnp.split(jax.nn.sigmoid(z_gate), 2, axis=-1)
    merged = g_a * (y_a @ p["w_branch_a"]) + g_s * (y_s @ p["w_branch_b"])
    return merged @ p["w_out"], s_f, s_b


def context_scan_states(h, p, s0):
    z_rwkv = centred_shift(h @ p["w_in"][:, :N_RWKV], p["shift_conv"])
    r, k_f, k_b, v, d_f, d_b, kk, a_f, a_b, _ = rwkv_prep(z_rwkv, p)
    _, s_f = rwkv_scan(r, k_f, v, d_f, kk, a_f, s0, reverse=False)
    _, s_b = rwkv_scan(r, k_b, v, d_b, kk, a_b, s0, reverse=True)
    return s_f, s_b


def expert_choice_ffn(h, p):
    B, T, D = h.shape
    cap = CAP_FACTOR * T // N_EXP
    aff = jax.nn.softmax((h @ p["router_w"]).astype(jnp.float32), axis=-1)
    gate, idx = lax.top_k(jnp.swapaxes(aff, 1, 2), cap)
    xe = jax.vmap(lambda hb, ib: hb[ib])(h, idx)
    hid = jax.nn.silu(jnp.einsum('becd,edf->becf', xe, p["exp_w1"])) * \
        jnp.einsum('becd,edf->becf', xe, p["exp_w3"])
    ye = jnp.einsum('becf,efd->becd', hid, p["exp_w2"]) * gate[..., None].astype(h.dtype)
    return jax.vmap(lambda yb, ib: jax.ops.segment_sum(
        yb.reshape(-1, D), ib.reshape(-1), num_segments=T))(ye, idx)


def setup_inputs(seed: int = 0) -> dict:
    key = jax.random.key(seed)
    ks = iter(jax.random.split(key, 40))
    L, D = DEPTH, D_MODEL
    nrm = lambda shape, scale: scale * jax.random.normal(next(ks), shape, jnp.float32)
    return {
        "x": nrm((BATCH, SEQ, D), 1.0),
        "c": nrm((BATCH, D), 1.0),
        "ctx": nrm((BATCH, CTX_LEN, D), 1.0),
        "c_ctx": nrm((D,), 1.0),
        "ada_w": nrm((L, D, 6 * D), D ** -0.5),
        "ada_b": nrm((L, 6 * D), 0.02),
        "w_in": nrm((L, D, N_IN), D ** -0.5),
        "shift_conv": jnp.array([0.25, 0.5, 0.25], jnp.float32)[None, :, None] + nrm((L, SHIFT_W, N_RWKV), 0.1),
        "w0": jax.random.uniform(next(ks), (L, 2, D_A), jnp.float32, -6.0, -1.0),
        "w2": nrm((L, 2, R_W, D_A), 0.5 * R_W ** -0.5),
        "a0": nrm((L, 2, D_A), 0.1),
        "a2": nrm((L, 2, R_A, D_A), 0.5 * R_A ** -0.5),
        "g2": nrm((L, R_G, D_A), R_G ** -0.5),
        "k_k": 0.85 + nrm((L, D_A), 0.05),
        "k_a": 1.0 + nrm((L, D_A), 0.05),
        "r_k": nrm((L, H_A, HEAD_A), 0.1),
        "lnx_g": 1.0 + nrm((L, D_A), 0.02),
        "lnx_b": nrm((L, D_A), 0.02),
        "sgu_ln_g": 1.0 + nrm((L, D_B), 0.02),
        "sgu_ln_b": nrm((L, D_B), 0.02),
        "sgu_w": nrm((L, G_B, CHUNK, CHUNK), 0.5 * CHUNK ** -0.5),
        "sgu_b": 1.0 + nrm((L, G_B, CHUNK), 0.1),
        "w_branch_a": nrm((L, D_A, D), D_A ** -0.5),
        "w_branch_b": nrm((L, D_B, D), D_B ** -0.5),
        "w_out": nrm((L, D, D), BETA * D ** -0.5),
        "ln1_g": 1.0 + nrm((L, D), 0.02),
        "ln1_b": nrm((L, D), 0.02),
        "router_w": nrm((L, D, N_EXP), D ** -0.5),
        "exp_w1": nrm((L, N_EXP, D, D_FF), D ** -0.5),
        "exp_w3": nrm((L, N_EXP, D, D_FF), D ** -0.5),
        "exp_w2": nrm((L, N_EXP, D_FF, D), BETA * D_FF ** -0.5),
        "ln2_g": 1.0 + nrm((L, D), 0.02),
        "ln2_b": nrm((L, D), 0.02),
    }


def reference(x, c, ctx, c_ctx, ada_w, ada_b, w_in, shift_conv, w0, w2, a0, a2, g2, k_k, k_a, r_k,
              lnx_g, lnx_b, sgu_ln_g, sgu_ln_b, sgu_w, sgu_b, w_branch_a, w_branch_b, w_out,
              ln1_g, ln1_b, router_w, exp_w1, exp_w3, exp_w2, ln2_g, ln2_b):
    B, T, _ = x.shape
    rows = T // GRID_W
    lat_chunks = rows * GRID_W // CHUNK
    ctx_chunks = ctx.shape[1] // CHUNK
    s0 = jnp.zeros((B, H_A, HEAD_A, HEAD_A), jnp.float32)
    for l in range(DEPTH):
        p = dict(w_in=w_in[l], shift_conv=shift_conv[l], w0=w0[l], w2=w2[l], a0=a0[l], a2=a2[l],
                 g2=g2[l], k_k=k_k[l], k_a=k_a[l], r_k=r_k[l], lnx_g=lnx_g[l], lnx_b=lnx_b[l],
                 sgu_ln_g=sgu_ln_g[l], sgu_ln_b=sgu_ln_b[l], sgu_w=sgu_w[l], sgu_b=sgu_b[l],
                 w_branch_a=w_branch_a[l], w_branch_b=w_branch_b[l], w_out=w_out[l],
                 router_w=router_w[l], exp_w1=exp_w1[l], exp_w3=exp_w3[l], exp_w2=exp_w2[l])
        mod_x = (jax.nn.silu(c) @ ada_w[l] + ada_b[l])[:, None, :]
        mod_c = (jax.nn.silu(c_ctx) @ ada_w[l] + ada_b[l])[None, None, :]
        sh1, sc1, gt1, sh2, sc2, gt2 = jnp.split(mod_x, 6, axis=-1)
        csh1, csc1, cgt1, csh2, csc2, cgt2 = jnp.split(mod_c, 6, axis=-1)

        hc = modulate(ctx, csh1, csc1)
        if l == DEPTH - 1:
            s_f, s_b = context_scan_states(hc, p, s0)
        else:
            yc, s_f, s_b = token_mixer(hc, p, s0, s0, ctx_chunks)
            ctx = layer_norm(ALPHA * ctx + cgt1 * yc, ln1_g[l], ln1_b[l])
            ctx = layer_norm(ALPHA * ctx + cgt2 * expert_choice_ffn(modulate(ctx, csh2, csc2), p),
                             ln2_g[l], ln2_b[l])

        yx, _, _ = token_mixer(modulate(x, sh1, sc1), p, s_f, s_b, lat_chunks)
        x = layer_norm(ALPHA * x + gt1 * yx, ln1_g[l], ln1_b[l])
        x = layer_norm(ALPHA * x + gt2 * expert_choice_ffn(modulate(x, sh2, sc2), p),
                       ln2_g[l], ln2_b[l])
    return x
```

```cpp
#include <hip/hip_runtime.h>
#include <cstdio>
#include <cstdint>

#ifndef MK_STOP
#define MK_DSEL 255
#define MK_STOP 99
#endif
#ifndef MK_SINGLE
#define MK_SINGLE 0
#endif

#define GAS __attribute__((address_space(1)))
#define LAS __attribute__((address_space(3)))

typedef unsigned short bf16_t;
typedef short bf16x8 __attribute__((ext_vector_type(8)));
typedef float f32x4 __attribute__((ext_vector_type(4)));
typedef float f32x2 __attribute__((ext_vector_type(2)));
typedef unsigned u32x4 __attribute__((ext_vector_type(4)));
typedef unsigned u32x2 __attribute__((ext_vector_type(2)));

constexpr int D = 1024, NB = 16, TL = 2048, TC = 256;
constexpr int MLAT = NB * TL;
constexpr int MCTX = NB * TC;
constexpr int MALL = MLAT + MCTX;
constexpr int NRW = 3456;
constexpr int NIN = 7552;
constexpr int ZR_LD = 3584;
constexpr int NZ = 7680;
constexpr int NEXP = 16, DFF = 2048;
constexpr float ALPHA = 1.41421356237309515f;
constexpr float LN_EPS = 1e-5f, GN_EPS = 64e-5f;
constexpr int NPH = 14;

constexpr size_t MiB = 1u << 20;
constexpr size_t WS_CTL = 0, CTL_ZERO_BYTES = 1 * MiB;
constexpr size_t WS_MOD = 1 * MiB;
constexpr size_t WS_WIN = 2 * MiB;
constexpr size_t WS_WA = 32 * MiB, WS_WB = 36 * MiB, WS_WO = 40 * MiB;
constexpr size_t WS_G2 = 44 * MiB;
constexpr size_t WS_WSG = 45 * MiB;
constexpr size_t WS_AFF = 46 * MiB;
constexpr size_t WS_INV = 49 * MiB;
constexpr size_t WS_BON = 52 * MiB;
constexpr size_t WS_SELT = 55 * MiB;
constexpr size_t WS_SELG = 55 * MiB + 512 * 1024;
constexpr size_t WS_CXM = 56 * MiB;
constexpr size_t WS_AG = 72 * MiB;
constexpr size_t WS_S = 90 * MiB;
constexpr size_t WS_Y = 162 * MiB;
constexpr size_t WS_XA = 306 * MiB;
constexpr size_t WS_Z = 450 * MiB;
#ifdef MK_RELOC
constexpr size_t WS_ZS = WS_Z, WS_ZG = WS_ZS + 144 * MiB, WS_ZR = WS_ZG + 144 * MiB;
#else
constexpr size_t WS_ZS = WS_Z + 252 * MiB, WS_ZG = WS_ZS + 144 * MiB, WS_ZR = WS_Z;
#endif
constexpr size_t WS_HID = WS_Z, WS_WE13 = WS_Z + 288 * MiB, WS_WE2 = WS_WE13 + 128 * MiB;
constexpr size_t WS_END = 990 * MiB;
static_assert(WS_WE2 + 64 * MiB <= WS_END, "ws map");
constexpr int CW_BAR = 4096;

constexpr int LDS_BYTES = 147456;
constexpr int LDS_MISC = LDS_BYTES - 256;

__device__ __forceinline__ float bf2f(unsigned short b) { return __uint_as_float(((unsigned)b) << 16); }
__device__ __forceinline__ float bflo(unsigned u) { return __uint_as_float(u << 16); }
__device__ __forceinline__ float bfhi(unsigned u) { return __uint_as_float(u & 0xffff0000u); }
typedef __bf16 bf16x2_t __attribute__((ext_vector_type(2)));
__device__ __forceinline__ unsigned cvt_pk_bf16(float lo, float hi) { const f32x2 v = {lo, hi}; const bf16x2_t b = __builtin_convertvector(v, bf16x2_t); return __builtin_bit_cast(unsigned, b); }
__device__ __forceinline__ unsigned short f2bf(float f) { return (unsigned short)(cvt_pk_bf16(f, 0.f) & 0xffffu); }
__device__ __forceinline__ float fast_exp(float x) { return __builtin_amdgcn_exp2f(x * 1.44269504088896341f); }
__device__ __forceinline__ float fast_sigmoid(float x) { return __builtin_amdgcn_rcpf(1.0f + fast_exp(-x)); }
__device__ __forceinline__ float fast_tanh(float x) { const float e = fast_exp(2.0f * x); return 1.0f - 2.0f * __builtin_amdgcn_rcpf(e + 1.0f); }
__device__ __forceinline__ float softplus_f(float x) { return fmaxf(x, 0.f) + __logf(1.0f + fast_exp(-fabsf(x))); }
__device__ __forceinline__ float wave_sum(float v) {
#pragma unroll
    for (int o = 32; o > 0; o >>= 1) v += __shfl_xor(v, o);
    return v;
}
template <int CTRL> __device__ __forceinline__ float dpp_f(float v) { return __int_as_float(__builtin_amdgcn_update_dpp(0, __float_as_int(v), CTRL, 0xf, 0xf, true)); }
__device__ __forceinline__ float quad_sum(float v) { v += dpp_f<0xB1>(v); v += dpp_f<0x4E>(v); return v; }
__device__ __forceinline__ float oct_sum(float v) { v = quad_sum(v); v += dpp_f<0x141>(v); return v; }
__device__ __forceinline__ void wave_lds_fence() { asm volatile("s_waitcnt lgkmcnt(0)" ::: "memory"); __builtin_amdgcn_wave_barrier(); asm volatile("" ::: "memory"); }

__device__ __forceinline__ f32x2 gelu_pk(f32x2 v) {
    const f32x2 av = __builtin_elementwise_abs(v), d = av * 0.2316418882f + 1.0f;
    f32x2 t; t.x = __builtin_amdgcn_rcpf(d.x); t.y = __builtin_amdgcn_rcpf(d.y);
    f32x2 q = t * 0.5307027145f + (-0.7265760135f); q = q * t + 0.7107068705f; q = q * t + (-0.142248368f); q = q * t + 0.127414796f; q = q * t;
    const f32x2 s = (v * v) * (-0.72134752044f);
    f32x2 e; e.x = __builtin_amdgcn_exp2f(s.x); e.y = __builtin_amdgcn_exp2f(s.y);
    const f32x2 m = v * (q * e), r = v - m;
    f32x2 o; o.x = v.x < 0.f ? m.x : r.x; o.y = v.y < 0.f ? m.y : r.y; return o;
}

#define XB_TMO      128
#define XB_XCNT(j)  (256  + 64 * (j))
#define XB_XSUB(j)  (1280 + 64 * (j))
#define XB_XGEN(j)  (2304 + 64 * (j))
#define XB_TOP      3328
#define XB_TOPGEN   3392
#define XCD_BAR_WORDS 3456
#define XB_SPIN_CAP (1u << 22)
__device__ __forceinline__ unsigned xb_ld(unsigned* p)              { return __hip_atomic_load(p, __ATOMIC_RELAXED, __HIP_MEMORY_SCOPE_AGENT); }
__device__ __forceinline__ unsigned xb_add(unsigned* p, unsigned v) { return __hip_atomic_fetch_add(p, v, __ATOMIC_RELAXED, __HIP_MEMORY_SCOPE_AGENT); }
__device__ __forceinline__ unsigned xb_xcc_id() { return (unsigned)__builtin_amdgcn_s_getreg((3 << 11) | 20) & 0xFu; }
#define XB_SPIN(cond, bar) do { unsigned _sp = 0; while (cond) { __builtin_amdgcn_s_sleep(1); \
    if ((++_sp & 255u) == 0u) { if (xb_ld(&(bar)[XB_TMO])) break; if (_sp > XB_SPIN_CAP) { atomicAdd(&(bar)[XB_TMO], 1u); break; } } } } while (0)
struct XcdBarrier { unsigned* bar; unsigned x; volatile LAS unsigned* st; };
__device__ __forceinline__ XcdBarrier xcd_barrier_post(unsigned* bar, volatile LAS unsigned* st) {
    XcdBarrier b; b.bar = bar; b.x = xb_xcc_id(); b.st = st;
    if (threadIdx.x == 0) (void)xb_add(&bar[XB_XCNT(b.x)], 1u);
    return b;
}
__device__ __forceinline__ void xcd_barrier_complete(unsigned* bar, unsigned x, unsigned& nloc, unsigned& nx) {
    const unsigned G = gridDim.x * gridDim.y * gridDim.z;
    unsigned sum, cnt, mine, sp = 0u;
    for (;;) {
        sum = 0u; cnt = 0u;
#pragma nounroll
        for (unsigned j = 0; j < 16; ++j) { const unsigned c = xb_ld(&bar[XB_XCNT(j)]); sum += c; cnt += (c > 0u) ? 1u : 0u; }
        mine = xb_ld(&bar[XB_XCNT(x)]);
        if (sum == G) break;
        __builtin_amdgcn_s_sleep(1);
        if ((++sp & 255u) == 0u) { if (xb_ld(&bar[XB_TMO])) break; if (sp > XB_SPIN_CAP) { atomicAdd(&bar[XB_TMO], 1u); break; } }
    }
    nloc = mine > 0u ? mine : 1u; nx = cnt > 0u ? cnt : 1u;
}
__device__ __forceinline__ void xcd_barrier(const XcdBarrier& b) {
    asm volatile("s_waitcnt vmcnt(0)" ::: "memory");
    __syncthreads();
    if (threadIdx.x == 0) {
        unsigned* bar = b.bar;
        __builtin_amdgcn_s_waitcnt(0);
        unsigned nloc = b.st[0], nx = b.st[1];
        if (nloc == 0u) { xcd_barrier_complete(bar, b.x, nloc, nx); b.st[0] = nloc; b.st[1] = nx; }
        const unsigned old = xb_add(&bar[XB_XSUB(b.x)], 1u);
        const unsigned gen = old / nloc;
        if (old + 1u == (gen + 1u) * nloc) {
            __builtin_amdgcn_fence(__ATOMIC_RELEASE, "agent");
            asm volatile("s_waitcnt vmcnt(0)" ::: "memory");
            const unsigned og = xb_add(&bar[XB_TOP], 1u);
            const unsigned tg = og / nx;
            if (og + 1u == (tg + 1u) * nx) xb_add(&bar[XB_TOPGEN], 1u);
            else XB_SPIN(xb_ld(&bar[XB_TOPGEN]) == tg, bar);
            __builtin_amdgcn_fence(__ATOMIC_ACQUIRE, "agent");
            xb_add(&bar[XB_XGEN(b.x)], 1u);
            asm volatile("s_waitcnt vmcnt(0)" ::: "memory");
        } else {
            XB_SPIN(xb_ld(&bar[XB_XGEN(b.x)]) == gen, bar);
            __builtin_amdgcn_fence(__ATOMIC_ACQUIRE, "agent");
            asm volatile("s_waitcnt vmcnt(0)" ::: "memory");
        }
    }
    __syncthreads();
}

namespace pg8 {
constexpr int BM = 256, BK = 64, HALF = 128, HTB = HALF * BK * 2, STAGE_BYTES = 8 * HTB, NXCD = 8, WGM = 8;
__host__ __device__ __forceinline__ int lds_byte(int r, int c) { const int st = (r >> 4) * 2 + (c >> 5), rr = r & 15, cc = c & 31, ob = rr * 64 + cc * 2; return st * 1024 + (ob ^ (((ob >> 9) & 1) << 5)); }
__host__ __device__ __forceinline__ void stage_rc(int b, int& R, int& C) { const int st = b / 1024, sb = b % 1024, swz = sb ^ (((sb >> 9) & 1) << 5); R = (st >> 1) * 16 + swz / 64; C = (st & 1) * 32 + (swz % 64) / 2; }
__host__ __device__ __forceinline__ int perm32(int rho) { const int n = rho >> 4, i = rho & 15; return 8 * (i >> 2) + 4 * n + (i & 3); }
struct Unit { int pm, pn; };
struct Gemm { const bf16_t* A; const bf16_t* Bt; int M, N, K; };

struct Order {
    int nM, nN, nwg, G, c, nMe, nNe;
    __device__ void init(int nM_, int nN_, int G_, int c_, int nMe_ = 0) { nM = nM_; nN = nN_; nwg = nM * nN; G = G_; c = c_; nMe = nMe_; nNe = nN_; }
    __device__ bool next(int i, Unit& u) const {
        const long L = (long)i * G + c; if (L >= nwg) return false;
        int wgid = (int)L; { const int q = nwg / NXCD, r = nwg % NXCD, xcd = wgid % NXCD, off = wgid / NXCD; wgid = (xcd < r ? xcd * (q + 1) : r * (q + 1) + (xcd - r) * q) + off; }
        const int nig = WGM * nN, gid = wgid / nig, fm = gid * WGM, gsz = (nM - fm) < WGM ? (nM - fm) : WGM;
        u.pm = fm + ((wgid % nig) % gsz); u.pn = (wgid % nig) / gsz;
        if (nMe > 0) u.pn += (u.pm / nMe) * nNe;
        return true;
    }
    __device__ __forceinline__ void a_ready(const Unit&) const {}
    __device__ __forceinline__ void done(const Unit&) const {}
};

template <class Epi, class Sched, bool ALIGN_EPI = true>
__device__ __forceinline__ void gemm_phase(LAS unsigned char* lds, const Gemm g, const Sched& S, const Epi& E) {
    int tid = threadIdx.x; asm volatile("" : "+v"(tid));
    const int wid = __builtin_amdgcn_readfirstlane(tid >> 6), lane = tid & 63, wr = wid >> 2, wc = wid & 3, fr = lane & 15, fq = lane >> 4;
    const int K = g.K, nt = K / BK;
    unsigned voffA[2], voffB[2];
#pragma unroll
    for (int i = 0; i < 2; ++i) { int R, C; stage_rc(tid * 16 + i * 8192, R, C); const int Rb = Epi::PERM ? ((R & ~31) + perm32(R & 31)) : R;
        voffA[i] = (unsigned)(R * K + C) * 2u; voffB[i] = (unsigned)(Rb * K + C) * 2u; }
    const size_t kstep = (size_t)(BK * 2);
    const size_t hstep = (size_t)HALF * K * 2;
    const size_t tstep = 2 * hstep;
    const unsigned ldsw = (unsigned)wid * 1024u;
    const int aoff = lds_byte(wr * 64 + fr, fq * 8), boff = lds_byte(wc * 32 + fr, fq * 8);
#define PG8_SA(b, h) (((b) * 2 + (h)) * HTB)
#define PG8_SB(b, h) ((4 + (b) * 2 + (h)) * HTB)
#define PG8_STAGE(bufoff, gbase, voff) do { _Pragma("unroll") for (int _i = 0; _i < 2; ++_i) \
        __builtin_amdgcn_global_load_lds((const unsigned*)((const char*)(gbase) + (voff)[_i]), (LAS unsigned*)(lds + (bufoff) + ldsw + _i * 8192), 16, 0, 0); } while (0)
#define PG8_LDA(dst, b, h) do { _Pragma("unroll") for (int m = 0; m < 4; ++m) _Pragma("unroll") for (int k = 0; k < 2; ++k) dst[m][k] = *(const LAS bf16x8*)(lds + PG8_SA(b, h) + aoff + m * 2048 + k * 1024); } while (0)
#define PG8_LDB(dst, b, h) do { _Pragma("unroll") for (int n = 0; n < 2; ++n) _Pragma("unroll") for (int k = 0; k < 2; ++k) dst[n][k] = *(const LAS bf16x8*)(lds + PG8_SB(b, h) + boff + n * 2048 + k * 1024); } while (0)
#define PG8_MMA(ai, bj, At, Bt) do { __builtin_amdgcn_s_setprio(1); _Pragma("unroll") for (int m = 0; m < 4; ++m) _Pragma("unroll") for (int n = 0; n < 2; ++n) _Pragma("unroll") for (int k = 0; k < 2; ++k) \
        acc[ai][bj][m][n] = __builtin_amdgcn_mfma_f32_16x16x32_bf16(Bt[n][k], At[m][k], acc[ai][bj][m][n], 0, 0, 0); __builtin_amdgcn_s_setprio(0); } while (0)
#ifdef MK_DRAIN
#define PG8_WAIT_V(n) asm volatile("s_waitcnt vmcnt(0)" ::: "memory")
#else
#define PG8_WAIT_V(n) asm volatile("s_waitcnt vmcnt(" #n ")" ::: "memory")
#endif
#define PG8_WAIT_L(n) asm volatile("s_waitcnt lgkmcnt(" #n ")" ::: "memory")
#define PG8_BAR __builtin_amdgcn_s_barrier()
#define PG8_SCHED __builtin_amdgcn_sched_barrier(0)
    Unit cur, nxt; int ui = 0;
    if (!S.next(0, cur)) return;
    f32x4 acc[2][2][4][2];
#pragma unroll
    for (int a = 0; a < 2; ++a)
#pragma unroll
        for (int b = 0; b < 2; ++b)
#pragma unroll
            for (int m = 0; m < 4; ++m)
#pragma unroll
                for (int n = 0; n < 2; ++n) acc[a][b][m][n] = (f32x4){0.f, 0.f, 0.f, 0.f};
    bf16x8 At[4][2], B0[2][2], B1[2][2];
    const char* cA = (const char*)g.A + (size_t)cur.pm * tstep; const char* cB = (const char*)g.Bt + (size_t)cur.pn * tstep;
    S.a_ready(cur);
    PG8_STAGE(PG8_SB(0, 0), cB, voffB); PG8_STAGE(PG8_SB(0, 1), cB + hstep, voffB); PG8_STAGE(PG8_SA(0, 0), cA, voffA); PG8_STAGE(PG8_SA(0, 1), cA + hstep, voffA);
    if (wr == 1) PG8_BAR;
    PG8_WAIT_V(2); PG8_BAR;
    PG8_STAGE(PG8_SB(1, 0), cB + kstep, voffB); PG8_STAGE(PG8_SA(1, 0), cA + kstep, voffA); PG8_STAGE(PG8_SB(1, 1), cB + hstep + kstep, voffB);
    PG8_WAIT_V(6); PG8_BAR;
    for (;;) {
        const bool has_next = S.next(ui + 1, nxt);
        const char* nA = has_next ? (const char*)g.A + (size_t)nxt.pm * tstep : cA; const char* nB = has_next ? (const char*)g.Bt + (size_t)nxt.pn * tstep : cB;
        for (int t = 0; t < nt; t += 2) {
            const bool last = (t == nt - 2);
            const char* a1 = cA + (size_t)(t + 1) * kstep;
            const char* a2 = last ? nA : cA + (size_t)(t + 2) * kstep; const char* b2 = last ? nB : cB + (size_t)(t + 2) * kstep;
            const char* a3 = a2 + kstep; const char* b3 = b2 + kstep;
            if (last && has_next) S.a_ready(nxt);
            PG8_LDB(B0, 0, 0); PG8_LDB(B1, 0, 1); PG8_SCHED; PG8_LDA(At, 0, 0); PG8_STAGE(PG8_SA(1, 1), a1 + hstep, voffA);
            PG8_WAIT_V(8); PG8_WAIT_L(0); PG8_BAR; PG8_MMA(0, 0, At, B0); PG8_MMA(0, 1, At, B1); PG8_BAR; PG8_SCHED;
            PG8_LDA(At, 0, 1); PG8_STAGE(PG8_SB(0, 0), b2, voffB); PG8_STAGE(PG8_SB(0, 1), b2 + hstep, voffB); PG8_STAGE(PG8_SA(0, 0), a2, voffA);
            PG8_WAIT_V(8); PG8_WAIT_L(0); PG8_BAR; PG8_MMA(1, 0, At, B0); PG8_MMA(1, 1, At, B1); PG8_BAR; PG8_SCHED;
            PG8_LDB(B0, 1, 0); PG8_LDB(B1, 1, 1); PG8_SCHED; PG8_LDA(At, 1, 0); PG8_STAGE(PG8_SA(0, 1), a2 + hstep, voffA);
            PG8_WAIT_V(8); PG8_WAIT_L(0); PG8_BAR; PG8_MMA(0, 0, At, B0); PG8_MMA(0, 1, At, B1); PG8_BAR; PG8_SCHED;
            PG8_LDA(At, 1, 1); PG8_STAGE(PG8_SB(1, 0), b3, voffB); PG8_STAGE(PG8_SB(1, 1), b3 + hstep, voffB); PG8_STAGE(PG8_SA(1, 0), a3, voffA);
            PG8_WAIT_V(8); PG8_WAIT_L(0); PG8_BAR; PG8_MMA(1, 0, At, B0); PG8_MMA(1, 1, At, B1); PG8_BAR; PG8_SCHED;
        }
        if constexpr (ALIGN_EPI) { if (wr == 0) PG8_BAR; }
        E(acc, cur, wr, wc, fr, fq); S.done(cur);
        if (!has_next) break;
#pragma unroll
        for (int a = 0; a < 2; ++a)
#pragma unroll
            for (int b = 0; b < 2; ++b)
#pragma unroll
                for (int m = 0; m < 4; ++m)
#pragma unroll
                    for (int n = 0; n < 2; ++n) acc[a][b][m][n] = (f32x4){0.f, 0.f, 0.f, 0.f};
        cur = nxt; cA = nA; cB = nB; ++ui;
        if constexpr (ALIGN_EPI) { if (wr == 1) PG8_BAR; }
    }
    PG8_WAIT_V(0);
    if constexpr (!ALIGN_EPI) { if (wr == 0) PG8_BAR; }
    PG8_BAR;
#undef PG8_SA
#undef PG8_SB
#undef PG8_STAGE
#undef PG8_LDA
#undef PG8_LDB
#undef PG8_MMA
#undef PG8_WAIT_V
#undef PG8_WAIT_L
#undef PG8_BAR
#undef PG8_SCHED
}


template <class Epi, class Sched>
__device__ __forceinline__ void gemm_simple(LAS unsigned char* lds, const Gemm g, const Sched& S, const Epi& E) {
    int tid = threadIdx.x; asm volatile("" : "+v"(tid));
    const int wid = __builtin_amdgcn_readfirstlane(tid >> 6), lane = tid & 63, wr = wid >> 2, wc = wid & 3, fr = lane & 15, fq = lane >> 4;
    const int K = g.K, nt = K / BK;
    unsigned voffA[2], voffB[2];
#pragma unroll
    for (int i = 0; i < 2; ++i) { int R, C; stage_rc(tid * 16 + i * 8192, R, C); const int Rb = Epi::PERM ? ((R & ~31) + perm32(R & 31)) : R;
        voffA[i] = (unsigned)(R * K + C) * 2u; voffB[i] = (unsigned)(Rb * K + C) * 2u; }
    const size_t hstep = (size_t)HALF * K * 2, tstep = 2 * hstep;
    const int aoff = lds_byte(wr * 64 + fr, fq * 8), boff = lds_byte(wc * 32 + fr, fq * 8);
    Unit cur;
    for (int ui = 0; S.next(ui, cur); ++ui) {
        f32x4 acc[2][2][4][2];
#pragma unroll
        for (int a = 0; a < 2; ++a)
#pragma unroll
            for (int b = 0; b < 2; ++b)
#pragma unroll
                for (int m = 0; m < 4; ++m)
#pragma unroll
                    for (int n = 0; n < 2; ++n) acc[a][b][m][n] = (f32x4){0.f, 0.f, 0.f, 0.f};
        const char* cA = (const char*)g.A + (size_t)cur.pm * tstep; const char* cB = (const char*)g.Bt + (size_t)cur.pn * tstep;
        for (int t = 0; t < nt; ++t) {
            __syncthreads();
#pragma unroll
            for (int h = 0; h < 2; ++h)
#pragma unroll
                for (int i = 0; i < 2; ++i) {
                    const u32x4 va = *(const u32x4*)(cA + h * hstep + (size_t)t * 128 + voffA[i]);
                    const u32x4 vb = *(const u32x4*)(cB + h * hstep + (size_t)t * 128 + voffB[i]);
                    *(LAS u32x4*)(lds + (0 + h) * HTB + tid * 16 + i * 8192) = va;
                    *(LAS u32x4*)(lds + (4 + h) * HTB + tid * 16 + i * 8192) = vb;
                }
            __syncthreads();
            bf16x8 At[4][2], B0[2][2], B1[2][2];
#pragma unroll
            for (int n = 0; n < 2; ++n)
#pragma unroll
                for (int k = 0; k < 2; ++k) { B0[n][k] = *(const LAS bf16x8*)(lds + 4 * HTB + boff + n * 2048 + k * 1024); B1[n][k] = *(const LAS bf16x8*)(lds + 5 * HTB + boff + n * 2048 + k * 1024); }
#pragma unroll
            for (int ai = 0; ai < 2; ++ai) {
#pragma unroll
                for (int m = 0; m < 4; ++m)
#pragma unroll
                    for (int k = 0; k < 2; ++k) At[m][k] = *(const LAS bf16x8*)(lds + ai * HTB + aoff + m * 2048 + k * 1024);
#pragma unroll
                for (int m = 0; m < 4; ++m)
#pragma unroll
                    for (int n = 0; n < 2; ++n)
#pragma unroll
                        for (int k = 0; k < 2; ++k) {
                            acc[ai][0][m][n] = __builtin_amdgcn_mfma_f32_16x16x32_bf16(B0[n][k], At[m][k], acc[ai][0][m][n], 0, 0, 0);
                            acc[ai][1][m][n] = __builtin_amdgcn_mfma_f32_16x16x32_bf16(B1[n][k], At[m][k], acc[ai][1][m][n], 0, 0, 0); }
            }
        }
        E(acc, cur, wr, wc, fr, fq);
    }
    __syncthreads();
}

__device__ __forceinline__ u32x4 pack8(const f32x4 v0, const f32x4 v1) { u32x4 w; w.x = cvt_pk_bf16(v0[0], v0[1]); w.y = cvt_pk_bf16(v0[2], v0[3]); w.z = cvt_pk_bf16(v1[0], v1[1]); w.w = cvt_pk_bf16(v1[2], v1[3]); return w; }

struct EpiZ {
    static constexpr bool PERM = true;
    bf16_t* Zr; bf16_t* Zs; bf16_t* Zg; int rowoff;
    __device__ __forceinline__ void operator()(const f32x4 (&acc)[2][2][4][2], const Unit& u, int wr, int wc, int fr, int fq) const {
        const int row0 = rowoff + u.pm * BM + wr * 64 + fr; const int pn = u.pn;
        if (pn < 14) {
            bf16_t* base = Zr + (size_t)row0 * ZR_LD + pn * 256 + wc * 32 + 8 * fq;
#pragma unroll
            for (int ai = 0; ai < 2; ++ai)
#pragma unroll
                for (int m = 0; m < 4; ++m)
#pragma unroll
                    for (int bj = 0; bj < 2; ++bj) *(u32x4*)(base + (size_t)(ai * HALF + m * 16) * ZR_LD + bj * HALF) = pack8(acc[ai][bj][m][0], acc[ai][bj][m][1]);
        } else if (pn < 22) {
            bf16_t* base = Zs + (size_t)row0 * 2048 + (pn - 14) * 256 + wc * 32 + 8 * fq;
#pragma unroll
            for (int ai = 0; ai < 2; ++ai)
#pragma unroll
                for (int m = 0; m < 4; ++m)
#pragma unroll
                    for (int bj = 0; bj < 2; ++bj) { const f32x4 v0 = acc[ai][bj][m][0], v1 = acc[ai][bj][m][1];
                        const f32x2 a = gelu_pk((f32x2){v0[0], v0[1]}), b = gelu_pk((f32x2){v0[2], v0[3]}), c = gelu_pk((f32x2){v1[0], v1[1]}), d = gelu_pk((f32x2){v1[2], v1[3]});
                        *(u32x4*)(base + (size_t)(ai * HALF + m * 16) * 2048 + bj * HALF) = pack8((f32x4){a.x, a.y, b.x, b.y}, (f32x4){c.x, c.y, d.x, d.y}); }
        } else {
            bf16_t* base = Zg + (size_t)row0 * 2048 + (pn - 22) * 256 + wc * 32 + 8 * fq;
#pragma unroll
            for (int ai = 0; ai < 2; ++ai)
#pragma unroll
                for (int m = 0; m < 4; ++m)
#pragma unroll
                    for (int bj = 0; bj < 2; ++bj) { f32x4 v0 = acc[ai][bj][m][0], v1 = acc[ai][bj][m][1];
#pragma unroll
                        for (int j = 0; j < 4; ++j) { v0[j] = fast_sigmoid(v0[j]); v1[j] = fast_sigmoid(v1[j]); }
                        *(u32x4*)(base + (size_t)(ai * HALF + m * 16) * 2048 + bj * HALF) = pack8(v0, v1); }
        }
    }
};
struct EpiMulInPlace {
    static constexpr bool PERM = true;
    bf16_t* IO;
    __device__ __forceinline__ void operator()(const f32x4 (&acc)[2][2][4][2], const Unit& u, int wr, int wc, int fr, int fq) const {
        bf16_t* base = IO + (size_t)(u.pm * BM + wr * 64 + fr) * 1024 + u.pn * 256 + wc * 32 + 8 * fq;
#pragma unroll
        for (int ai = 0; ai < 2; ++ai)
#pragma unroll
            for (int m = 0; m < 4; ++m)
#pragma unroll
                for (int bj = 0; bj < 2; ++bj) { u32x4* p = (u32x4*)(base + (size_t)(ai * HALF + m * 16) * 1024 + bj * HALF); const u32x4 w = *p;
                    const f32x4 a0 = acc[ai][bj][m][0], a1 = acc[ai][bj][m][1];
                    const f32x4 v0 = (f32x4){bflo(w.x) * a0[0], bfhi(w.x) * a0[1], bflo(w.y) * a0[2], bfhi(w.y) * a0[3]};
                    const f32x4 v1 = (f32x4){bflo(w.z) * a1[0], bfhi(w.z) * a1[1], bflo(w.w) * a1[2], bfhi(w.w) * a1[3]};
                    *p = pack8(v0, v1); }
    }
};
template <bool ACCUM> struct EpiGate {
    static constexpr bool PERM = true;
    bf16_t* OUT; const bf16_t* Zg; int goff;
    __device__ __forceinline__ void operator()(const f32x4 (&acc)[2][2][4][2], const Unit& u, int wr, int wc, int fr, int fq) const {
        const int row0 = u.pm * BM + wr * 64 + fr, col0 = u.pn * 256 + wc * 32 + 8 * fq;
#pragma unroll
        for (int ai = 0; ai < 2; ++ai)
#pragma unroll
            for (int m = 0; m < 4; ++m)
#pragma unroll
                for (int bj = 0; bj < 2; ++bj) { const size_t r = (size_t)(row0 + ai * HALF + m * 16);
                    const u32x4 gt = *(const u32x4*)(Zg + r * 2048 + goff + col0 + bj * HALF);
                    u32x4* p = (u32x4*)(OUT + r * 1024 + col0 + bj * HALF);
                    const f32x4 a0 = acc[ai][bj][m][0], a1 = acc[ai][bj][m][1];
                    f32x4 v0 = (f32x4){bflo(gt.x) * a0[0], bfhi(gt.x) * a0[1], bflo(gt.y) * a0[2], bfhi(gt.y) * a0[3]};
                    f32x4 v1 = (f32x4){bflo(gt.z) * a1[0], bfhi(gt.z) * a1[1], bflo(gt.w) * a1[2], bfhi(gt.w) * a1[3]};
                    if (ACCUM) { const u32x4 w = *p; v0 += (f32x4){bflo(w.x), bfhi(w.x), bflo(w.y), bfhi(w.y)}; v1 += (f32x4){bflo(w.z), bfhi(w.z), bflo(w.w), bfhi(w.w)}; }
                    *p = pack8(v0, v1); }
    }
};
struct EpiRes {
    static constexpr bool PERM = false;
    const float* xlat; const float* xctx; float* olat; float* octx; const float* gt;
    __device__ __forceinline__ void operator()(const f32x4 (&acc)[2][2][4][2], const Unit& u, int wr, int wc, int fr, int fq) const {
        const int rt = u.pm * BM; const bool isctx = rt >= MLAT;
        const int s = isctx ? 16 : (rt >> 11);
        const float* xin = isctx ? xctx + (size_t)(rt - MLAT) * 1024 : xlat + (size_t)rt * 1024;
        float* out = isctx ? octx + (size_t)(rt - MLAT) * 1024 : olat + (size_t)rt * 1024;
        const int col0 = u.pn * 256 + wc * 32 + 4 * fq;
        f32x4 gv[2][2];
#pragma unroll
        for (int bj = 0; bj < 2; ++bj)
#pragma unroll
            for (int n = 0; n < 2; ++n) gv[bj][n] = *(const f32x4*)(gt + (size_t)s * 6144 + col0 + bj * HALF + n * 16);
#pragma unroll
        for (int ai = 0; ai < 2; ++ai)
#pragma unroll
            for (int m = 0; m < 4; ++m) { const size_t ro = (size_t)(wr * 64 + fr + ai * HALF + m * 16) * 1024 + col0;
#pragma unroll
                for (int bj = 0; bj < 2; ++bj)
#pragma unroll
                    for (int n = 0; n < 2; ++n) { const f32x4 xv = *(const f32x4*)(xin + ro + bj * HALF + n * 16);
                        *(f32x4*)(out + ro + bj * HALF + n * 16) = xv * ALPHA + gv[bj][n] * acc[ai][bj][m][n]; } }
    }
};
struct EpiSwiGLU {
    static constexpr bool PERM = true;
    bf16_t* HID;
    __device__ __forceinline__ void operator()(const f32x4 (&acc)[2][2][4][2], const Unit& u, int wr, int wc, int fr, int fq) const {
        const int pn = u.pn & 15;
        bf16_t* base = HID + (size_t)(u.pm * BM + wr * 64 + fr) * 2048 + pn * 128 + wc * 32 + 8 * fq;
#pragma unroll
        for (int ai = 0; ai < 2; ++ai)
#pragma unroll
            for (int m = 0; m < 4; ++m) { f32x4 v[2];
#pragma unroll
                for (int n = 0; n < 2; ++n) { const f32x4 a1 = acc[ai][0][m][n], a3 = acc[ai][1][m][n];
#pragma unroll
                    for (int j = 0; j < 4; ++j) v[n][j] = a1[j] * fast_sigmoid(a1[j]) * a3[j]; }
                *(u32x4*)(base + (size_t)(ai * HALF + m * 16) * 2048) = pack8(v[0], v[1]); }
    }
};
struct EpiScaleRow {
    static constexpr bool PERM = true;
    bf16_t* YE; const float* gate;
    __device__ __forceinline__ void operator()(const f32x4 (&acc)[2][2][4][2], const Unit& u, int wr, int wc, int fr, int fq) const {
        const int pn = u.pn & 3; const int row0 = u.pm * BM + wr * 64 + fr;
#pragma unroll
        for (int ai = 0; ai < 2; ++ai)
#pragma unroll
            for (int m = 0; m < 4; ++m) { const int r = row0 + ai * HALF + m * 16; const float gs = gate[r];
#pragma unroll
                for (int bj = 0; bj < 2; ++bj)
                    *(u32x4*)(YE + (size_t)r * 1024 + pn * 256 + wc * 32 + 8 * fq + bj * HALF) = pack8(acc[ai][bj][m][0] * gs, acc[ai][bj][m][1] * gs); }
    }
};
}

struct Args { const float* in[33]; float* out; unsigned char* ws; int ph_lo, ph_hi; };
enum { I_X = 0, I_C, I_CTX, I_CCTX, I_ADAW, I_ADAB, I_WIN, I_SHIFT, I_W0, I_W2, I_A0, I_A2, I_G2, I_KK, I_KA, I_RK, I_LNXG, I_LNXB, I_SLNG, I_SLNB, I_SGUW, I_SGUB,
       I_WBA, I_WBB, I_WOUT, I_LN1G, I_LN1B, I_ROUTER, I_EW1, I_EW3, I_EW2, I_LN2G, I_LN2B };

struct Th { int tid, lane, wv, G, bid; };
typedef const Args __attribute__((address_space(4)))* KArgP;
__device__ __forceinline__ KArgP kargs() { KArgP p = (KArgP)__builtin_amdgcn_kernarg_segment_ptr(); asm volatile("" : "+s"(p)); return p; }
__device__ __forceinline__ Th mk_th() { Th t; int tid = threadIdx.x; asm volatile("" : "+v"(tid)); int G = gridDim.x, bid = blockIdx.x; asm volatile("" : "+s"(G), "+s"(bid));
    t.tid = tid; t.lane = tid & 63; t.wv = __builtin_amdgcn_readfirstlane(tid >> 6); t.G = G; t.bid = bid; return t; }
__device__ __forceinline__ int opaque_i(int v) { asm volatile("" : "+s"(v)); return v; }

__device__ __forceinline__ void cvt_tile(const float* src, int ldsrc, int k0, int n0, bf16_t* dst, int ldd, int r0, int kd0, LAS unsigned short* T, int lane) {
#pragma unroll 4
    for (int it = 0; it < 16; ++it) {
        const int kk = it * 4 + (lane >> 4), nn = (lane & 15) * 4;
        const f32x4 v = *(const f32x4*)(src + (size_t)(k0 + kk) * ldsrc + n0 + nn);
        T[(nn + 0) * 72 + kk] = f2bf(v[0]); T[(nn + 1) * 72 + kk] = f2bf(v[1]); T[(nn + 2) * 72 + kk] = f2bf(v[2]); T[(nn + 3) * 72 + kk] = f2bf(v[3]);
    }
    wave_lds_fence();
#pragma unroll 4
    for (int it = 0; it < 8; ++it) {
        const int nn = it * 8 + (lane >> 3), ks = (lane & 7) * 8;
        const u32x4 w = *(const LAS u32x4*)(T + nn * 72 + ks);
        *(u32x4*)(dst + (size_t)(r0 + nn) * ldd + kd0 + ks) = w;
    }
    wave_lds_fence();
}
__device__ __forceinline__ int cvt_row(int mode, int n0) {
    if (mode == 1) return n0 < NRW ? n0 : n0 + 128;
    if (mode == 2) return (n0 >> 7) * 256 + (n0 & 127);
    if (mode == 3) return (n0 >> 7) * 256 + 128 + (n0 & 127);
    return n0;
}
__device__ __forceinline__ void cvt_matrix(const float* src, int K, int N, bf16_t* dst, int ldd, int mode, LAS unsigned short* T, int gw, int nw, int lane) {
    const int ntn = N >> 6, ntile = (K >> 6) * ntn;
    for (int t = gw; t < ntile; t += nw) { const int kt = t / ntn, n0 = (t - kt * ntn) * 64; cvt_tile(src, N, kt * 64, n0, dst, ldd, cvt_row(mode, n0), kt * 64, T, lane); }
}

__device__ __forceinline__ void ph_prologue(KArgP a, LAS unsigned char* lds, const Th& t) {
    LAS float* SL = (LAS float*)lds;
    LAS float* RED = SL + 17 * 1024;
    float* MOD = (float*)(a->ws + WS_MOD);
    for (int i = t.tid; i < 17 * 1024; i += 512) { const int s = i >> 10, k = i & 1023; const float v = s < 16 ? a->in[I_C][s * 1024 + k] : a->in[I_CCTX][k]; SL[i] = v * fast_sigmoid(v); }
    __syncthreads();
    for (int slab = t.bid; slab < 256; slab += t.G) {
        const int l = slab >> 7, j0 = (slab & 127) * 48, col = t.tid % 48, kg = t.tid / 48;
        float acc[17];
#pragma unroll
        for (int s = 0; s < 17; ++s) acc[s] = 0.f;
        if (kg < 10) {
            const float* wp = a->in[I_ADAW] + (size_t)l * 1024 * 6144 + j0 + col;
            for (int k = kg; k < 1024; k += 10) { const float w = wp[(size_t)k * 6144];
#pragma unroll
                for (int s = 0; s < 17; ++s) acc[s] += SL[s * 1024 + k] * w; }
#pragma unroll
            for (int s = 0; s < 17; ++s) RED[(kg * 17 + s) * 48 + col] = acc[s];
        }
        __syncthreads();
        for (int i = t.tid; i < 17 * 48; i += 512) { const int s = i / 48, cc = i % 48; float sum = 0.f;
#pragma unroll
            for (int g = 0; g < 10; ++g) sum += RED[(g * 17 + s) * 48 + cc];
            MOD[((size_t)l * 17 + s) * 6144 + j0 + cc] = sum + a->in[I_ADAB][l * 6144 + j0 + cc]; }
        __syncthreads();
    }
    LAS unsigned short* T = (LAS unsigned short*)(lds + 73728) + t.wv * (64 * 72);
    T = (LAS unsigned short*)(lds) + t.wv * (64 * 72);
    const int gw = t.bid * 8 + t.wv, nw = t.G * 8;
    for (int l = 0; l < 2; ++l) {
        cvt_matrix(a->in[I_WIN] + (size_t)l * 1024 * NIN, 1024, NIN, (bf16_t*)(a->ws + WS_WIN) + (size_t)l * NZ * 1024, 1024, 1, T, gw, nw, t.lane);
        cvt_matrix(a->in[I_WBA] + (size_t)l * 1024 * 1024, 1024, 1024, (bf16_t*)(a->ws + WS_WA) + (size_t)l * 1024 * 1024, 1024, 0, T, gw, nw, t.lane);
        cvt_matrix(a->in[I_WBB] + (size_t)l * 1024 * 1024, 1024, 1024, (bf16_t*)(a->ws + WS_WB) + (size_t)l * 1024 * 1024, 1024, 0, T, gw, nw, t.lane);
        cvt_matrix(a->in[I_WOUT] + (size_t)l * 1024 * 1024, 1024, 1024, (bf16_t*)(a->ws + WS_WO) + (size_t)l * 1024 * 1024, 1024, 0, T, gw, nw, t.lane);
        cvt_matrix(a->in[I_G2] + (size_t)l * 128 * 1024, 128, 1024, (bf16_t*)(a->ws + WS_G2) + (size_t)l * 1024 * 256, 256, 0, T, gw, nw, t.lane);
    }
    const int gt = t.bid * 512 + t.tid, nt = t.G * 512;
    for (int i = gt; i < 2 * 128 * 1024 / 8; i += nt) {
        const int l = i / (128 * 1024 / 8), r = i % (128 * 1024 / 8);
        *(u32x4*)((bf16_t*)(a->ws + WS_WIN) + ((size_t)l * NZ + NRW) * 1024 + (size_t)r * 8) = (u32x4){0u, 0u, 0u, 0u};
    }
    for (int i = gt; i < 2 * 1024 * 128 / 8; i += nt) {
        const int row = i / 16, c8 = i % 16;
        *(u32x4*)((bf16_t*)(a->ws + WS_G2) + (size_t)row * 256 + 128 + c8 * 8) = (u32x4){0u, 0u, 0u, 0u};
    }
    for (int i = gt; i < 2 * 8 * 128 * 128 / 4; i += nt) {
        const f32x4 v = *(const f32x4*)(a->in[I_SGUW] + (size_t)i * 4);
        *(u32x2*)((bf16_t*)(a->ws + WS_WSG) + (size_t)i * 4) = (u32x2){cvt_pk_bf16(v[0], v[1]), cvt_pk_bf16(v[2], v[3])};
    }
}

__device__ __forceinline__ void ln_rows(float (&v)[16]) {
    float s = 0.f;
#pragma unroll
    for (int i = 0; i < 16; ++i) s += v[i];
    const float mean = wave_sum(s) * (1.0f / 1024.0f);
    float q = 0.f;
#pragma unroll
    for (int i = 0; i < 16; ++i) { v[i] -= mean; q += v[i] * v[i]; }
    const float rstd = rsqrtf(wave_sum(q) * (1.0f / 1024.0f) + LN_EPS);
#pragma unroll
    for (int i = 0; i < 16; ++i) v[i] *= rstd;
}
__device__ __forceinline__ void load_row16(const float* p, int lane, float (&v)[16]) {
#pragma unroll
    for (int i = 0; i < 4; ++i) { const f32x4 x = *(const f32x4*)(p + i * 256 + lane * 4); v[4 * i] = x[0]; v[4 * i + 1] = x[1]; v[4 * i + 2] = x[2]; v[4 * i + 3] = x[3]; }
}
__device__ __forceinline__ void store_row16(float* p, int lane, const float (&v)[16]) {
#pragma unroll
    for (int i = 0; i < 4; ++i) *(f32x4*)(p + i * 256 + lane * 4) = (f32x4){v[4 * i], v[4 * i + 1], v[4 * i + 2], v[4 * i + 3]};
}
__device__ __forceinline__ void store_row16_bf16(bf16_t* p, int lane, const float (&v)[16]) {
#pragma unroll
    for (int i = 0; i < 4; ++i) *(u32x2*)(p + i * 256 + lane * 4) = (u32x2){cvt_pk_bf16(v[4 * i], v[4 * i + 1]), cvt_pk_bf16(v[4 * i + 2], v[4 * i + 3])};
}
__device__ __forceinline__ void modulate16(float (&v)[16], const float* sh, const float* sc, int lane) {
#pragma unroll
    for (int i = 0; i < 4; ++i) { const f32x4 a = *(const f32x4*)(sc + i * 256 + lane * 4), b = *(const f32x4*)(sh + i * 256 + lane * 4);
#pragma unroll
        for (int j = 0; j < 4; ++j) v[4 * i + j] = v[4 * i + j] * (1.0f + a[j]) + b[j]; }
}
__device__ __forceinline__ void affine16(float (&v)[16], const float* g, const float* b, int lane) {
#pragma unroll
    for (int i = 0; i < 4; ++i) { const f32x4 a = *(const f32x4*)(g + i * 256 + lane * 4), c = *(const f32x4*)(b + i * 256 + lane * 4);
#pragma unroll
        for (int j = 0; j < 4; ++j) v[4 * i + j] = v[4 * i + j] * a[j] + c[j]; }
}

__device__ __forceinline__ void ph_lnmod0(KArgP a, const Th& t) {
    const float* MOD = (const float*)(a->ws + WS_MOD);
    bf16_t* H = (bf16_t*)(a->ws + WS_S);
    for (int m = t.bid * 8 + t.wv; m < MALL; m += t.G * 8) {
        const int s = m < MLAT ? (m >> 11) : 16;
        const float* xp = m < MLAT ? a->in[I_X] + (size_t)m * 1024 : a->in[I_CTX] + (size_t)(m - MLAT) * 1024;
        float v[16]; load_row16(xp, t.lane, v); ln_rows(v);
        modulate16(v, MOD + (size_t)s * 6144, MOD + (size_t)s * 6144 + 1024, t.lane);
        store_row16_bf16(H + (size_t)m * 1024, t.lane, v);
    }
}

__device__ __forceinline__ void ph_sgu(KArgP a, int l, LAS unsigned char* lds, const Th& t) {
    LAS float* ST = (LAS float*)lds;
    LAS unsigned short* VT = (LAS unsigned short*)(lds + 1024);
    const bf16_t* Zs = (const bf16_t*)(a->ws + WS_ZS);
    bf16_t* YS = (bf16_t*)(a->ws + WS_S);
    const bf16_t* WSG = (const bf16_t*)(a->ws + WS_WSG);
    const float* lng = a->in[I_SLNG] + l * 1024; const float* lnb = a->in[I_SLNB] + l * 1024;
    const int nunits = (l == 0 ? 288 : 256) * 8;
    const int fr = t.lane & 15, fq = t.lane >> 4;
    for (int unit = t.bid; unit < nunits; unit += t.G) {
        const int ck = unit >> 3, g = unit & 7, m0 = ck * 128;
        {
            const int row = t.tid >> 2, part = t.tid & 3;
            const u32x4* p = (const u32x4*)(Zs + (size_t)(m0 + row) * 2048 + 1024 + part * 256);
            float s = 0.f, ss = 0.f;
#pragma unroll 8
            for (int j = 0; j < 32; ++j) { const u32x4 w = p[j];
                const float x0 = bflo(w.x), x1 = bfhi(w.x), x2 = bflo(w.y), x3 = bfhi(w.y), x4 = bflo(w.z), x5 = bfhi(w.z), x6 = bflo(w.w), x7 = bfhi(w.w);
                s += ((x0 + x1) + (x2 + x3)) + ((x4 + x5) + (x6 + x7));
                ss += ((x0 * x0 + x1 * x1) + (x2 * x2 + x3 * x3)) + ((x4 * x4 + x5 * x5) + (x6 * x6 + x7 * x7)); }
            s = quad_sum(s); ss = quad_sum(ss);
            if (part == 0) { const float mean = s * (1.0f / 1024.0f); const float var = fmaxf(ss * (1.0f / 1024.0f) - mean * mean, 0.f); ST[row * 2] = mean; ST[row * 2 + 1] = rsqrtf(var + LN_EPS); }
        }
        __syncthreads();
        {
            const int q = t.tid >> 2, seg = t.tid & 3; const float mean = ST[q * 2], rstd = ST[q * 2 + 1];
            const u32x4* p = (const u32x4*)(Zs + (size_t)(m0 + q) * 2048 + 1024 + 128 * g + 32 * seg);
#pragma unroll
            for (int j = 0; j < 4; ++j) { const u32x4 w = p[j]; const int c0 = 32 * seg + 8 * j; const int ch = 128 * g + c0;
                const f32x4 g0 = *(const f32x4*)(lng + ch), g1 = *(const f32x4*)(lng + ch + 4), b0 = *(const f32x4*)(lnb + ch), b1 = *(const f32x4*)(lnb + ch + 4);
                VT[(c0 + 0) * 136 + q] = f2bf((bflo(w.x) - mean) * rstd * g0[0] + b0[0]); VT[(c0 + 1) * 136 + q] = f2bf((bfhi(w.x) - mean) * rstd * g0[1] + b0[1]);
                VT[(c0 + 2) * 136 + q] = f2bf((bflo(w.y) - mean) * rstd * g0[2] + b0[2]); VT[(c0 + 3) * 136 + q] = f2bf((bfhi(w.y) - mean) * rstd * g0[3] + b0[3]);
                VT[(c0 + 4) * 136 + q] = f2bf((bflo(w.z) - mean) * rstd * g1[0] + b1[0]); VT[(c0 + 5) * 136 + q] = f2bf((bfhi(w.z) - mean) * rstd * g1[1] + b1[1]);
                VT[(c0 + 6) * 136 + q] = f2bf((bflo(w.w) - mean) * rstd * g1[2] + b1[2]); VT[(c0 + 7) * 136 + q] = f2bf((bfhi(w.w) - mean) * rstd * g1[3] + b1[3]); }
        }
        __syncthreads();
        {
            const int ct0 = 2 * (t.wv & 3), pt0 = 4 * (t.wv >> 2);
            const bf16_t* Wg = WSG + (size_t)((l * 8 + g) * 128) * 128;
            f32x4 acc[2][4];
#pragma unroll
            for (int i = 0; i < 2; ++i)
#pragma unroll
                for (int j = 0; j < 4; ++j) acc[i][j] = (f32x4){0.f, 0.f, 0.f, 0.f};
#pragma unroll
            for (int ks = 0; ks < 4; ++ks) {
                bf16x8 af[2], bfr[4];
#pragma unroll
                for (int i = 0; i < 2; ++i) af[i] = *(const LAS bf16x8*)(VT + (16 * (ct0 + i) + fr) * 136 + 32 * ks + 8 * fq);
#pragma unroll
                for (int j = 0; j < 4; ++j) bfr[j] = *(const bf16x8*)(Wg + (size_t)(16 * (pt0 + j) + fr) * 128 + 32 * ks + 8 * fq);
#pragma unroll
                for (int i = 0; i < 2; ++i)
#pragma unroll
                    for (int j = 0; j < 4; ++j) acc[i][j] = __builtin_amdgcn_mfma_f32_16x16x32_bf16(af[i], bfr[j], acc[i][j], 0, 0, 0);
            }
#pragma unroll
            for (int j = 0; j < 4; ++j) { const int p = 16 * (pt0 + j) + fr; const float bias = a->in[I_SGUB][(l * 8 + g) * 128 + p]; const size_t m = (size_t)(m0 + p);
#pragma unroll
                for (int i = 0; i < 2; ++i) { const int c0 = 16 * (ct0 + i) + 4 * fq;
                    const u32x2 uu = *(const u32x2*)(Zs + m * 2048 + 128 * g + c0);
                    const f32x4 r = acc[i][j];
                    *(u32x2*)(YS + m * 1024 + 128 * g + c0) = (u32x2){cvt_pk_bf16(bflo(uu.x) * (r[0] + bias), bfhi(uu.x) * (r[1] + bias)), cvt_pk_bf16(bflo(uu.y) * (r[2] + bias), bfhi(uu.y) * (r[3] + bias))}; } }
        }
        __syncthreads();
    }
}

__device__ __forceinline__ void ph_scan(KArgP a, int l, LAS unsigned char* lds, const Th& t) {
    LAS float* OPS = (LAS float*)lds;
    LAS float* W2L = (LAS float*)(lds + 49152);
    LAS float* A2L = (LAS float*)(lds + 81920);
    LAS float* TDL = (LAS float*)(lds + 114688);
    LAS float* YL = (LAS float*)(lds + 131072);
    const bf16_t* Zr = (const bf16_t*)(a->ws + WS_ZR);
    bf16_t* Yf = (bf16_t*)(a->ws + WS_Y); bf16_t* Yb = Yf + (size_t)MALL * 1024;
    float* BON = (float*)(a->ws + WS_BON);
    const float* scw = a->in[I_SHIFT] + (size_t)l * 3 * NRW;
    const int lane = t.lane, wv = t.wv, dir = wv >> 2, wq = wv & 3;
    for (int unit = t.bid; unit < 256; unit += t.G) {
        const int b = unit >> 4, h = unit & 15;
        __syncthreads();
        for (int idx = t.tid; idx < 8192; idx += 512) { const int d_ = idx >> 12, i = (idx >> 6) & 63, c = idx & 63; const size_t o = ((size_t)(l * 2 + d_) * 64 + i) * 1024 + 64 * h + c;
            W2L[idx] = a->in[I_W2][o]; A2L[idx] = a->in[I_A2][o]; }
        const int ch = 64 * h + lane;
        const float w0v = a->in[I_W0][(l * 2 + dir) * 1024 + ch], a0v = a->in[I_A0][(l * 2 + dir) * 1024 + ch];
        const float kkv = a->in[I_KK][l * 1024 + ch], kav = a->in[I_KA][l * 1024 + ch], rkv = a->in[I_RK][l * 1024 + ch];
        float swr[3], swk[3], swv[3], swd[3], swa[3];
#pragma unroll
        for (int j = 0; j < 3; ++j) { swr[j] = scw[j * NRW + ch]; swk[j] = scw[j * NRW + 1024 + ch]; swv[j] = scw[j * NRW + 2048 + ch];
            swd[j] = scw[j * NRW + 3072 + 64 * dir + lane]; swa[j] = scw[j * NRW + 3200 + 64 * dir + lane]; }
        float S[2][8];
#pragma unroll
        for (int r = 0; r < 2; ++r)
#pragma unroll
            for (int k = 0; k < 8; ++k) S[r][k] = 0.f;
        const int rp = lane >> 3, cg = lane & 7;
        __syncthreads();
        for (int blk = 0; blk < 144; ++blk) {
            const bool isctx = blk < 16; const int jj = isctx ? blk : blk - 16; const int Tseq = isctx ? TC : TL;
            const int mbase = isctx ? (MLAT + b * TC) : b * TL;
            float rr[4], kx[4], vx[4], lw[4], la[4];
#pragma unroll
            for (int q = 0; q < 4; ++q) {
                const int s = 4 * wq + q; const int tl = dir == 0 ? 16 * jj + s : Tseq - 1 - (16 * jj + s);
                const bf16_t* z0 = Zr + (size_t)(mbase + tl) * ZR_LD;
                float r_ = 0.f, k_ = 0.f, v_ = 0.f, dw_ = 0.f, da_ = 0.f;
#pragma unroll
                for (int j = 0; j < 3; ++j) { const int tt = tl + j - 1;
                    if (tt >= 0 && tt < Tseq) { const bf16_t* zz = z0 + (j - 1) * ZR_LD;
                        r_ += swr[j] * bf2f(zz[ch]); k_ += swk[j] * bf2f(zz[1024 + ch]); v_ += swv[j] * bf2f(zz[2048 + ch]);
                        dw_ += swd[j] * bf2f(zz[3072 + 64 * dir + lane]); da_ += swa[j] * bf2f(zz[3200 + 64 * dir + lane]); } }
                rr[q] = r_; kx[q] = k_; vx[q] = v_; lw[q] = 0.f; la[q] = 0.f;
                TDL[wv * 512 + lane * 4 + q] = fast_tanh(dw_); TDL[wv * 512 + 256 + lane * 4 + q] = da_;
            }
            wave_lds_fence();
#pragma unroll 8
            for (int i = 0; i < 64; ++i) { const float w2v = W2L[dir * 4096 + i * 64 + lane], a2v = A2L[dir * 4096 + i * 64 + lane];
                const f32x4 td = *(const LAS f32x4*)(TDL + wv * 512 + i * 4), dd = *(const LAS f32x4*)(TDL + wv * 512 + 256 + i * 4);
#pragma unroll
                for (int q = 0; q < 4; ++q) { lw[q] += td[q] * w2v; la[q] += dd[q] * a2v; } }
#pragma unroll
            for (int q = 0; q < 4; ++q) {
                const int s = 4 * wq + q; const int tl = dir == 0 ? 16 * jj + s : Tseq - 1 - (16 * jj + s);
                const float wlog = -softplus_f(-(w0v + lw[q])) - 0.5f; const float dcy = fast_exp(-fast_exp(wlog));
                const float av = fast_sigmoid(a0v + la[q]);
                const float kraw = kx[q] * kkv; const float ssq = wave_sum(kraw * kraw); const float kap = kraw * rsqrtf(fmaxf(ssq, 1e-12f));
                const float kd = kx[q] * (1.0f + (av - 1.0f) * kav);
                LAS float* o = OPS + ((dir * 16 + s) * 6) * 64 + lane;
                o[0] = kap; o[64] = dcy; o[128] = kap * av; o[192] = kd; o[256] = rr[q]; o[320] = vx[q];
                if (dir == 0) { const float bs = wave_sum(rr[q] * kd * rkv); if (lane == 0) BON[(size_t)(mbase + tl) * 16 + h] = bs; }
            }
            __syncthreads();
#pragma unroll 2
            for (int s = 0; s < 16; ++s) {
                const LAS float* o = OPS + ((dir * 16 + s) * 6) * 64 + 8 * cg;
                const f32x4 ka0 = *(const LAS f32x4*)(o), ka1 = *(const LAS f32x4*)(o + 4);
                const f32x4 d0 = *(const LAS f32x4*)(o + 64), d1 = *(const LAS f32x4*)(o + 68);
                const f32x4 b0 = *(const LAS f32x4*)(o + 128), b1 = *(const LAS f32x4*)(o + 132);
                const f32x4 k0 = *(const LAS f32x4*)(o + 192), k1 = *(const LAS f32x4*)(o + 196);
                const f32x4 r0 = *(const LAS f32x4*)(o + 256), r1 = *(const LAS f32x4*)(o + 260);
                const f32x2 v2 = *(const LAS f32x2*)(OPS + ((dir * 16 + s) * 6 + 5) * 64 + 16 * wq + 2 * rp);
                float u[2], y[2];
#pragma unroll
                for (int r = 0; r < 2; ++r) {
                    float us = 0.f, ys = 0.f;
#pragma unroll
                    for (int k = 0; k < 4; ++k) { us += S[r][k] * ka0[k] + S[r][4 + k] * ka1[k]; ys += S[r][k] * r0[k] + S[r][4 + k] * r1[k]; }
                    u[r] = oct_sum(us); y[r] = ys;
                }
#pragma unroll
                for (int r = 0; r < 2; ++r) {
                    const float vr = r == 0 ? v2.x : v2.y;
#pragma unroll
                    for (int k = 0; k < 4; ++k) { S[r][k] = S[r][k] * d0[k] - u[r] * b0[k] + vr * k0[k]; S[r][4 + k] = S[r][4 + k] * d1[k] - u[r] * b1[k] + vr * k1[k]; }
                }
                if (dir == 0) {
#pragma unroll
                    for (int r = 0; r < 2; ++r) { float ys = 0.f;
#pragma unroll
                        for (int k = 0; k < 4; ++k) ys += S[r][k] * r0[k] + S[r][4 + k] * r1[k];
                        y[r] = ys; }
                }
                y[0] = oct_sum(y[0]); y[1] = oct_sum(y[1]);
                if (cg == 0) *(LAS f32x2*)(YL + (dir * 16 + s) * 64 + 16 * wq + 2 * rp) = (f32x2){y[0], y[1]};
            }
            __syncthreads();
            for (int idx = t.tid; idx < 2048; idx += 512) { const int d_ = idx >> 10, s = (idx >> 6) & 15, c = idx & 63;
                const int tl = d_ == 0 ? 16 * jj + s : Tseq - 1 - (16 * jj + s);
                (d_ ? Yb : Yf)[(size_t)(mbase + tl) * 1024 + 64 * h + c] = f2bf(YL[idx]); }
        }
    }
}

__device__ __forceinline__ void ph_readout(KArgP a, int l, const Th& t) {
    const bf16_t* Zr = (const bf16_t*)(a->ws + WS_ZR);
    bf16_t* Yf = (bf16_t*)(a->ws + WS_Y); const bf16_t* Yb = Yf + (size_t)MALL * 1024;
    const float* BON = (const float*)(a->ws + WS_BON);
    bf16_t* AG = (bf16_t*)(a->ws + WS_AG);
    const float* scw = a->in[I_SHIFT] + (size_t)l * 3 * NRW;
    const float* lg = a->in[I_LNXG] + l * 1024; const float* lb = a->in[I_LNXB] + l * 1024;
    const int Mrows = l == 0 ? MALL : MLAT;
    const int lane = t.lane, ch0 = lane * 16, head = lane >> 2;
    for (int m = t.bid * 8 + t.wv; m < Mrows; m += t.G * 8) {
        const bool isctx = m >= MLAT; const int tl = isctx ? ((m - MLAT) & (TC - 1)) : (m & (TL - 1)); const int Tseq = isctx ? TC : TL;
        float y[16], v[16];
        {
            const u32x4 f0 = *(const u32x4*)(Yf + (size_t)m * 1024 + ch0), f1 = *(const u32x4*)(Yf + (size_t)m * 1024 + ch0 + 8);
            const u32x4 g0 = *(const u32x4*)(Yb + (size_t)m * 1024 + ch0), g1 = *(const u32x4*)(Yb + (size_t)m * 1024 + ch0 + 8);
            y[0] = bflo(f0.x) + bflo(g0.x); y[1] = bfhi(f0.x) + bfhi(g0.x); y[2] = bflo(f0.y) + bflo(g0.y); y[3] = bfhi(f0.y) + bfhi(g0.y);
            y[4] = bflo(f0.z) + bflo(g0.z); y[5] = bfhi(f0.z) + bfhi(g0.z); y[6] = bflo(f0.w) + bflo(g0.w); y[7] = bfhi(f0.w) + bfhi(g0.w);
            y[8] = bflo(f1.x) + bflo(g1.x); y[9] = bfhi(f1.x) + bfhi(g1.x); y[10] = bflo(f1.y) + bflo(g1.y); y[11] = bfhi(f1.y) + bfhi(g1.y);
            y[12] = bflo(f1.z) + bflo(g1.z); y[13] = bfhi(f1.z) + bfhi(g1.z); y[14] = bflo(f1.w) + bflo(g1.w); y[15] = bfhi(f1.w) + bfhi(g1.w);
        }
        float s = 0.f;
#pragma unroll
        for (int i = 0; i < 16; ++i) s += y[i];
        const float mean = quad_sum(s) * (1.0f / 64.0f);
        float q = 0.f;
#pragma unroll
        for (int i = 0; i < 16; ++i) { y[i] -= mean; q += y[i] * y[i]; }
        const float rstd = rsqrtf(quad_sum(q) * (1.0f / 64.0f) + GN_EPS);
#pragma unroll
        for (int i = 0; i < 16; ++i) v[i] = 0.f;
#pragma unroll
        for (int j = 0; j < 3; ++j) { const int tt = tl + j - 1;
            if (tt >= 0 && tt < Tseq) { const bf16_t* zz = Zr + (size_t)(m + j - 1) * ZR_LD + 2048 + ch0; const float* sw = scw + j * NRW + 2048 + ch0;
                const u32x4 z0 = *(const u32x4*)zz, z1 = *(const u32x4*)(zz + 8);
                const f32x4 s0 = *(const f32x4*)sw, s1 = *(const f32x4*)(sw + 4), s2 = *(const f32x4*)(sw + 8), s3 = *(const f32x4*)(sw + 12);
                v[0] += s0[0] * bflo(z0.x); v[1] += s0[1] * bfhi(z0.x); v[2] += s0[2] * bflo(z0.y); v[3] += s0[3] * bfhi(z0.y);
                v[4] += s1[0] * bflo(z0.z); v[5] += s1[1] * bfhi(z0.z); v[6] += s1[2] * bflo(z0.w); v[7] += s1[3] * bfhi(z0.w);
                v[8] += s2[0] * bflo(z1.x); v[9] += s2[1] * bfhi(z1.x); v[10] += s2[2] * bflo(z1.y); v[11] += s2[3] * bfhi(z1.y);
                v[12] += s3[0] * bflo(z1.z); v[13] += s3[1] * bfhi(z1.z); v[14] += s3[2] * bflo(z1.w); v[15] += s3[3] * bfhi(z1.w); } }
        const float bon = BON[(size_t)m * 16 + head];
        float o[16];
#pragma unroll
        for (int i = 0; i < 16; ++i) o[i] = y[i] * rstd * lg[ch0 + i] + lb[ch0 + i] + bon * v[i];
        *(u32x4*)(Yf + (size_t)m * 1024 + ch0) = (u32x4){cvt_pk_bf16(o[0], o[1]), cvt_pk_bf16(o[2], o[3]), cvt_pk_bf16(o[4], o[5]), cvt_pk_bf16(o[6], o[7])};
        *(u32x4*)(Yf + (size_t)m * 1024 + ch0 + 8) = (u32x4){cvt_pk_bf16(o[8], o[9]), cvt_pk_bf16(o[10], o[11]), cvt_pk_bf16(o[12], o[13]), cvt_pk_bf16(o[14], o[15])};
        if (lane < 32) {
            float gsum[4] = {0.f, 0.f, 0.f, 0.f};
#pragma unroll
            for (int j = 0; j < 3; ++j) { const int tt = tl + j - 1;
                if (tt >= 0 && tt < Tseq) { const u32x2 z = *(const u32x2*)(Zr + (size_t)(m + j - 1) * ZR_LD + 3328 + 4 * lane); const float* sw = scw + j * NRW + 3328 + 4 * lane;
                    gsum[0] += sw[0] * bflo(z.x); gsum[1] += sw[1] * bfhi(z.x); gsum[2] += sw[2] * bflo(z.y); gsum[3] += sw[3] * bfhi(z.y); } }
            *(u32x2*)(AG + (size_t)m * 256 + 4 * lane) = (u32x2){cvt_pk_bf16(fast_sigmoid(gsum[0]), fast_sigmoid(gsum[1])), cvt_pk_bf16(fast_sigmoid(gsum[2]), fast_sigmoid(gsum[3]))};
        } else {
            *(u32x2*)(AG + (size_t)m * 256 + 128 + 4 * (lane - 32)) = (u32x2){0u, 0u};
        }
    }
}

__device__ __forceinline__ void ph_ln1(KArgP a, int l, LAS unsigned char* lds, const Th& t) {
    LAS float* RWL = (LAS float*)lds;
    const float* rw = a->in[I_ROUTER] + (size_t)l * 1024 * 16;
    for (int i = t.tid; i < 16384; i += 512) { const int c = i >> 4, e = i & 15; RWL[e * 1024 + c] = rw[i]; }
    __syncthreads();
    const float* MOD = (const float*)(a->ws + WS_MOD) + (size_t)l * 17 * 6144;
    float* CXM = (float*)(a->ws + WS_CXM);
    bf16_t* H2 = (bf16_t*)(a->ws + WS_S);
    float* AFF = (float*)(a->ws + WS_AFF);
    const float* g1 = a->in[I_LN1G] + l * 1024; const float* b1 = a->in[I_LN1B] + l * 1024;
    const int Mrows = l == 0 ? MALL : MLAT;
    const int lane = t.lane;
    for (int m = t.bid * 8 + t.wv; m < Mrows; m += t.G * 8) {
        const int s = m < MLAT ? (m >> 11) : 16;
        float* xp = m < MLAT ? a->out + (size_t)m * 1024 : CXM + (size_t)(m - MLAT) * 1024;
        float v[16]; load_row16(xp, lane, v); ln_rows(v); affine16(v, g1, b1, lane);
        store_row16(xp, lane, v);
        ln_rows(v); modulate16(v, MOD + (size_t)s * 6144 + 3072, MOD + (size_t)s * 6144 + 4096, lane);
        store_row16_bf16(H2 + (size_t)m * 1024, lane, v);
        float mylg = -3.0e38f;
#pragma unroll 1
        for (int e = 0; e < 16; ++e) { float p = 0.f;
#pragma unroll
            for (int i = 0; i < 4; ++i) { const f32x4 w = *(const LAS f32x4*)(RWL + e * 1024 + i * 256 + lane * 4); p += (v[4 * i] * w[0] + v[4 * i + 1] * w[1]) + (v[4 * i + 2] * w[2] + v[4 * i + 3] * w[3]); }
            p = wave_sum(p); mylg = (lane == e) ? p : mylg; }
        float mx = mylg;
#pragma unroll
        for (int o = 8; o > 0; o >>= 1) mx = fmaxf(mx, __shfl_xor(mx, o));
        const float ex = (lane < 16) ? __expf(mylg - mx) : 0.f;
        float den = ex;
#pragma unroll
        for (int o = 8; o > 0; o >>= 1) den += __shfl_xor(den, o);
        if (lane < 16) AFF[(size_t)m * 16 + lane] = ex / den;
    }
}

__device__ __forceinline__ void ph_select(KArgP a, int l, const Th& t) {
    const float* AFF = (const float*)(a->ws + WS_AFF);
    int* INV = (int*)(a->ws + WS_INV); int* SELT = (int*)(a->ws + WS_SELT); float* SELG = (float*)(a->ws + WS_SELG);
    const int RPE = l == 0 ? 4608 : 4096;
    const int nunits = l == 0 ? 512 : 256;
    const int lane = t.lane;
    const unsigned long long lt_mask = (lane == 0) ? 0ull : (~0ull >> (64 - lane));
    for (int unit = t.bid * 8 + t.wv; unit < nunits; unit += t.G * 8) {
        const int set = unit >> 4, e = unit & 15;
        const bool isctx = set >= 16; const int Tseq = isctx ? TC : TL, C = isctx ? 32 : 256, nj = Tseq >> 6;
        const int mbase = isctx ? MLAT + (set - 16) * TC : set * TL;
        const int rbase = e * RPE + (isctx ? 4096 + (set - 16) * 32 : set * 256);
        unsigned val[32];
#pragma unroll
        for (int j = 0; j < 32; ++j) val[j] = (j < nj) ? __float_as_uint(AFF[(size_t)(mbase + j * 64 + lane) * 16 + e]) : 0u;
        unsigned thr = 0u;
        for (int bit = 30; bit >= 0; --bit) {
            const unsigned cand = thr | (1u << bit);
            int cnt = 0;
#pragma unroll
            for (int j = 0; j < 32; ++j) cnt += (val[j] >= cand) ? 1 : 0;
#pragma unroll
            for (int o = 32; o > 0; o >>= 1) cnt += __shfl_xor(cnt, o);
            if (cnt >= C) thr = cand;
        }
        int ngt = 0;
#pragma unroll
        for (int j = 0; j < 32; ++j) ngt += (val[j] > thr) ? 1 : 0;
#pragma unroll
        for (int o = 32; o > 0; o >>= 1) ngt += __shfl_xor(ngt, o);
        const int need = C - ngt;
        int base = 0, eqseen = 0;
#pragma unroll
        for (int j = 0; j < 32; ++j) {
            if (j < nj) {
                const bool gt = val[j] > thr, eq = val[j] == thr;
                const unsigned long long meq = __ballot(eq);
                const bool take = gt || (eq && (eqseen + __popcll(meq & lt_mask)) < need);
                const unsigned long long mt = __ballot(take);
                const int m = mbase + j * 64 + lane;
                int slot = -1;
                if (take) { slot = rbase + base + __popcll(mt & lt_mask); SELT[slot] = m; SELG[slot] = __uint_as_float(val[j]); }
                INV[(size_t)m * 16 + e] = slot;
                base += __popcll(mt); eqseen += __popcll(meq);
            }
        }
    }
}

__device__ __forceinline__ void ph_gather(KArgP a, int l, const Th& t) {
    const int* SELT = (const int*)(a->ws + WS_SELT);
    const bf16_t* H2 = (const bf16_t*)(a->ws + WS_S); bf16_t* XE = (bf16_t*)(a->ws + WS_XA);
    const int nrows = 16 * (l == 0 ? 4608 : 4096);
    for (int r = t.bid * 8 + t.wv; r < nrows; r += t.G * 8) {
        const int tok = SELT[r];
        const u32x4* src = (const u32x4*)(H2 + (size_t)tok * 1024); u32x4* dst = (u32x4*)(XE + (size_t)r * 1024);
        dst[t.lane] = src[t.lane]; dst[64 + t.lane] = src[64 + t.lane];
    }
}

__device__ __forceinline__ void ph_combine(KArgP a, int l, const Th& t) {
    const int* INV = (const int*)(a->ws + WS_INV); const bf16_t* YE = (const bf16_t*)(a->ws + WS_Y);
    const float* MOD = (const float*)(a->ws + WS_MOD);
    float* CXM = (float*)(a->ws + WS_CXM); float* XA = (float*)(a->ws + WS_XA); bf16_t* H = (bf16_t*)(a->ws + WS_S);
    const float* g2 = a->in[I_LN2G] + l * 1024; const float* b2 = a->in[I_LN2B] + l * 1024;
    const int Mrows = l == 0 ? MALL : MLAT;
    const int lane = t.lane;
    for (int m = t.bid * 8 + t.wv; m < Mrows; m += t.G * 8) {
        const int s = m < MLAT ? (m >> 11) : 16;
        float acc[16];
#pragma unroll
        for (int i = 0; i < 16; ++i) acc[i] = 0.f;
        for (int e = 0; e < 16; ++e) { const int R = __builtin_amdgcn_readfirstlane(INV[(size_t)m * 16 + e]);
            if (R >= 0) { const bf16_t* yr = YE + (size_t)R * 1024;
#pragma unroll
                for (int i = 0; i < 4; ++i) { const u32x2 w = *(const u32x2*)(yr + i * 256 + lane * 4); acc[4 * i] += bflo(w.x); acc[4 * i + 1] += bfhi(w.x); acc[4 * i + 2] += bflo(w.y); acc[4 * i + 3] += bfhi(w.y); } } }
        float* xp = m < MLAT ? a->out + (size_t)m * 1024 : CXM + (size_t)(m - MLAT) * 1024;
        float v[16]; load_row16(xp, lane, v);
        const float* gt2 = MOD + ((size_t)l * 17 + s) * 6144 + 5120;
#pragma unroll
        for (int i = 0; i < 4; ++i) { const f32x4 gg = *(const f32x4*)(gt2 + i * 256 + lane * 4);
#pragma unroll
            for (int j = 0; j < 4; ++j) v[4 * i + j] = ALPHA * v[4 * i + j] + gg[j] * acc[4 * i + j]; }
        ln_rows(v); affine16(v, g2, b2, lane);
        if (l == 0) {
            store_row16(XA + (size_t)m * 1024, lane, v);
            ln_rows(v); modulate16(v, MOD + ((size_t)17 + s) * 6144, MOD + ((size_t)17 + s) * 6144 + 1024, lane);
            store_row16_bf16(H + (size_t)m * 1024, lane, v);
        } else {
            store_row16(a->out + (size_t)m * 1024, lane, v);
        }
    }
}

__device__ __forceinline__ void ph_cvt_experts(KArgP a, int l, LAS unsigned char* lds, const Th& t) {
    LAS unsigned short* T = (LAS unsigned short*)(lds) + t.wv * (64 * 72);
    const int gw = t.bid * 8 + t.wv, nw = t.G * 8;
    bf16_t* WE13 = (bf16_t*)(a->ws + WS_WE13); bf16_t* WE2 = (bf16_t*)(a->ws + WS_WE2);
    for (int tt = gw; tt < 16 * 1536; tt += nw) {
        const int e = tt / 1536, r = tt % 1536, which = r >> 9, ti = r & 511;
        if (which < 2) { const float* src = a->in[which == 0 ? I_EW1 : I_EW3] + ((size_t)(l * 16 + e)) * 1024 * 2048; const int kt = ti >> 5, n0 = (ti & 31) * 64;
            cvt_tile(src, 2048, kt * 64, n0, WE13 + (size_t)e * 4096 * 1024, 1024, cvt_row(2 + which, n0), kt * 64, T, t.lane); }
        else { const float* src = a->in[I_EW2] + ((size_t)(l * 16 + e)) * 2048 * 1024; const int kt = ti >> 4, n0 = (ti & 15) * 64;
            cvt_tile(src, 1024, kt * 64, n0, WE2 + (size_t)e * 1024 * 2048, 2048, n0, kt * 64, T, t.lane); }
    }
}

__global__ void __launch_bounds__(512, 2) mk_fwd(const Args args) {
    extern __shared__ __attribute__((aligned(16))) unsigned char smem[];
    LAS unsigned char* lds = (LAS unsigned char*)smem;
    volatile LAS unsigned* MISC = (volatile LAS unsigned*)(lds + LDS_MISC);
    if (threadIdx.x < 64) MISC[threadIdx.x] = 0u;
#ifdef MK_FENCE
    __builtin_amdgcn_fence(__ATOMIC_ACQUIRE, "agent"); asm volatile("s_waitcnt vmcnt(0)" ::: "memory");
#endif
    __syncthreads();
    const int lo = args.ph_lo, hi = args.ph_hi;
    XcdBarrier bar; bar.bar = nullptr; bar.x = 0; bar.st = MISC + 8;
    if (hi - lo > 1) bar = xcd_barrier_post((unsigned*)(kargs()->ws + WS_CTL) + CW_BAR, MISC + 8);
#define IN(k) (lo <= (k) && (k) < hi)
#define SEAM(k) do { if (IN((k) + 1)) xcd_barrier(bar); } while (0)
    using namespace pg8;
    for (int l = 0; l < 2; ++l) {
        const int P = l * NPH;
        if (l == 0 && IN(P + 0)) { ph_prologue(kargs(), lds, mk_th()); SEAM(P + 0); }
        if (l == 0 && IN(P + 1)) { ph_lnmod0(kargs(), mk_th()); SEAM(P + 1); }
        if (IN(P + 2)) {
            KArgP a = kargs(); const Th t = mk_th(); const int Mrows = l == 0 ? MALL : MLAT;
            bf16_t* const H = (bf16_t*)(a->ws + WS_S); bf16_t* const Zr = (bf16_t*)(a->ws + WS_ZR); bf16_t* const Zs = (bf16_t*)(a->ws + WS_ZS); bf16_t* const Zg = (bf16_t*)(a->ws + WS_ZG);
            const bf16_t* Wt = (const bf16_t*)(a->ws + WS_WIN) + (size_t)l * NZ * 1024;
#ifdef MK_SIMPLE2
            { Gemm g{H, Wt, Mrows, NZ, 1024}; Order S; S.init(Mrows / 256, NZ / 256, t.G, t.bid); EpiZ E{Zr, Zs, Zg, 0}; gemm_simple<EpiZ, Order>(lds, g, S, E); }
#else
            { Gemm g{H, Wt, Mrows, NZ, 1024}; Order S; S.init(Mrows / 256, NZ / 256, t.G, t.bid); EpiZ E{Zr, Zs, Zg, 0}; gemm_phase<EpiZ, Order>(lds, g, S, E); }
#endif
            if (l == 1) { Gemm g{H + (size_t)MLAT * 1024, Wt, MCTX, ZR_LD, 1024}; Order S; S.init(MCTX / 256, ZR_LD / 256, t.G, t.bid); EpiZ E{Zr, Zs, Zg, MLAT}; gemm_phase<EpiZ, Order>(lds, g, S, E); }
            SEAM(P + 2);
        }
        if (IN(P + 3)) { ph_sgu(kargs(), l, lds, mk_th()); ph_scan(kargs(), l, lds, mk_th()); SEAM(P + 3); }
        if (IN(P + 4)) { ph_readout(kargs(), l, mk_th()); SEAM(P + 4); }
        if (IN(P + 5)) {
            KArgP a = kargs(); const Th t = mk_th(); const int Mrows = l == 0 ? MALL : MLAT;
            Gemm g{(const bf16_t*)(a->ws + WS_AG), (const bf16_t*)(a->ws + WS_G2) + (size_t)l * 1024 * 256, Mrows, 1024, opaque_i(256)}; Order S; S.init(Mrows / 256, 4, t.G, t.bid);
            EpiMulInPlace E{(bf16_t*)(a->ws + WS_Y)}; gemm_phase<EpiMulInPlace, Order>(lds, g, S, E);
            SEAM(P + 5);
        }
        if (IN(P + 6)) {
            KArgP a = kargs(); const Th t = mk_th(); const int Mrows = l == 0 ? MALL : MLAT;
            bf16_t* const Yf = (bf16_t*)(a->ws + WS_Y); bf16_t* const Mg = Yf + (size_t)MALL * 1024; const bf16_t* Zg = (const bf16_t*)(a->ws + WS_ZG);
            { Gemm g{Yf, (const bf16_t*)(a->ws + WS_WA) + (size_t)l * 1024 * 1024, Mrows, 1024, 1024}; Order S; S.init(Mrows / 256, 4, t.G, t.bid);
              EpiGate<false> E{Mg, Zg, 0}; gemm_phase<EpiGate<false>, Order>(lds, g, S, E); }
            { Gemm g{(const bf16_t*)(a->ws + WS_S), (const bf16_t*)(a->ws + WS_WB) + (size_t)l * 1024 * 1024, Mrows, 1024, 1024}; Order S; S.init(Mrows / 256, 4, t.G, t.bid);
              EpiGate<true> E{Mg, Zg, 1024}; gemm_phase<EpiGate<true>, Order>(lds, g, S, E); }
            SEAM(P + 6);
        }
        if (IN(P + 7)) {
            ph_cvt_experts(kargs(), l, lds, mk_th());
            __syncthreads();
            KArgP a = kargs(); const Th t = mk_th(); const int Mrows = l == 0 ? MALL : MLAT;
            Gemm g{(const bf16_t*)(a->ws + WS_Y) + (size_t)MALL * 1024, (const bf16_t*)(a->ws + WS_WO) + (size_t)l * 1024 * 1024, Mrows, 1024, 1024}; Order S; S.init(Mrows / 256, 4, t.G, t.bid);
            EpiRes E{l == 0 ? a->in[I_X] : (const float*)(a->ws + WS_XA), l == 0 ? a->in[I_CTX] : (const float*)(a->ws + WS_XA) + (size_t)MLAT * 1024, a->out, (float*)(a->ws + WS_CXM),
                     (const float*)(a->ws + WS_MOD) + (size_t)l * 17 * 6144 + 2048};
            gemm_phase<EpiRes, Order>(lds, g, S, E);
            SEAM(P + 7);
        }
        if (IN(P + 8)) { ph_ln1(kargs(), l, lds, mk_th()); SEAM(P + 8); }
        if (IN(P + 9)) { ph_select(kargs(), l, mk_th()); SEAM(P + 9); }
        if (IN(P + 10)) { ph_gather(kargs(), l, mk_th()); SEAM(P + 10); }
        if (IN(P + 11)) {
            KArgP a = kargs(); const Th t = mk_th(); const int nMe = l == 0 ? 18 : 16;
            Gemm g{(const bf16_t*)(a->ws + WS_XA), (const bf16_t*)(a->ws + WS_WE13), 16 * nMe * 256, 4096, 1024}; Order S; S.init(16 * nMe, 16, t.G, t.bid, nMe);
            EpiSwiGLU E{(bf16_t*)(a->ws + WS_HID)}; gemm_phase<EpiSwiGLU, Order>(lds, g, S, E);
            SEAM(P + 11);
        }
        if (IN(P + 12)) {
            KArgP a = kargs(); const Th t = mk_th(); const int nMe = l == 0 ? 18 : 16;
            Gemm g{(const bf16_t*)(a->ws + WS_HID), (const bf16_t*)(a->ws + WS_WE2), 16 * nMe * 256, 1024, 2048}; Order S; S.init(16 * nMe, 4, t.G, t.bid, nMe);
            EpiScaleRow E{(bf16_t*)(a->ws + WS_Y), (const float*)(a->ws + WS_SELG)}; gemm_phase<EpiScaleRow, Order>(lds, g, S, E);
            SEAM(P + 12);
        }
        if (IN(P + 13)) { ph_combine(kargs(), l, mk_th()); SEAM(P + 13); }
    }
#undef IN
#undef SEAM
#ifdef MK_FENCE
    asm volatile("s_waitcnt vmcnt(0)" ::: "memory"); __builtin_amdgcn_fence(__ATOMIC_RELEASE, "agent"); asm volatile("s_waitcnt vmcnt(0)" ::: "memory");
#endif
}


#ifdef MK_DELAY
__global__ void mk_delay() { const unsigned long long t0 = __builtin_amdgcn_s_memrealtime(); while (__builtin_amdgcn_s_memrealtime() - t0 < 2000000ull) __builtin_amdgcn_s_sleep(32); }
#endif
#ifdef MK_DUMP
__global__ void __launch_bounds__(512) mk_dump(const Args args) {
    const unsigned char* ws = args.ws; float* out = args.out;
    const bf16_t* Zr = (const bf16_t*)(ws + WS_ZR); const bf16_t* Zs = (const bf16_t*)(ws + WS_ZS); const bf16_t* Zg = (const bf16_t*)(ws + WS_ZG);
    const bf16_t* Yf = (const bf16_t*)(ws + WS_Y); const bf16_t* Yb = Yf + (size_t)MALL * 1024; const bf16_t* YS = (const bf16_t*)(ws + WS_S);
    const float* BON = (const float*)(ws + WS_BON); const bf16_t* AG = (const bf16_t*)(ws + WS_AG); const float* MOD = (const float*)(ws + WS_MOD);
    for (size_t i = (size_t)blockIdx.x * 512 + threadIdx.x; i < (size_t)MLAT * 1024; i += (size_t)gridDim.x * 512) {
        const size_t m = i >> 10; const int c = (int)(i & 1023); float v = 0.f;
#if MK_DUMP == 1
        if (MK_DSEL & 1) v += bf2f(Zr[m * ZR_LD + c]);
        if (MK_DSEL & 2) v += bf2f(Zr[m * ZR_LD + 1024 + c]);
        if (MK_DSEL & 4) v += bf2f(Zr[m * ZR_LD + 2048 + c]);
        if (MK_DSEL & 8) v += bf2f(Zr[m * ZR_LD + 2560 + c]);
        if (MK_DSEL & 16) v += bf2f(Zs[m * 2048 + c]);
        if (MK_DSEL & 32) v += bf2f(Zs[m * 2048 + 1024 + c]);
        if (MK_DSEL & 64) v += bf2f(Zg[m * 2048 + c]);
        if (MK_DSEL & 128) v += bf2f(Zg[m * 2048 + 1024 + c]);
#elif MK_DUMP == 2
        v = bf2f(Yf[m * 1024 + c]) + bf2f(Yb[m * 1024 + c]);
#elif MK_DUMP == 3
        v = bf2f(YS[m * 1024 + c]);
#elif MK_DUMP == 4
        v = BON[m * 16 + (c & 15)] + bf2f(AG[m * 256 + (c & 255)]);
#elif MK_DUMP == 5
        v = bf2f(Yb[m * 1024 + c]);
#elif MK_DUMP == 6
        v = bf2f(Yf[m * 1024 + c]);
#elif MK_DUMP == 7
        v = bf2f(YS[m * 1024 + c]) + MOD[(i % (2 * 17 * 6144))];
#elif MK_DUMP == 8
        v = bf2f(((const bf16_t*)(ws + WS_WIN))[i % ((size_t)2 * NZ * 1024)]);
#endif
        out[i] = v;
    }
}
#endif
extern "C" void kernel_launch(void* const* d_in, const int* in_sizes, int n_in, void* d_out, int out_size, void* d_ws, size_t ws_size, hipStream_t stream) {
    static int grid = 0;
    if (grid == 0) {
        if (n_in != 33 || out_size != MLAT * D || ws_size < WS_END) { fprintf(stderr, "kernel_launch: unexpected problem (n_in %d out %d ws %zu)\n", n_in, out_size, ws_size); grid = -1; return; }
        int dev = 0, cus = 0, per_cu = 0;
        if (hipGetDevice(&dev) != hipSuccess || hipDeviceGetAttribute(&cus, hipDeviceAttributeMultiprocessorCount, dev) != hipSuccess) { grid = -1; return; }
        if (hipFuncSetAttribute((const void*)mk_fwd, hipFuncAttributeMaxDynamicSharedMemorySize, LDS_BYTES) != hipSuccess) { fprintf(stderr, "kernel_launch: hipFuncSetAttribute failed\n"); grid = -1; return; }
        if (hipOccupancyMaxActiveBlocksPerMultiprocessor(&per_cu, (const void*)mk_fwd, 512, LDS_BYTES) != hipSuccess || per_cu < 1) { fprintf(stderr, "kernel_launch: occupancy query says %d\n", per_cu); }
        (void)hipGetLastError();
        grid = cus > 0 ? cus : 256;
    }
    if (grid < 0) return;
    (void)hipMemsetAsync((char*)d_ws + WS_CTL, 0, CTL_ZERO_BYTES, stream);
    Args a{};
    for (int i = 0; i < 33; ++i) a.in[i] = (const float*)d_in[i];
    a.out = (float*)d_out; a.ws = (unsigned char*)d_ws;
#if MK_SINGLE
    a.ph_lo = 0; a.ph_hi = 2 * NPH;
    hipLaunchKernelGGL(mk_fwd, dim3(grid), dim3(512), LDS_BYTES, stream, a);
#else
#ifdef MK_DELAY
    hipLaunchKernelGGL(mk_delay, dim3(1), dim3(64), 0, stream);
#endif
    for (int k = 0; k < 2 * NPH; ++k) {
        if (k == NPH + 0 || k == NPH + 1) continue;
        if (k > MK_STOP) break;
        a.ph_lo = k; a.ph_hi = k + 1;
        hipLaunchKernelGGL(mk_fwd, dim3(grid), dim3(512), LDS_BYTES, stream, a);
#ifdef MK_TWICE
        if (k == 2) hipLaunchKernelGGL(mk_fwd, dim3(grid), dim3(512), LDS_BYTES, stream, a);
#endif
    }
#ifdef MK_DUMP
    hipLaunchKernelGGL(mk_dump, dim3(1024), dim3(512), 0, stream, a);
#endif
#endif
}
```

```cpp
#include <hip/hip_runtime.h>
#include <cstdio>
#include <cstdint>

#ifndef MK_TMASK
#define MK_TMASK 0
#endif
#define MK_TAMP 4
#ifndef MK_STOP
#define MK_DSEL 255
#define MK_STOP 99
#endif
#ifndef MK_SINGLE
#define MK_SINGLE 1
#endif

#define GAS __attribute__((address_space(1)))
#define LAS __attribute__((address_space(3)))

typedef unsigned short bf16_t;
typedef short bf16x8 __attribute__((ext_vector_type(8)));
typedef float f32x4 __attribute__((ext_vector_type(4)));
typedef float f32x2 __attribute__((ext_vector_type(2)));
typedef unsigned u32x4 __attribute__((ext_vector_type(4)));
typedef unsigned u32x2 __attribute__((ext_vector_type(2)));

constexpr int D = 1024, NB = 16, TL = 2048, TC = 256;
constexpr int MLAT = NB * TL;
constexpr int MCTX = NB * TC;
constexpr int MALL = MLAT + MCTX;
constexpr int NRW = 3456;
constexpr int NIN = 7552;
constexpr int ZR_LD = 3584;
constexpr int NZ = 7680;
constexpr int NEXP = 16, DFF = 2048;
constexpr float WIN8_SCALE = 32.f;
constexpr float ALPHA = 1.41421356237309515f;
constexpr float LN_EPS = 1e-5f, GN_EPS = 64e-5f;
constexpr int NPH = 14;

constexpr size_t MiB = 1u << 20;
constexpr size_t WS_CTL = 0, CTL_ZERO_BYTES = 1 * MiB;
constexpr size_t WS_MOD = 1 * MiB;
constexpr size_t WS_WIN = 2 * MiB;
constexpr size_t WS_WA = 32 * MiB, WS_WB = 36 * MiB, WS_WO = 40 * MiB;
constexpr size_t WS_G2 = 44 * MiB;
constexpr size_t WS_WSG = 45 * MiB;
constexpr size_t WS_AFF = 46 * MiB;
constexpr size_t WS_INV = 49 * MiB;
constexpr size_t WS_BON = 52 * MiB;
constexpr size_t WS_SELT = 55 * MiB;
constexpr size_t WS_SELG = 55 * MiB + 512 * 1024;
constexpr size_t WS_CXM = 56 * MiB;
constexpr size_t WS_AG = 72 * MiB;
constexpr size_t WS_S = 90 * MiB;
constexpr size_t WS_Y = 162 * MiB;
constexpr size_t WS_XA = 306 * MiB;
constexpr size_t WS_XM = WS_XA + 72 * MiB;
constexpr size_t WS_Z = 450 * MiB;
#ifdef MK_RELOC
constexpr size_t WS_ZS = WS_Z, WS_ZG = WS_ZS + 144 * MiB, WS_ZR = WS_ZG + 144 * MiB;
#else
constexpr size_t WS_ZS = WS_Z + 252 * MiB, WS_ZG = WS_ZS + 144 * MiB, WS_ZR = WS_Z;
#endif
constexpr size_t WS_HID = WS_Z, WS_WE13 = WS_Z + 288 * MiB, WS_WE2 = WS_WE13 + 128 * MiB;
constexpr size_t WS_HQ = 990 * MiB;
constexpr size_t WS_WIN8 = 1026 * MiB;
constexpr size_t WS_END = 1034 * MiB;
static_assert(WS_WE2 + 64 * MiB <= WS_END, "ws map");
constexpr int CW_BAR = 4096;

constexpr int LDS_BYTES = 147456;
constexpr int LDS_MISC = LDS_BYTES - 256;

__device__ __forceinline__ float bf2f(unsigned short b) { return __uint_as_float(((unsigned)b) << 16); }
__device__ __forceinline__ float bflo(unsigned u) { return __uint_as_float(u << 16); }
__device__ __forceinline__ float bfhi(unsigned u) { return __uint_as_float(u & 0xffff0000u); }
typedef __bf16 bf16x2_t __attribute__((ext_vector_type(2)));
__device__ __forceinline__ unsigned cvt_pk_bf16(float lo, float hi) { const f32x2 v = {lo, hi}; const bf16x2_t b = __builtin_convertvector(v, bf16x2_t); return __builtin_bit_cast(unsigned, b); }
__device__ __forceinline__ unsigned short f2bf(float f) { return (unsigned short)(cvt_pk_bf16(f, 0.f) & 0xffffu); }
__device__ __forceinline__ float fast_exp(float x) { return __builtin_amdgcn_exp2f(x * 1.44269504088896341f); }
__device__ __forceinline__ float fast_sigmoid(float x) { return __builtin_amdgcn_rcpf(1.0f + fast_exp(-x)); }
__device__ __forceinline__ float fast_tanh(float x) { const float e = fast_exp(2.0f * x); return 1.0f - 2.0f * __builtin_amdgcn_rcpf(e + 1.0f); }
__device__ __forceinline__ float softplus_f(float x) { return fmaxf(x, 0.f) + __logf(1.0f + fast_exp(-fabsf(x))); }

template <int CTRL> __device__ __forceinline__ float dpp_f(float v) { return __int_as_float(__builtin_amdgcn_update_dpp(0, __float_as_int(v), CTRL, 0xf, 0xf, true)); }
__device__ __forceinline__ float quad_sum(float v) { v += dpp_f<0xB1>(v); v += dpp_f<0x4E>(v); return v; }
__device__ __forceinline__ float oct_sum(float v) { v = quad_sum(v); v += dpp_f<0x141>(v); return v; }
__device__ __forceinline__ float wave_sum(float v) {
    v += dpp_f<0xB1>(v); v += dpp_f<0x4E>(v); v += dpp_f<0x141>(v); v += dpp_f<0x140>(v);
    const int vi = __float_as_int(v);
    const float s0 = __int_as_float(__builtin_amdgcn_readlane(vi, 0)), s1 = __int_as_float(__builtin_amdgcn_readlane(vi, 16)), s2 = __int_as_float(__builtin_amdgcn_readlane(vi, 32)), s3 = __int_as_float(__builtin_amdgcn_readlane(vi, 48));
    return (s0 + s1) + (s2 + s3);
}
__device__ __forceinline__ void lds_barrier() { asm volatile("s_waitcnt lgkmcnt(0)" ::: "memory"); __builtin_amdgcn_s_barrier(); asm volatile("" ::: "memory"); }
__device__ __forceinline__ void wave_lds_fence() { asm volatile("s_waitcnt lgkmcnt(0)" ::: "memory"); __builtin_amdgcn_wave_barrier(); asm volatile("" ::: "memory"); }

__device__ __forceinline__ float clamp_e4m3(float x) { return __builtin_amdgcn_fmed3f(x, -448.0f, 448.0f); }
__device__ __forceinline__ unsigned pk4_fp8(float a, float b, float c, float d) { int p = __builtin_amdgcn_cvt_pk_fp8_f32(clamp_e4m3(a), clamp_e4m3(b), 0, false); p = __builtin_amdgcn_cvt_pk_fp8_f32(clamp_e4m3(c), clamp_e4m3(d), p, true); return (unsigned)p; }
__device__ __forceinline__ f32x2 gelu_pk(f32x2 v) {
    const f32x2 av = __builtin_elementwise_abs(v), d = av * 0.2316418882f + 1.0f;
    f32x2 t; t.x = __builtin_amdgcn_rcpf(d.x); t.y = __builtin_amdgcn_rcpf(d.y);
    f32x2 q = t * 0.5307027145f + (-0.7265760135f); q = q * t + 0.7107068705f; q = q * t + (-0.142248368f); q = q * t + 0.127414796f; q = q * t;
    const f32x2 s = (v * v) * (-0.72134752044f);
    f32x2 e; e.x = __builtin_amdgcn_exp2f(s.x); e.y = __builtin_amdgcn_exp2f(s.y);
    const f32x2 m = v * (q * e), r = v - m;
    f32x2 o; o.x = v.x < 0.f ? m.x : r.x; o.y = v.y < 0.f ? m.y : r.y; return o;
}

#define XB_TMO      128
#define XB_XCNT(j)  (256  + 64 * (j))
#define XB_XSUB(j)  (1280 + 64 * (j))
#define XB_XGEN(j)  (2304 + 64 * (j))
#define XB_TOP      3328
#define XB_TOPGEN   3392
#define XCD_BAR_WORDS 3456
#define XB_SPIN_CAP (1u << 22)
__device__ __forceinline__ unsigned xb_ld(unsigned* p)              { return __hip_atomic_load(p, __ATOMIC_RELAXED, __HIP_MEMORY_SCOPE_AGENT); }
__device__ __forceinline__ unsigned xb_add(unsigned* p, unsigned v) { return __hip_atomic_fetch_add(p, v, __ATOMIC_RELAXED, __HIP_MEMORY_SCOPE_AGENT); }
__device__ __forceinline__ unsigned xb_xcc_id() { return (unsigned)__builtin_amdgcn_s_getreg((3 << 11) | 20) & 0xFu; }
#define XB_SPIN(cond, bar) do { unsigned _sp = 0; while (cond) { __builtin_amdgcn_s_sleep(1); \
    if ((++_sp & 255u) == 0u) { if (xb_ld(&(bar)[XB_TMO])) break; if (_sp > XB_SPIN_CAP) { atomicAdd(&(bar)[XB_TMO], 1u); break; } } } } while (0)
struct XcdBarrier { unsigned* bar; unsigned x; volatile LAS unsigned* st; };
__device__ __forceinline__ XcdBarrier xcd_barrier_post(unsigned* bar, volatile LAS unsigned* st) {
    XcdBarrier b; b.bar = bar; b.x = xb_xcc_id(); b.st = st;
    if (threadIdx.x == 0) (void)xb_add(&bar[XB_XCNT(b.x)], 1u);
    return b;
}
__device__ __forceinline__ void xcd_barrier_complete(unsigned* bar, unsigned x, unsigned& nloc, unsigned& nx) {
    const unsigned G = gridDim.x * gridDim.y * gridDim.z;
    unsigned sum, cnt, mine, sp = 0u;
    for (;;) {
        sum = 0u; cnt = 0u;
#pragma nounroll
        for (unsigned j = 0; j < 16; ++j) { const unsigned c = xb_ld(&bar[XB_XCNT(j)]); sum += c; cnt += (c > 0u) ? 1u : 0u; }
        mine = xb_ld(&bar[XB_XCNT(x)]);
        if (sum == G) break;
        __builtin_amdgcn_s_sleep(1);
        if ((++sp & 255u) == 0u) { if (xb_ld(&bar[XB_TMO])) break; if (sp > XB_SPIN_CAP) { atomicAdd(&bar[XB_TMO], 1u); break; } }
    }
    nloc = mine > 0u ? mine : 1u; nx = cnt > 0u ? cnt : 1u;
}
__device__ __forceinline__ void xcd_barrier(const XcdBarrier& b) {
    asm volatile("s_waitcnt vmcnt(0)" ::: "memory");
    __syncthreads();
    if (threadIdx.x == 0) {
        unsigned* bar = b.bar;
        __builtin_amdgcn_s_waitcnt(0);
        unsigned nloc = b.st[0], nx = b.st[1];
        if (nloc == 0u) { xcd_barrier_complete(bar, b.x, nloc, nx); b.st[0] = nloc; b.st[1] = nx; }
        const unsigned old = xb_add(&bar[XB_XSUB(b.x)], 1u);
        const unsigned gen = old / nloc;
        if (old + 1u == (gen + 1u) * nloc) {
            __builtin_amdgcn_fence(__ATOMIC_RELEASE, "agent");
            asm volatile("s_waitcnt vmcnt(0)" ::: "memory");
            const unsigned og = xb_add(&bar[XB_TOP], 1u);
            const unsigned tg = og / nx;
            if (og + 1u == (tg + 1u) * nx) xb_add(&bar[XB_TOPGEN], 1u);
            else XB_SPIN(xb_ld(&bar[XB_TOPGEN]) == tg, bar);
            __builtin_amdgcn_fence(__ATOMIC_ACQUIRE, "agent");
            xb_add(&bar[XB_XGEN(b.x)], 1u);
            asm volatile("s_waitcnt vmcnt(0)" ::: "memory");
        } else {
            XB_SPIN(xb_ld(&bar[XB_XGEN(b.x)]) == gen, bar);
            __builtin_amdgcn_fence(__ATOMIC_ACQUIRE, "agent");
            asm volatile("s_waitcnt vmcnt(0)" ::: "memory");
        }
    }
    __syncthreads();
}

namespace pg8 {
constexpr int BM = 256, BK = 64, HALF = 128, HTB = HALF * BK * 2, STAGE_BYTES = 8 * HTB, NXCD = 8, WGM = 8;
__host__ __device__ __forceinline__ int lds_byte(int r, int c) { const int st = (r >> 4) * 2 + (c >> 5), rr = r & 15, cc = c & 31, ob = rr * 64 + cc * 2; return st * 1024 + (ob ^ (((ob >> 9) & 1) << 5)); }
__host__ __device__ __forceinline__ void stage_rc(int b, int& R, int& C) { const int st = b / 1024, sb = b % 1024, swz = sb ^ (((sb >> 9) & 1) << 5); R = (st >> 1) * 16 + swz / 64; C = (st & 1) * 32 + (swz % 64) / 2; }
__host__ __device__ __forceinline__ int perm32(int rho) { const int n = rho >> 4, i = rho & 15; return 8 * (i >> 2) + 4 * n + (i & 3); }
struct Unit { int pm, pn; };
struct Gemm { const bf16_t* A; const bf16_t* Bt; int M, N, K; const int* gidx = nullptr; };

struct Order {
    int nM, nN, nwg, G, c, nMe, nNe;
    __device__ void init(int nM_, int nN_, int G_, int c_, int nMe_ = 0) { nM = nM_; nN = nN_; nwg = nM * nN; G = G_; c = c_; nMe = nMe_; nNe = nN_; }
    __device__ bool next(int i, Unit& u) const {
        const long L = (long)i * G + c; if (L >= nwg) return false;
        int wgid = (int)L; { const int q = nwg / NXCD, r = nwg % NXCD, xcd = wgid % NXCD, off = wgid / NXCD; wgid = (xcd < r ? xcd * (q + 1) : r * (q + 1) + (xcd - r) * q) + off; }
        const int nig = WGM * nN, gid = wgid / nig, fm = gid * WGM, gsz = (nM - fm) < WGM ? (nM - fm) : WGM;
        u.pm = fm + ((wgid % nig) % gsz); u.pn = (wgid % nig) / gsz;
        if (nMe > 0) u.pn += (u.pm / nMe) * nNe;
        return true;
    }
    __device__ __forceinline__ void a_ready(const Unit&) const {}
    __device__ __forceinline__ void done(const Unit&) const {}
};

typedef int i32x8 __attribute__((ext_vector_type(8)));
typedef int i32x4 __attribute__((ext_vector_type(4)));
template <class Epi, class Sched, bool FP8 = false, bool GATHER = false, bool ALIGN_EPI = true>
__device__ __forceinline__ void gemm_phase(LAS unsigned char* lds, const Gemm g, const Sched& S, const Epi& E) {
    int tid = threadIdx.x; asm volatile("" : "+v"(tid));
    const int wid = __builtin_amdgcn_readfirstlane(tid >> 6), lane = tid & 63, wr = wid >> 2, wc = wid & 3, fr = lane & 15, fq = lane >> 4;
    const int Kb = FP8 ? g.K : g.K * 2, nt = Kb / 128;
    unsigned voffA[2], voffB[2];
#pragma unroll
    for (int i = 0; i < 2; ++i) { int R, C; stage_rc(tid * 16 + i * 8192, R, C); const int Rb = Epi::PERM ? ((R & ~31) + perm32(R & 31)) : R;
        voffA[i] = (unsigned)(R * Kb + C * 2); voffB[i] = (unsigned)(Rb * Kb + C * 2); }
    unsigned gv[2][2], gn[2][2];
#pragma unroll
    for (int i = 0; i < 2; ++i) { gv[0][i] = gv[1][i] = gn[0][i] = gn[1][i] = 0u; }
#define PG8_GLOAD(dst, pm_) do { if constexpr (GATHER) { int tz_ = threadIdx.x; asm volatile("" : "+v"(tz_)); _Pragma("unroll") for (int i_ = 0; i_ < 2; ++i_) { int R_, C_; stage_rc(tz_ * 16 + i_ * 8192, R_, C_); \
        _Pragma("unroll") for (int h_ = 0; h_ < 2; ++h_) dst[h_][i_] = (unsigned)g.gidx[(pm_) * BM + h_ * HALF + R_] * (unsigned)Kb + (unsigned)(C_ * 2); } } } while (0)
#define PG8_STAGE_A(bufoff, h_, cur_, ko_, nx_) do { if constexpr (GATHER) { if (nx_) PG8_STAGE(bufoff, rsA, (ko_), gn[h_]); else PG8_STAGE(bufoff, rsA, (ko_), gv[h_]); } \
        else PG8_STAGE(bufoff, rsA, (cur_) + (h_) * hstep + (ko_), voffA); } while (0)
    const unsigned kstep = 128u;
    const unsigned hstep = (unsigned)(HALF * Kb);
    const unsigned tstep = 2u * hstep;
    const __amdgpu_buffer_rsrc_t rsA = __builtin_amdgcn_make_buffer_rsrc((void*)g.A, 0, -1, 0x00020000), rsB = __builtin_amdgcn_make_buffer_rsrc((void*)g.Bt, 0, -1, 0x00020000);
    const unsigned ldsw = (unsigned)wid * 1024u;
    const int aoff = lds_byte(wr * 64 + fr, fq * 8), boff = lds_byte(wc * 32 + fr, fq * 8);
#define PG8_SA(b, h) (((b) * 2 + (h)) * HTB)
#define PG8_SB(b, h) ((4 + (b) * 2 + (h)) * HTB)
#define PG8_STAGE(bufoff, rs_, soff, voff) do { _Pragma("unroll") for (int _i = 0; _i < 2; ++_i) \
        __builtin_amdgcn_raw_ptr_buffer_load_lds((rs_), (LAS void*)(lds + (bufoff) + ldsw + _i * 8192), 16, (int)(voff)[_i], (int)(soff), 0, 0); } while (0)
#define PG8_CAT(x0, x1) __builtin_shufflevector(__builtin_bit_cast(i32x4, (x0)), __builtin_bit_cast(i32x4, (x1)), 0, 1, 2, 3, 4, 5, 6, 7)
#define PG8_LDA(dst, b, h) do { _Pragma("unroll") for (int m = 0; m < 4; ++m) { const bf16x8 x0_ = *(const LAS bf16x8*)(lds + PG8_SA(b, h) + aoff + m * 2048), x1_ = *(const LAS bf16x8*)(lds + PG8_SA(b, h) + aoff + m * 2048 + 1024); \
        if constexpr (FP8) dst##8[m] = PG8_CAT(x0_, x1_); else { dst[m][0] = x0_; dst[m][1] = x1_; } } } while (0)
#define PG8_LDB(dst, b, h) do { _Pragma("unroll") for (int n = 0; n < 2; ++n) { const bf16x8 x0_ = *(const LAS bf16x8*)(lds + PG8_SB(b, h) + boff + n * 2048), x1_ = *(const LAS bf16x8*)(lds + PG8_SB(b, h) + boff + n * 2048 + 1024); \
        if constexpr (FP8) dst##8[n] = PG8_CAT(x0_, x1_); else { dst[n][0] = x0_; dst[n][1] = x1_; } } } while (0)
#define PG8_MMA(ai, bj, At, Bt) do { __builtin_amdgcn_s_setprio(1); \
        if constexpr (FP8) { _Pragma("unroll") for (int m = 0; m < 4; ++m) _Pragma("unroll") for (int n = 0; n < 2; ++n) { \
            f32x16& av_ = accv[ai][bj][m >> 1]; constexpr int dummy_ = 0; (void)dummy_; const int e0_ = ((m & 1) * 2 + n) * 4; \
            f32x4 c_ = (f32x4){av_[e0_], av_[e0_ + 1], av_[e0_ + 2], av_[e0_ + 3]}; \
            c_ = __builtin_amdgcn_mfma_scale_f32_16x16x128_f8f6f4(Bt##8[n], At##8[m], c_, 0, 0, 0, 0, 0, 0); \
            av_[e0_] = c_[0]; av_[e0_ + 1] = c_[1]; av_[e0_ + 2] = c_[2]; av_[e0_ + 3] = c_[3]; } } \
        else { _Pragma("unroll") for (int m = 0; m < 4; ++m) _Pragma("unroll") for (int n = 0; n < 2; ++n) _Pragma("unroll") for (int k = 0; k < 2; ++k) \
            acc[ai][bj][m][n] = __builtin_amdgcn_mfma_f32_16x16x32_bf16(Bt[n][k], At[m][k], acc[ai][bj][m][n], 0, 0, 0); } \
        __builtin_amdgcn_s_setprio(0); } while (0)
#ifdef MK_DRAIN
#define PG8_WAIT_V(n) asm volatile("s_waitcnt vmcnt(0)" ::: "memory")
#else
#define PG8_WAIT_V(n) asm volatile("s_waitcnt vmcnt(" #n ")" ::: "memory")
#endif
#define PG8_WAIT_L(n) asm volatile("s_waitcnt lgkmcnt(" #n ")" ::: "memory")
#define PG8_BAR __builtin_amdgcn_s_barrier()
#define PG8_SCHED __builtin_amdgcn_sched_barrier(0)
    Unit cur, nxt; int ui = 0;
    if (!S.next(0, cur)) return;
    f32x4 acc[2][2][4][2];
#pragma unroll
    for (int a = 0; a < 2; ++a)
#pragma unroll
        for (int b = 0; b < 2; ++b)
#pragma unroll
            for (int m = 0; m < 4; ++m)
#pragma unroll
                for (int n = 0; n < 2; ++n) acc[a][b][m][n] = (f32x4){0.f, 0.f, 0.f, 0.f};
    typedef float f32x16 __attribute__((ext_vector_type(16)));
    f32x16 accv[2][2][2];
#pragma unroll
    for (int a = 0; a < 2; ++a)
#pragma unroll
        for (int b = 0; b < 2; ++b)
#pragma unroll
            for (int q = 0; q < 2; ++q)
#pragma unroll
                for (int e = 0; e < 16; ++e) accv[a][b][q][e] = 0.f;
    bf16x8 At[4][2], B0[2][2], B1[2][2]; i32x8 At8[4], B08[2], B18[2];
    unsigned cA = (unsigned)cur.pm * tstep, cB = (unsigned)cur.pn * tstep;
    S.a_ready(cur);
    PG8_GLOAD(gv, cur.pm);
    PG8_STAGE(PG8_SB(0, 0), rsB, cB, voffB); PG8_STAGE(PG8_SB(0, 1), rsB, cB + hstep, voffB); PG8_STAGE_A(PG8_SA(0, 0), 0, cA, 0u, false); PG8_STAGE_A(PG8_SA(0, 1), 1, cA, 0u, false);
    if (wr == 1) PG8_BAR;
    PG8_WAIT_V(2); PG8_BAR;
    PG8_STAGE(PG8_SB(1, 0), rsB, cB + kstep, voffB); PG8_STAGE_A(PG8_SA(1, 0), 0, cA, kstep, false); PG8_STAGE(PG8_SB(1, 1), rsB, cB + hstep + kstep, voffB);
    PG8_WAIT_V(6); PG8_BAR;
    for (;;) {
        const bool has_next = S.next(ui + 1, nxt);
        const unsigned nA = has_next ? (unsigned)nxt.pm * tstep : cA, nB = has_next ? (unsigned)nxt.pn * tstep : cB;
        if constexpr (GATHER) { if (has_next) PG8_GLOAD(gn, nxt.pm); else { _Pragma("unroll") for (int h_ = 0; h_ < 2; ++h_) _Pragma("unroll") for (int i_ = 0; i_ < 2; ++i_) gn[h_][i_] = gv[h_][i_]; } }
        for (int t = 0; t < nt; t += 2) {
            const bool last = (t == nt - 2);
            const unsigned k1 = (unsigned)(t + 1) * kstep, k2 = last ? 0u : (unsigned)(t + 2) * kstep, k3 = k2 + kstep;
            const unsigned aB = last ? nA : cA;
            const unsigned b2 = last ? nB : cB + (unsigned)(t + 2) * kstep, b3 = b2 + kstep;
            if (last && has_next) S.a_ready(nxt);
            PG8_LDB(B0, 0, 0); PG8_LDB(B1, 0, 1); PG8_SCHED; PG8_LDA(At, 0, 0); PG8_STAGE_A(PG8_SA(1, 1), 1, cA, k1, false);
            PG8_WAIT_V(8); PG8_WAIT_L(0); PG8_BAR; PG8_MMA(0, 0, At, B0); PG8_MMA(0, 1, At, B1); PG8_BAR; PG8_SCHED;
            PG8_LDA(At, 0, 1); PG8_STAGE(PG8_SB(0, 0), rsB, b2, voffB); PG8_STAGE(PG8_SB(0, 1), rsB, b2 + hstep, voffB); PG8_STAGE_A(PG8_SA(0, 0), 0, aB, k2, last);
            PG8_WAIT_V(8); PG8_WAIT_L(0); PG8_BAR; PG8_MMA(1, 0, At, B0); PG8_MMA(1, 1, At, B1); PG8_BAR; PG8_SCHED;
            PG8_LDB(B0, 1, 0); PG8_LDB(B1, 1, 1); PG8_SCHED; PG8_LDA(At, 1, 0); PG8_STAGE_A(PG8_SA(0, 1), 1, aB, k2, last);
            PG8_WAIT_V(8); PG8_WAIT_L(0); PG8_BAR; PG8_MMA(0, 0, At, B0); PG8_MMA(0, 1, At, B1); PG8_BAR; PG8_SCHED;
            PG8_LDA(At, 1, 1); PG8_STAGE(PG8_SB(1, 0), rsB, b3, voffB); PG8_STAGE(PG8_SB(1, 1), rsB, b3 + hstep, voffB); PG8_STAGE_A(PG8_SA(1, 0), 0, aB, k3, last);
            PG8_WAIT_V(8); PG8_WAIT_L(0); PG8_BAR; PG8_MMA(1, 0, At, B0); PG8_MMA(1, 1, At, B1); PG8_BAR; PG8_SCHED;
        }
        if constexpr (ALIGN_EPI) { if (wr == 0) PG8_BAR; }
        if constexpr (FP8) {
#pragma unroll
            for (int a_ = 0; a_ < 2; ++a_)
#pragma unroll
                for (int b_ = 0; b_ < 2; ++b_)
#pragma unroll
                    for (int m = 0; m < 4; ++m)
#pragma unroll
                        for (int n = 0; n < 2; ++n) { const f32x16 av_ = accv[a_][b_][m >> 1]; const int e0_ = ((m & 1) * 2 + n) * 4; acc[a_][b_][m][n] = (f32x4){av_[e0_], av_[e0_ + 1], av_[e0_ + 2], av_[e0_ + 3]}; }
        }
        E(acc, cur, wr, wc, fr, fq); S.done(cur);
        if (!has_next) break;
#pragma unroll
        for (int a = 0; a < 2; ++a)
#pragma unroll
            for (int b = 0; b < 2; ++b)
#pragma unroll
                for (int m = 0; m < 4; ++m)
#pragma unroll
                    for (int n = 0; n < 2; ++n) acc[a][b][m][n] = (f32x4){0.f, 0.f, 0.f, 0.f};
#pragma unroll
        for (int a = 0; a < 2; ++a)
#pragma unroll
            for (int b = 0; b < 2; ++b)
#pragma unroll
                for (int q = 0; q < 2; ++q)
#pragma unroll
                    for (int e = 0; e < 16; ++e) accv[a][b][q][e] = 0.f;
        cur = nxt; cA = nA; cB = nB; ++ui;
        if constexpr (GATHER) { _Pragma("unroll") for (int h_ = 0; h_ < 2; ++h_) _Pragma("unroll") for (int i_ = 0; i_ < 2; ++i_) gv[h_][i_] = gn[h_][i_]; }
        if constexpr (ALIGN_EPI) { if (wr == 1) PG8_BAR; }
    }
    PG8_WAIT_V(0);
    if constexpr (!ALIGN_EPI) { if (wr == 0) PG8_BAR; }
    PG8_BAR;
#undef PG8_SA
#undef PG8_GLOAD
#undef PG8_STAGE_A
#undef PG8_SB
#undef PG8_STAGE
#undef PG8_LDA
#undef PG8_LDB
#undef PG8_MMA
#undef PG8_CAT
#undef PG8_WAIT_V
#undef PG8_WAIT_L
#undef PG8_BAR
#undef PG8_SCHED
}


template <class Epi, class Sched>
__device__ __forceinline__ void gemm_simple(LAS unsigned char* lds, const Gemm g, const Sched& S, const Epi& E) {
    int tid = threadIdx.x; asm volatile("" : "+v"(tid));
    const int wid = __builtin_amdgcn_readfirstlane(tid >> 6), lane = tid & 63, wr = wid >> 2, wc = wid & 3, fr = lane & 15, fq = lane >> 4;
    const int K = g.K, nt = K / BK;
    unsigned voffA[2], voffB[2];
#pragma unroll
    for (int i = 0; i < 2; ++i) { int R, C; stage_rc(tid * 16 + i * 8192, R, C); const int Rb = Epi::PERM ? ((R & ~31) + perm32(R & 31)) : R;
        voffA[i] = (unsigned)(R * K + C) * 2u; voffB[i] = (unsigned)(Rb * K + C) * 2u; }
    const size_t hstep = (size_t)HALF * K * 2, tstep = 2 * hstep;
    const int aoff = lds_byte(wr * 64 + fr, fq * 8), boff = lds_byte(wc * 32 + fr, fq * 8);
    Unit cur;
    for (int ui = 0; S.next(ui, cur); ++ui) {
        f32x4 acc[2][2][4][2];
#pragma unroll
        for (int a = 0; a < 2; ++a)
#pragma unroll
            for (int b = 0; b < 2; ++b)
#pragma unroll
                for (int m = 0; m < 4; ++m)
#pragma unroll
                    for (int n = 0; n < 2; ++n) acc[a][b][m][n] = (f32x4){0.f, 0.f, 0.f, 0.f};
        const char* cA = (const char*)g.A + (size_t)cur.pm * tstep; const char* cB = (const char*)g.Bt + (size_t)cur.pn * tstep;
        for (int t = 0; t < nt; ++t) {
            __syncthreads();
#pragma unroll
            for (int h = 0; h < 2; ++h)
#pragma unroll
                for (int i = 0; i < 2; ++i) {
                    const u32x4 va = *(const u32x4*)(cA + h * hstep + (size_t)t * 128 + voffA[i]);
                    const u32x4 vb = *(const u32x4*)(cB + h * hstep + (size_t)t * 128 + voffB[i]);
                    *(LAS u32x4*)(lds + (0 + h) * HTB + tid * 16 + i * 8192) = va;
                    *(LAS u32x4*)(lds + (4 + h) * HTB + tid * 16 + i * 8192) = vb;
                }
            __syncthreads();
            bf16x8 At[4][2], B0[2][2], B1[2][2];
#pragma unroll
            for (int n = 0; n < 2; ++n)
#pragma unroll
                for (int k = 0; k < 2; ++k) { B0[n][k] = *(const LAS bf16x8*)(lds + 4 * HTB + boff + n * 2048 + k * 1024); B1[n][k] = *(const LAS bf16x8*)(lds + 5 * HTB + boff + n * 2048 + k * 1024); }
#pragma unroll
            for (int ai = 0; ai < 2; ++ai) {
#pragma unroll
                for (int m = 0; m < 4; ++m)
#pragma unroll
                    for (int k = 0; k < 2; ++k) At[m][k] = *(const LAS bf16x8*)(lds + ai * HTB + aoff + m * 2048 + k * 1024);
#pragma unroll
                for (int m = 0; m < 4; ++m)
#pragma unroll
                    for (int n = 0; n < 2; ++n)
#pragma unroll
                        for (int k = 0; k < 2; ++k) {
                            acc[ai][0][m][n] = __builtin_amdgcn_mfma_f32_16x16x32_bf16(B0[n][k], At[m][k], acc[ai][0][m][n], 0, 0, 0);
                            acc[ai][1][m][n] = __builtin_amdgcn_mfma_f32_16x16x32_bf16(B1[n][k], At[m][k], acc[ai][1][m][n], 0, 0, 0); }
            }
        }
        E(acc, cur, wr, wc, fr, fq);
    }
    __syncthreads();
}

__device__ __forceinline__ u32x4 pack8(const f32x4 v0, const f32x4 v1) { u32x4 w; w.x = cvt_pk_bf16(v0[0], v0[1]); w.y = cvt_pk_bf16(v0[2], v0[3]); w.z = cvt_pk_bf16(v1[0], v1[1]); w.w = cvt_pk_bf16(v1[2], v1[3]); return w; }

struct EpiZ {
    static constexpr bool PERM = true;
    bf16_t* Zr; bf16_t* Zs; bf16_t* Zg; int rowoff; int pn0; float sc;
    __device__ __forceinline__ void operator()(const f32x4 (&acc)[2][2][4][2], const Unit& u, int wr, int wc, int fr, int fq) const {
        const int row0 = rowoff + u.pm * BM + wr * 64 + fr; const int pn = u.pn + pn0;
        if (pn < 14) {
            bf16_t* base = Zr + (size_t)row0 * ZR_LD + pn * 256 + wc * 32 + 8 * fq;
#pragma unroll
            for (int ai = 0; ai < 2; ++ai)
#pragma unroll
                for (int m = 0; m < 4; ++m)
#pragma unroll
                    for (int bj = 0; bj < 2; ++bj) *(u32x4*)(base + (size_t)(ai * HALF + m * 16) * ZR_LD + bj * HALF) = pack8(acc[ai][bj][m][0], acc[ai][bj][m][1]);
        } else if (pn < 22) {
            bf16_t* base = Zs + (size_t)row0 * 2048 + (pn - 14) * 256 + wc * 32 + 8 * fq;
#pragma unroll
            for (int ai = 0; ai < 2; ++ai)
#pragma unroll
                for (int m = 0; m < 4; ++m)
#pragma unroll
                    for (int bj = 0; bj < 2; ++bj) { const f32x4 v0 = acc[ai][bj][m][0] * sc, v1 = acc[ai][bj][m][1] * sc;
                        const f32x2 a = gelu_pk((f32x2){v0[0], v0[1]}), b = gelu_pk((f32x2){v0[2], v0[3]}), c = gelu_pk((f32x2){v1[0], v1[1]}), d = gelu_pk((f32x2){v1[2], v1[3]});
                        *(u32x4*)(base + (size_t)(ai * HALF + m * 16) * 2048 + bj * HALF) = pack8((f32x4){a.x, a.y, b.x, b.y}, (f32x4){c.x, c.y, d.x, d.y}); }
        } else {
            bf16_t* base = Zg + (size_t)row0 * 2048 + (pn - 22) * 256 + wc * 32 + 8 * fq;
#pragma unroll
            for (int ai = 0; ai < 2; ++ai)
#pragma unroll
                for (int m = 0; m < 4; ++m)
#pragma unroll
                    for (int bj = 0; bj < 2; ++bj) { f32x4 v0 = acc[ai][bj][m][0] * sc, v1 = acc[ai][bj][m][1] * sc;
#pragma unroll
                        for (int j = 0; j < 4; ++j) { v0[j] = fast_sigmoid(v0[j]); v1[j] = fast_sigmoid(v1[j]); }
                        *(u32x4*)(base + (size_t)(ai * HALF + m * 16) * 2048 + bj * HALF) = pack8(v0, v1); }
        }
    }
};
struct EpiMulInPlace {
    static constexpr bool PERM = true;
    bf16_t* IO;
    __device__ __forceinline__ void operator()(const f32x4 (&acc)[2][2][4][2], const Unit& u, int wr, int wc, int fr, int fq) const {
        bf16_t* base = IO + (size_t)(u.pm * BM + wr * 64 + fr) * 1024 + u.pn * 256 + wc * 32 + 8 * fq;
#pragma unroll
        for (int ai = 0; ai < 2; ++ai) {
            u32x4 wv[4][2];
#pragma unroll
            for (int m = 0; m < 4; ++m)
#pragma unroll
                for (int bj = 0; bj < 2; ++bj) wv[m][bj] = *(const u32x4*)(base + (size_t)(ai * HALF + m * 16) * 1024 + bj * HALF);
#pragma unroll
            for (int m = 0; m < 4; ++m)
#pragma unroll
                for (int bj = 0; bj < 2; ++bj) { u32x4* p = (u32x4*)(base + (size_t)(ai * HALF + m * 16) * 1024 + bj * HALF); const u32x4 w = wv[m][bj];
                    const f32x4 a0 = acc[ai][bj][m][0], a1 = acc[ai][bj][m][1];
                    const f32x4 v0 = (f32x4){bflo(w.x) * a0[0], bfhi(w.x) * a0[1], bflo(w.y) * a0[2], bfhi(w.y) * a0[3]};
                    const f32x4 v1 = (f32x4){bflo(w.z) * a1[0], bfhi(w.z) * a1[1], bflo(w.w) * a1[2], bfhi(w.w) * a1[3]};
                    *p = pack8(v0, v1); }
        }
    }
};
template <bool ACCUM> struct EpiGate {
    static constexpr bool PERM = true;
    bf16_t* OUT; const bf16_t* Zg; int goff;
    __device__ __forceinline__ void operator()(const f32x4 (&acc)[2][2][4][2], const Unit& u, int wr, int wc, int fr, int fq) const {
        const int row0 = u.pm * BM + wr * 64 + fr, col0 = u.pn * 256 + wc * 32 + 8 * fq;
#pragma unroll
        for (int ai = 0; ai < 2; ++ai) {
            u32x4 gt[4][2], od[4][2];
#pragma unroll
            for (int m = 0; m < 4; ++m)
#pragma unroll
                for (int bj = 0; bj < 2; ++bj) { const size_t r = (size_t)(row0 + ai * HALF + m * 16);
                    gt[m][bj] = *(const u32x4*)(Zg + r * 2048 + goff + col0 + bj * HALF);
                    if (ACCUM) od[m][bj] = *(const u32x4*)(OUT + r * 1024 + col0 + bj * HALF); else od[m][bj] = (u32x4){0u, 0u, 0u, 0u}; }
#pragma unroll
            for (int m = 0; m < 4; ++m)
#pragma unroll
                for (int bj = 0; bj < 2; ++bj) { const size_t r = (size_t)(row0 + ai * HALF + m * 16); const u32x4 g = gt[m][bj];
                    const f32x4 a0 = acc[ai][bj][m][0], a1 = acc[ai][bj][m][1];
                    f32x4 v0 = (f32x4){bflo(g.x) * a0[0], bfhi(g.x) * a0[1], bflo(g.y) * a0[2], bfhi(g.y) * a0[3]};
                    f32x4 v1 = (f32x4){bflo(g.z) * a1[0], bfhi(g.z) * a1[1], bflo(g.w) * a1[2], bfhi(g.w) * a1[3]};
                    if (ACCUM) { const u32x4 w = od[m][bj]; v0 += (f32x4){bflo(w.x), bfhi(w.x), bflo(w.y), bfhi(w.y)}; v1 += (f32x4){bflo(w.z), bfhi(w.z), bflo(w.w), bfhi(w.w)}; }
                    *(u32x4*)(OUT + r * 1024 + col0 + bj * HALF) = pack8(v0, v1); }
        }
    }
};
struct EpiRes {
    static constexpr bool PERM = true;
    const float* xlat; const float* xctx; const bf16_t* xb; bf16_t* out; const float* gt;
    __device__ __forceinline__ void operator()(const f32x4 (&acc)[2][2][4][2], const Unit& u, int wr, int wc, int fr, int fq) const {
        const int rt = u.pm * BM; const bool isctx = rt >= MLAT;
        const int s = isctx ? 16 : (rt >> 11);
        const int col0 = u.pn * 256 + wc * 32 + 8 * fq;
        f32x4 gv[2][2];
#pragma unroll
        for (int bj = 0; bj < 2; ++bj)
#pragma unroll
            for (int n = 0; n < 2; ++n) gv[bj][n] = *(const f32x4*)(gt + (size_t)s * 6144 + col0 + bj * HALF + n * 4);
        const size_t ro0 = (size_t)(rt + wr * 64 + fr) * 1024 + col0;
        if (xb != nullptr) {
#pragma unroll
            for (int ai = 0; ai < 2; ++ai) {
                u32x4 xw[4][2];
#pragma unroll
                for (int m = 0; m < 4; ++m)
#pragma unroll
                    for (int bj = 0; bj < 2; ++bj) xw[m][bj] = *(const u32x4*)(xb + ro0 + (size_t)(ai * HALF + m * 16) * 1024 + bj * HALF);
#pragma unroll
                for (int m = 0; m < 4; ++m)
#pragma unroll
                    for (int bj = 0; bj < 2; ++bj) { const size_t ro = ro0 + (size_t)(ai * HALF + m * 16) * 1024 + bj * HALF; const u32x4 w = xw[m][bj];
                        const f32x4 x0 = (f32x4){bflo(w.x), bfhi(w.x), bflo(w.y), bfhi(w.y)}, x1 = (f32x4){bflo(w.z), bfhi(w.z), bflo(w.w), bfhi(w.w)};
                        *(u32x4*)(out + ro) = pack8(x0 * ALPHA + gv[bj][0] * acc[ai][bj][m][0], x1 * ALPHA + gv[bj][1] * acc[ai][bj][m][1]); }
            }
        } else {
            const float* xin = isctx ? xctx - (size_t)MLAT * 1024 : xlat;
#pragma unroll
            for (int ai = 0; ai < 2; ++ai) {
                f32x4 xf[4][2][2];
#pragma unroll
                for (int m = 0; m < 4; ++m)
#pragma unroll
                    for (int bj = 0; bj < 2; ++bj) { const size_t ro = ro0 + (size_t)(ai * HALF + m * 16) * 1024 + bj * HALF; xf[m][bj][0] = *(const f32x4*)(xin + ro); xf[m][bj][1] = *(const f32x4*)(xin + ro + 4); }
#pragma unroll
                for (int m = 0; m < 4; ++m)
#pragma unroll
                    for (int bj = 0; bj < 2; ++bj) { const size_t ro = ro0 + (size_t)(ai * HALF + m * 16) * 1024 + bj * HALF;
                        *(u32x4*)(out + ro) = pack8(xf[m][bj][0] * ALPHA + gv[bj][0] * acc[ai][bj][m][0], xf[m][bj][1] * ALPHA + gv[bj][1] * acc[ai][bj][m][1]); }
            }
        }
    }
};
constexpr float W13_SCALE = 32.f, W2_SCALE = 64.f, HID_SCALE = 2.f;
struct EpiSwiGLU {
    static constexpr bool PERM = true;
    unsigned char* HID;
    __device__ __forceinline__ void operator()(const f32x4 (&acc)[2][2][4][2], const Unit& u, int wr, int wc, int fr, int fq) const {
        const int pn = u.pn & 15;
        unsigned char* base = HID + (size_t)(u.pm * BM + wr * 64 + fr) * 2048 + pn * 128 + wc * 32 + 8 * fq;
#pragma unroll
        for (int ai = 0; ai < 2; ++ai)
#pragma unroll
            for (int m = 0; m < 4; ++m) { f32x4 v[2];
#pragma unroll
                for (int n = 0; n < 2; ++n) {
#pragma unroll
                    for (int j = 0; j < 4; ++j) { const float x1 = acc[ai][0][m][n][j] * (1.0f / W13_SCALE); v[n][j] = x1 * fast_sigmoid(x1) * (acc[ai][1][m][n][j] * (HID_SCALE / W13_SCALE)); } }
                *(u32x2*)(base + (size_t)(ai * HALF + m * 16) * 2048) = (u32x2){pk4_fp8(v[0][0], v[0][1], v[0][2], v[0][3]), pk4_fp8(v[1][0], v[1][1], v[1][2], v[1][3])};
                asm volatile("" ::: "memory"); }
    }
};
struct EpiScaleRow {
    static constexpr bool PERM = true;
    bf16_t* YE; const float* gate;
    __device__ __forceinline__ void operator()(const f32x4 (&acc)[2][2][4][2], const Unit& u, int wr, int wc, int fr, int fq) const {
        const int pn = u.pn & 3; const int row0 = u.pm * BM + wr * 64 + fr;
        float gsv[2][4];
#pragma unroll
        for (int ai = 0; ai < 2; ++ai)
#pragma unroll
            for (int m = 0; m < 4; ++m) gsv[ai][m] = gate[row0 + ai * HALF + m * 16] * (1.0f / (HID_SCALE * W2_SCALE));
#pragma unroll
        for (int ai = 0; ai < 2; ++ai)
#pragma unroll
            for (int m = 0; m < 4; ++m) { const int r = row0 + ai * HALF + m * 16; const float gs = gsv[ai][m];
#pragma unroll
                for (int bj = 0; bj < 2; ++bj)
                    *(u32x4*)(YE + (size_t)r * 1024 + pn * 256 + wc * 32 + 8 * fq + bj * HALF) = pack8(acc[ai][bj][m][0] * gs, acc[ai][bj][m][1] * gs); }
    }
};
}

struct Args { const float* in[33]; float* out; unsigned char* ws; int ph_lo, ph_hi; };
enum { I_X = 0, I_C, I_CTX, I_CCTX, I_ADAW, I_ADAB, I_WIN, I_SHIFT, I_W0, I_W2, I_A0, I_A2, I_G2, I_KK, I_KA, I_RK, I_LNXG, I_LNXB, I_SLNG, I_SLNB, I_SGUW, I_SGUB,
       I_WBA, I_WBB, I_WOUT, I_LN1G, I_LN1B, I_ROUTER, I_EW1, I_EW3, I_EW2, I_LN2G, I_LN2B };

struct Th { int tid, lane, wv, G, bid; };
typedef const Args __attribute__((address_space(4)))* KArgP;
__device__ __forceinline__ KArgP kargs() { KArgP p = (KArgP)__builtin_amdgcn_kernarg_segment_ptr(); asm volatile("" : "+s"(p)); return p; }
__device__ __forceinline__ Th mk_th() { Th t; int tid = threadIdx.x; asm volatile("" : "+v"(tid)); int G = gridDim.x, bid = blockIdx.x; asm volatile("" : "+s"(G), "+s"(bid));
    t.tid = tid; t.lane = tid & 63; t.wv = __builtin_amdgcn_readfirstlane(tid >> 6); t.G = G; t.bid = bid; return t; }
__device__ __forceinline__ int opaque_i(int v) { asm volatile("" : "+s"(v)); return v; }

__device__ __forceinline__ void cvt_tile(const float* src, int ldsrc, int k0, int n0, bf16_t* dst, int ldd, int r0, int kd0, LAS unsigned short* T, int lane) {
    f32x4 vv[16];
#pragma unroll
    for (int it = 0; it < 16; ++it) vv[it] = *(const f32x4*)(src + (size_t)(k0 + it * 4 + (lane >> 4)) * ldsrc + n0 + (lane & 15) * 4);
#pragma unroll
    for (int it = 0; it < 16; ++it) {
        const int kk = it * 4 + (lane >> 4), nn = (lane & 15) * 4; const f32x4 v = vv[it];
        T[(nn + 0) * 72 + kk] = f2bf(v[0]); T[(nn + 1) * 72 + kk] = f2bf(v[1]); T[(nn + 2) * 72 + kk] = f2bf(v[2]); T[(nn + 3) * 72 + kk] = f2bf(v[3]);
    }
    wave_lds_fence();
#pragma unroll 4
    for (int it = 0; it < 8; ++it) {
        const int nn = it * 8 + (lane >> 3), ks = (lane & 7) * 8;
        const u32x4 w = *(const LAS u32x4*)(T + nn * 72 + ks);
        *(u32x4*)(dst + (size_t)(r0 + nn) * ldd + kd0 + ks) = w;
    }
    wave_lds_fence();
}
__device__ __forceinline__ void cvt_tile_fp8(const float* src, int ldsrc, int k0, int n0, unsigned char* dst, int ldd, int r0, int kd0, LAS unsigned char* T, int lane, float scale) {
    const int nn = (lane & 15) * 4, kr = 4 * (lane >> 4);
    f32x4 v[4][4];
#pragma unroll
    for (int blk = 0; blk < 4; ++blk)
#pragma unroll
        for (int j = 0; j < 4; ++j) v[blk][j] = *(const f32x4*)(src + (size_t)(k0 + blk * 16 + kr + j) * ldsrc + n0 + nn);
#pragma unroll
    for (int blk = 0; blk < 4; ++blk)
#pragma unroll
        for (int c = 0; c < 4; ++c) *(LAS unsigned*)(T + (nn + c) * 80 + blk * 16 + kr) = pk4_fp8(v[blk][0][c] * scale, v[blk][1][c] * scale, v[blk][2][c] * scale, v[blk][3][c] * scale);
    wave_lds_fence();
#pragma unroll
    for (int it = 0; it < 4; ++it) {
        const int nn = it * 16 + (lane >> 2), ks = (lane & 3) * 16;
        const u32x4 w = *(const LAS u32x4*)(T + nn * 80 + ks);
        *(u32x4*)(dst + (size_t)(r0 + nn) * ldd + kd0 + ks) = w;
    }
    wave_lds_fence();
}
__device__ __forceinline__ int cvt_row(int mode, int n0) {
    if (mode == 1) return n0 < NRW ? n0 : n0 + 128;
    if (mode == 2) return (n0 >> 7) * 256 + (n0 & 127);
    if (mode == 3) return (n0 >> 7) * 256 + 128 + (n0 & 127);
    return n0;
}
__device__ __forceinline__ void cvt_matrix(const float* src, int K, int N, bf16_t* dst, int ldd, int mode, LAS unsigned short* T, int gw, int nw, int lane) {
    const int ntn = N >> 6, ntile = (K >> 6) * ntn;
    for (int t = gw; t < ntile; t += nw) { const int kt = t / ntn, n0 = (t - kt * ntn) * 64; cvt_tile(src, N, kt * 64, n0, dst, ldd, cvt_row(mode, n0), kt * 64, T, lane); }
}

__device__ __forceinline__ void ph_prologue(KArgP a, LAS unsigned char* lds, const Th& t) {
    LAS float* SL = (LAS float*)lds;
    LAS float* RED = SL + 17 * 1024;
    float* MOD = (float*)(a->ws + WS_MOD);
    for (int i = t.tid; i < 17 * 1024; i += 512) { const int s = i >> 10, k = i & 1023; const float v = s < 16 ? a->in[I_C][s * 1024 + k] : a->in[I_CCTX][k]; SL[i] = v * fast_sigmoid(v); }
    __syncthreads();
    for (int slab = t.bid; slab < 256; slab += t.G) {
        const int l = slab >> 7, j0 = (slab & 127) * 48, col = t.tid % 48, kg = t.tid / 48;
        float acc[17];
#pragma unroll
        for (int s = 0; s < 17; ++s) acc[s] = 0.f;
        if (kg < 10) {
            const float* wp = a->in[I_ADAW] + (size_t)l * 1024 * 6144 + j0 + col;
            for (int k0 = kg; k0 < 1024; k0 += 80) {
                float w[8];
#pragma unroll
                for (int u = 0; u < 8; ++u) { const int k = k0 + 10 * u; w[u] = k < 1024 ? wp[(size_t)k * 6144] : 0.f; }
#pragma unroll
                for (int u = 0; u < 8; ++u) { const int k = (k0 + 10 * u) < 1024 ? (k0 + 10 * u) : 1023;
#pragma unroll
                    for (int s = 0; s < 17; ++s) acc[s] += SL[s * 1024 + k] * w[u]; } }
#pragma unroll
            for (int s = 0; s < 17; ++s) RED[(kg * 17 + s) * 48 + col] = acc[s];
        }
        __syncthreads();
        for (int i = t.tid; i < 17 * 48; i += 512) { const int s = i / 48, cc = i % 48; float sum = 0.f;
#pragma unroll
            for (int g = 0; g < 10; ++g) sum += RED[(g * 17 + s) * 48 + cc];
            MOD[((size_t)l * 17 + s) * 6144 + j0 + cc] = sum + a->in[I_ADAB][l * 6144 + j0 + cc]; }
        __syncthreads();
    }
    LAS unsigned short* T = (LAS unsigned short*)(lds + 73728) + t.wv * (64 * 72);
    T = (LAS unsigned short*)(lds) + t.wv * (64 * 72);
    const int gw = t.bid * 8 + t.wv, nw = t.G * 8;
    for (int l = 0; l < 2; ++l) {
        cvt_matrix(a->in[I_WIN] + (size_t)l * 1024 * NIN, 1024, NIN, (bf16_t*)(a->ws + WS_WIN) + (size_t)l * NZ * 1024, 1024, 1, T, gw, nw, t.lane);
        cvt_matrix(a->in[I_WBA] + (size_t)l * 1024 * 1024, 1024, 1024, (bf16_t*)(a->ws + WS_WA) + (size_t)l * 1024 * 1024, 1024, 0, T, gw, nw, t.lane);
        cvt_matrix(a->in[I_WBB] + (size_t)l * 1024 * 1024, 1024, 1024, (bf16_t*)(a->ws + WS_WB) + (size_t)l * 1024 * 1024, 1024, 0, T, gw, nw, t.lane);
        cvt_matrix(a->in[I_WOUT] + (size_t)l * 1024 * 1024, 1024, 1024, (bf16_t*)(a->ws + WS_WO) + (size_t)l * 1024 * 1024, 1024, 0, T, gw, nw, t.lane);
        cvt_matrix(a->in[I_G2] + (size_t)l * 128 * 1024, 128, 1024, (bf16_t*)(a->ws + WS_G2) + (size_t)l * 1024 * 256, 256, 0, T, gw, nw, t.lane);
    }
    {
        __syncthreads();
        LAS unsigned char* T8 = lds + t.wv * (64 * 80);
        for (int l = 0; l < 2; ++l)
            for (int tt = gw; tt < 16 * 64; tt += nw) { const int kt = tt >> 6, n0 = NRW + (tt & 63) * 64;
                cvt_tile_fp8(a->in[I_WIN] + (size_t)l * 1024 * NIN, NIN, kt * 64, n0, a->ws + WS_WIN8 + (size_t)l * 4096 * 1024, 1024, n0 - NRW, kt * 64, T8, t.lane, WIN8_SCALE); }
        __syncthreads();
    }
    const int gt = t.bid * 512 + t.tid, nt = t.G * 512;
    for (int i = gt; i < 2 * 128 * 1024 / 8; i += nt) {
        const int l = i / (128 * 1024 / 8), r = i % (128 * 1024 / 8);
        *(u32x4*)((bf16_t*)(a->ws + WS_WIN) + ((size_t)l * NZ + NRW) * 1024 + (size_t)r * 8) = (u32x4){0u, 0u, 0u, 0u};
    }
    for (int i = gt; i < 2 * 1024 * 128 / 8; i += nt) {
        const int row = i / 16, c8 = i % 16;
        *(u32x4*)((bf16_t*)(a->ws + WS_G2) + (size_t)row * 256 + 128 + c8 * 8) = (u32x4){0u, 0u, 0u, 0u};
    }
    for (int i = gt; i < 2 * 8 * 128 * 128 / 4; i += nt) {
        const f32x4 v = *(const f32x4*)(a->in[I_SGUW] + (size_t)i * 4);
        *(u32x2*)((bf16_t*)(a->ws + WS_WSG) + (size_t)i * 4) = (u32x2){cvt_pk_bf16(v[0], v[1]), cvt_pk_bf16(v[2], v[3])};
    }
}

__device__ __forceinline__ void ln_rows(float (&v)[16]) {
    float s = 0.f;
#pragma unroll
    for (int i = 0; i < 16; ++i) s += v[i];
    const float mean = wave_sum(s) * (1.0f / 1024.0f);
    float q = 0.f;
#pragma unroll
    for (int i = 0; i < 16; ++i) { v[i] -= mean; q += v[i] * v[i]; }
    const float rstd = rsqrtf(wave_sum(q) * (1.0f / 1024.0f) + LN_EPS);
#pragma unroll
    for (int i = 0; i < 16; ++i) v[i] *= rstd;
}
__device__ __forceinline__ void load_row16(const float* p, int lane, float (&v)[16]) {
#pragma unroll
    for (int i = 0; i < 4; ++i) { const f32x4 x = *(const f32x4*)(p + i * 256 + lane * 4); v[4 * i] = x[0]; v[4 * i + 1] = x[1]; v[4 * i + 2] = x[2]; v[4 * i + 3] = x[3]; }
}
__device__ __forceinline__ void load_row16_bf16(const bf16_t* p, int lane, float (&v)[16]) {
#pragma unroll
    for (int i = 0; i < 4; ++i) { const u32x2 x = *(const u32x2*)(p + i * 256 + lane * 4); v[4 * i] = bflo(x.x); v[4 * i + 1] = bfhi(x.x); v[4 * i + 2] = bflo(x.y); v[4 * i + 3] = bfhi(x.y); }
}
__device__ __forceinline__ void store_row16(float* p, int lane, const float (&v)[16]) {
#pragma unroll
    for (int i = 0; i < 4; ++i) *(f32x4*)(p + i * 256 + lane * 4) = (f32x4){v[4 * i], v[4 * i + 1], v[4 * i + 2], v[4 * i + 3]};
}
__device__ __forceinline__ void store_row16_bf16(bf16_t* p, int lane, const float (&v)[16]) {
#pragma unroll
    for (int i = 0; i < 4; ++i) *(u32x2*)(p + i * 256 + lane * 4) = (u32x2){cvt_pk_bf16(v[4 * i], v[4 * i + 1]), cvt_pk_bf16(v[4 * i + 2], v[4 * i + 3])};
}
__device__ __forceinline__ void modulate16(float (&v)[16], const float* sh, const float* sc, int lane) {
#pragma unroll
    for (int i = 0; i < 4; ++i) { const f32x4 a = *(const f32x4*)(sc + i * 256 + lane * 4), b = *(const f32x4*)(sh + i * 256 + lane * 4);
#pragma unroll
        for (int j = 0; j < 4; ++j) v[4 * i + j] = v[4 * i + j] * (1.0f + a[j]) + b[j]; }
}
__device__ __forceinline__ void affine16(float (&v)[16], const float* g, const float* b, int lane) {
#pragma unroll
    for (int i = 0; i < 4; ++i) { const f32x4 a = *(const f32x4*)(g + i * 256 + lane * 4), c = *(const f32x4*)(b + i * 256 + lane * 4);
#pragma unroll
        for (int j = 0; j < 4; ++j) v[4 * i + j] = v[4 * i + j] * a[j] + c[j]; }
}

__device__ __forceinline__ void ph_lnmod0(KArgP a, const Th& t) {
    const float* MOD = (const float*)(a->ws + WS_MOD);
    bf16_t* H = (bf16_t*)(a->ws + WS_S);
    for (int m = t.bid * 8 + t.wv; m < MALL; m += t.G * 8) {
        const int s = m < MLAT ? (m >> 11) : 16;
        const float* xp = m < MLAT ? a->in[I_X] + (size_t)m * 1024 : a->in[I_CTX] + (size_t)(m - MLAT) * 1024;
        float v[16]; load_row16(xp, t.lane, v); ln_rows(v);
        modulate16(v, MOD + (size_t)s * 6144, MOD + (size_t)s * 6144 + 1024, t.lane);
        store_row16_bf16(H + (size_t)m * 1024, t.lane, v);
#pragma unroll
        for (int i = 0; i < 4; ++i) *(unsigned*)(a->ws + WS_HQ + (size_t)m * 1024 + i * 256 + t.lane * 4) = pk4_fp8(v[4 * i], v[4 * i + 1], v[4 * i + 2], v[4 * i + 3]);
    }
}

__device__ __forceinline__ void sgu_block(KArgP a, int l, LAS unsigned char* lds, const Th& t, int ck, int g0, int ng) {
    LAS float* ST = (LAS float*)lds;
    LAS unsigned short* VT0 = (LAS unsigned short*)(lds + 1024);
    const bf16_t* Zs = (const bf16_t*)(a->ws + WS_ZS);
    bf16_t* YS = (bf16_t*)(a->ws + WS_S);
    const bf16_t* WSG = (const bf16_t*)(a->ws + WS_WSG);
    const float* lng = a->in[I_SLNG] + l * 1024; const float* lnb = a->in[I_SLNB] + l * 1024;
    const int fr = t.lane & 15, fq = t.lane >> 4, m0 = ck * 128;
    const int q = t.tid >> 2, seg = t.tid & 3;
    __syncthreads();
    LAS float* LNP = (LAS float*)(lds + 71680);
    *(LAS f32x4*)(LNP + t.tid * 4) = t.tid < 256 ? *(const f32x4*)(lng + t.tid * 4) : *(const f32x4*)(lnb + (t.tid - 256) * 4);
    {
        const u32x4* p = (const u32x4*)(Zs + (size_t)(m0 + q) * 2048 + 1024 + seg * 256);
        float sm = 0.f, ss = 0.f;
#pragma unroll 16
        for (int j = 0; j < 32; ++j) { const u32x4 w = p[j];
            const float x0 = bflo(w.x), x1 = bfhi(w.x), x2 = bflo(w.y), x3 = bfhi(w.y), x4 = bflo(w.z), x5 = bfhi(w.z), x6 = bflo(w.w), x7 = bfhi(w.w);
            sm += ((x0 + x1) + (x2 + x3)) + ((x4 + x5) + (x6 + x7));
            ss += ((x0 * x0 + x1 * x1) + (x2 * x2 + x3 * x3)) + ((x4 * x4 + x5 * x5) + (x6 * x6 + x7 * x7)); }
        sm = quad_sum(sm); ss = quad_sum(ss);
        if (seg == 0) { const float mean = sm * (1.0f / 1024.0f); const float var = fmaxf(ss * (1.0f / 1024.0f) - mean * mean, 0.f); ST[q * 2] = mean; ST[q * 2 + 1] = rsqrtf(var + LN_EPS); }
    }
    u32x4 vreg[4];
    { const u32x4* p = (const u32x4*)(Zs + (size_t)(m0 + q) * 2048 + 1024 + 128 * g0 + 32 * seg);
#pragma unroll
      for (int j = 0; j < 4; ++j) vreg[j] = p[j]; }
    __syncthreads();
    const float mean = ST[q * 2], rstd = ST[q * 2 + 1];
    const int ct0 = 2 * (t.wv & 3), pt0 = 4 * (t.wv >> 2);
    for (int gi = 0; gi < ng; ++gi) {
        const int g = g0 + gi;
        LAS unsigned short* VT = VT0 + (gi & 1) * (128 * 136);
        const bf16_t* Wg = WSG + (size_t)((l * 8 + g) * 128) * 128;
        bf16x8 bfr[4][4];
#pragma unroll
        for (int ks = 0; ks < 4; ++ks)
#pragma unroll
            for (int j = 0; j < 4; ++j) bfr[ks][j] = *(const bf16x8*)(Wg + (size_t)(16 * (pt0 + j) + fr) * 128 + 32 * ks + 8 * fq);
        u32x2 uu[4][2]; float bias[4];
#pragma unroll
        for (int j = 0; j < 4; ++j) { const int p = 16 * (pt0 + j) + fr; bias[j] = a->in[I_SGUB][(l * 8 + g) * 128 + p];
#pragma unroll
            for (int i = 0; i < 2; ++i) uu[j][i] = *(const u32x2*)(Zs + (size_t)(m0 + p) * 2048 + 128 * g + 16 * (ct0 + i) + 4 * fq); }
#pragma unroll
        for (int j = 0; j < 4; ++j) { const u32x4 w = vreg[j]; const int c0 = 32 * seg + 8 * j; const int ch = 128 * g + c0;
            const f32x4 g0v = *(const LAS f32x4*)(LNP + ch), g1v = *(const LAS f32x4*)(LNP + ch + 4), b0 = *(const LAS f32x4*)(LNP + 1024 + ch), b1 = *(const LAS f32x4*)(LNP + 1024 + ch + 4);
            VT[(c0 + 0) * 136 + q] = f2bf((bflo(w.x) - mean) * rstd * g0v[0] + b0[0]); VT[(c0 + 1) * 136 + q] = f2bf((bfhi(w.x) - mean) * rstd * g0v[1] + b0[1]);
            VT[(c0 + 2) * 136 + q] = f2bf((bflo(w.y) - mean) * rstd * g0v[2] + b0[2]); VT[(c0 + 3) * 136 + q] = f2bf((bfhi(w.y) - mean) * rstd * g0v[3] + b0[3]);
            VT[(c0 + 4) * 136 + q] = f2bf((bflo(w.z) - mean) * rstd * g1v[0] + b1[0]); VT[(c0 + 5) * 136 + q] = f2bf((bfhi(w.z) - mean) * rstd * g1v[1] + b1[1]);
            VT[(c0 + 6) * 136 + q] = f2bf((bflo(w.w) - mean) * rstd * g1v[2] + b1[2]); VT[(c0 + 7) * 136 + q] = f2bf((bfhi(w.w) - mean) * rstd * g1v[3] + b1[3]); }
        if (gi + 1 < ng) { const u32x4* p = (const u32x4*)(Zs + (size_t)(m0 + q) * 2048 + 1024 + 128 * (g + 1) + 32 * seg);
#pragma unroll
            for (int j = 0; j < 4; ++j) vreg[j] = p[j]; }
        lds_barrier();
        f32x4 acc[2][4];
#pragma unroll
        for (int i = 0; i < 2; ++i)
#pragma unroll
            for (int j = 0; j < 4; ++j) acc[i][j] = (f32x4){0.f, 0.f, 0.f, 0.f};
#pragma unroll
        for (int ks = 0; ks < 4; ++ks) {
            bf16x8 af[2];
#pragma unroll
            for (int i = 0; i < 2; ++i) af[i] = *(const LAS bf16x8*)(VT + (16 * (ct0 + i) + fr) * 136 + 32 * ks + 8 * fq);
#pragma unroll
            for (int i = 0; i < 2; ++i)
#pragma unroll
                for (int j = 0; j < 4; ++j) acc[i][j] = __builtin_amdgcn_mfma_f32_16x16x32_bf16(af[i], bfr[ks][j], acc[i][j], 0, 0, 0);
        }
#pragma unroll
        for (int j = 0; j < 4; ++j) { const int p = 16 * (pt0 + j) + fr; const size_t m = (size_t)(m0 + p);
#pragma unroll
            for (int i = 0; i < 2; ++i) { const int c0 = 16 * (ct0 + i) + 4 * fq; const f32x4 r = acc[i][j]; const u32x2 u2 = uu[j][i];
                *(u32x2*)(YS + m * 1024 + 128 * g + c0) = (u32x2){cvt_pk_bf16(bflo(u2.x) * (r[0] + bias[j]), bfhi(u2.x) * (r[1] + bias[j])), cvt_pk_bf16(bflo(u2.y) * (r[2] + bias[j]), bfhi(u2.y) * (r[3] + bias[j]))}; } }
    }
}
__device__ __forceinline__ void ph_sgu(KArgP a, int l, LAS unsigned char* lds, const Th& t) {
    for (int w = t.bid; w < 256; w += t.G) sgu_block(a, l, lds, t, w, 0, 8);
    if (l == 0) for (int w = t.bid; w < 256; w += t.G) sgu_block(a, l, lds, t, 256 + (w >> 3), w & 7, 1);
    __syncthreads();
}

__device__ __forceinline__ void ph_scan(KArgP a, int l, LAS unsigned char* lds, const Th& t) {
    LAS float* OPS = (LAS float*)lds;
    LAS float* W2L = (LAS float*)(lds + 49152);
    LAS float* A2L = (LAS float*)(lds + 81920);
    LAS float* TDL = (LAS float*)(lds + 114688);
    LAS float* YL = (LAS float*)(lds + 131072);
    const bf16_t* Zr = (const bf16_t*)(a->ws + WS_ZR);
    bf16_t* Yf = (bf16_t*)(a->ws + WS_Y); bf16_t* Yb = Yf + (size_t)MALL * 1024;
    float* BON = (float*)(a->ws + WS_BON);
    const float* scw = a->in[I_SHIFT] + (size_t)l * 3 * NRW;
    const int lane = t.lane, wv = t.wv, dir = wv >> 2, wq = wv & 3;
    for (int unit = t.bid; unit < 256; unit += t.G) {
        const int b = unit >> 4, h = unit & 15;
        __syncthreads();
        for (int idx = t.tid; idx < 8192; idx += 512) { const int d_ = idx >> 12, i = (idx >> 6) & 63, c = idx & 63; const size_t o = ((size_t)(l * 2 + d_) * 64 + i) * 1024 + 64 * h + c;
            W2L[idx] = a->in[I_W2][o]; A2L[idx] = a->in[I_A2][o]; }
        const int ch = 64 * h + lane;
        const float w0v = a->in[I_W0][(l * 2 + dir) * 1024 + ch], a0v = a->in[I_A0][(l * 2 + dir) * 1024 + ch];
        const float kkv = a->in[I_KK][l * 1024 + ch], kav = a->in[I_KA][l * 1024 + ch], rkv = a->in[I_RK][l * 1024 + ch];
        float swr[3], swk[3], swv[3], swd[3], swa[3];
#pragma unroll
        for (int j = 0; j < 3; ++j) { swr[j] = scw[j * NRW + ch]; swk[j] = scw[j * NRW + 1024 + ch]; swv[j] = scw[j * NRW + 2048 + ch];
            swd[j] = scw[j * NRW + 3072 + 64 * dir + lane]; swa[j] = scw[j * NRW + 3200 + 64 * dir + lane]; }
        float S[2][8];
#pragma unroll
        for (int r = 0; r < 2; ++r)
#pragma unroll
            for (int k = 0; k < 8; ++k) S[r][k] = 0.f;
        const int rp = lane >> 3, cg = lane & 7;
        __syncthreads();
        for (int blk = 0; blk < 144; ++blk) {
            const bool isctx = blk < 16; const int jj = isctx ? blk : blk - 16; const int Tseq = isctx ? TC : TL;
            const int mbase = isctx ? (MLAT + b * TC) : b * TL;
            float rr[4], kx[4], vx[4], lw[4], la[4];
#pragma unroll
            for (int q = 0; q < 4; ++q) {
                const int s = 4 * wq + q; const int tl = dir == 0 ? 16 * jj + s : Tseq - 1 - (16 * jj + s);
                const bf16_t* z0 = Zr + (size_t)(mbase + tl) * ZR_LD;
                float r_ = 0.f, k_ = 0.f, v_ = 0.f, dw_ = 0.f, da_ = 0.f;
#pragma unroll
                for (int j = 0; j < 3; ++j) { const int tt = tl + j - 1;
                    if (tt >= 0 && tt < Tseq) { const bf16_t* zz = z0 + (j - 1) * ZR_LD;
                        r_ += swr[j] * bf2f(zz[ch]); k_ += swk[j] * bf2f(zz[1024 + ch]); v_ += swv[j] * bf2f(zz[2048 + ch]);
                        dw_ += swd[j] * bf2f(zz[3072 + 64 * dir + lane]); da_ += swa[j] * bf2f(zz[3200 + 64 * dir + lane]); } }
                rr[q] = r_; kx[q] = k_; vx[q] = v_; lw[q] = 0.f; la[q] = 0.f;
                TDL[wv * 512 + lane * 4 + q] = fast_tanh(dw_); TDL[wv * 512 + 256 + lane * 4 + q] = da_;
            }
            wave_lds_fence();
#pragma unroll 8
            for (int i = 0; i < 64; ++i) { const float w2v = W2L[dir * 4096 + i * 64 + lane], a2v = A2L[dir * 4096 + i * 64 + lane];
                const f32x4 td = *(const LAS f32x4*)(TDL + wv * 512 + i * 4), dd = *(const LAS f32x4*)(TDL + wv * 512 + 256 + i * 4);
#pragma unroll
                for (int q = 0; q < 4; ++q) { lw[q] += td[q] * w2v; la[q] += dd[q] * a2v; } }
#pragma unroll
            for (int q = 0; q < 4; ++q) {
                const int s = 4 * wq + q; const int tl = dir == 0 ? 16 * jj + s : Tseq - 1 - (16 * jj + s);
                const float wlog = -softplus_f(-(w0v + lw[q])) - 0.5f; const float dcy = fast_exp(-fast_exp(wlog));
                const float av = fast_sigmoid(a0v + la[q]);
                const float kraw = kx[q] * kkv; const float ssq = wave_sum(kraw * kraw); const float kap = kraw * rsqrtf(fmaxf(ssq, 1e-12f));
                const float kd = kx[q] * (1.0f + (av - 1.0f) * kav);
                LAS float* o = OPS + ((dir * 16 + s) * 6) * 64 + lane;
                o[0] = kap; o[64] = dcy; o[128] = kap * av; o[192] = kd; o[256] = rr[q]; o[320] = vx[q];
                if (dir == 0) { const float bs = wave_sum(rr[q] * kd * rkv); if (lane == 0) BON[(size_t)(mbase + tl) * 16 + h] = bs; }
            }
            __syncthreads();
#pragma unroll 2
            for (int s = 0; s < 16; ++s) {
                const LAS float* o = OPS + ((dir * 16 + s) * 6) * 64 + 8 * cg;
                const f32x4 ka0 = *(const LAS f32x4*)(o), ka1 = *(const LAS f32x4*)(o + 4);
                const f32x4 d0 = *(const LAS f32x4*)(o + 64), d1 = *(const LAS f32x4*)(o + 68);
                const f32x4 b0 = *(const LAS f32x4*)(o + 128), b1 = *(const LAS f32x4*)(o + 132);
                const f32x4 k0 = *(const LAS f32x4*)(o + 192), k1 = *(const LAS f32x4*)(o + 196);
                const f32x4 r0 = *(const LAS f32x4*)(o + 256), r1 = *(const LAS f32x4*)(o + 260);
                const f32x2 v2 = *(const LAS f32x2*)(OPS + ((dir * 16 + s) * 6 + 5) * 64 + 16 * wq + 2 * rp);
                float u[2], y[2];
#pragma unroll
                for (int r = 0; r < 2; ++r) {
                    float us = 0.f, ys = 0.f;
#pragma unroll
                    for (int k = 0; k < 4; ++k) { us += S[r][k] * ka0[k] + S[r][4 + k] * ka1[k]; ys += S[r][k] * r0[k] + S[r][4 + k] * r1[k]; }
                    u[r] = oct_sum(us); y[r] = ys;
                }
#pragma unroll
                for (int r = 0; r < 2; ++r) {
                    const float vr = r == 0 ? v2.x : v2.y;
#pragma unroll
                    for (int k = 0; k < 4; ++k) { S[r][k] = S[r][k] * d0[k] - u[r] * b0[k] + vr * k0[k]; S[r][4 + k] = S[r][4 + k] * d1[k] - u[r] * b1[k] + vr * k1[k]; }
                }
                if (dir == 0) {
#pragma unroll
                    for (int r = 0; r < 2; ++r) { float ys = 0.f;
#pragma unroll
                        for (int k = 0; k < 4; ++k) ys += S[r][k] * r0[k] + S[r][4 + k] * r1[k];
                        y[r] = ys; }
                }
                y[0] = oct_sum(y[0]); y[1] = oct_sum(y[1]);
                if (cg == 0) *(LAS f32x2*)(YL + (dir * 16 + s) * 64 + 16 * wq + 2 * rp) = (f32x2){y[0], y[1]};
            }
            __syncthreads();
            for (int idx = t.tid; idx < 2048; idx += 512) { const int d_ = idx >> 10, s = (idx >> 6) & 15, c = idx & 63;
                const int tl = d_ == 0 ? 16 * jj + s : Tseq - 1 - (16 * jj + s);
                (d_ ? Yb : Yf)[(size_t)(mbase + tl) * 1024 + 64 * h + c] = f2bf(YL[idx]); }
        }
    }
}


__device__ __forceinline__ float row16_sum(float v) { v += dpp_f<0xB1>(v); v += dpp_f<0x4E>(v); v += dpp_f<0x141>(v); v += dpp_f<0x140>(v); return v; }
__device__ __forceinline__ void ph_scan2(KArgP a, int l, LAS unsigned char* lds, const Th& t) {
    LAS float* OPS = (LAS float*)lds;
    LAS unsigned short* ZA = (LAS unsigned short*)(lds + 49152);
    LAS float* PART = (LAS float*)(lds + 58368);
    LAS float* YL = (LAS float*)(lds + 59392);
    const bf16_t* Zr = (const bf16_t*)(a->ws + WS_ZR);
    bf16_t* Yf = (bf16_t*)(a->ws + WS_Y); bf16_t* Yb = Yf + (size_t)MALL * 1024;
    float* BON = (float*)(a->ws + WS_BON);
    const float* scw = a->in[I_SHIFT] + (size_t)l * 3 * NRW;
    const int lane = t.lane, wv = t.wv, dir = wv >> 2, wq = wv & 3, fr = lane & 15, fq = lane >> 4;
    const int zq = wq & 1, zth = wq >> 1;
    const int rp = lane >> 3, cg = lane & 7;
    for (int unit = t.bid; unit < 256; unit += t.G) {
        const int b = unit >> 4, h = unit & 15;
        const int ch = 64 * h + 16 * wq + fr;
        bf16x8 bw[2], ba[2];
        {
            const float* w2p = a->in[I_W2] + ((size_t)(l * 2 + dir) * 64) * 1024 + ch; const float* a2p = a->in[I_A2] + ((size_t)(l * 2 + dir) * 64) * 1024 + ch;
#pragma unroll
            for (int ks = 0; ks < 2; ++ks) { unsigned pw[4], pa[4];
#pragma unroll
                for (int e = 0; e < 4; ++e) { const int k0 = 32 * ks + 8 * fq + 2 * e;
                    pw[e] = cvt_pk_bf16(w2p[(size_t)k0 * 1024], w2p[(size_t)(k0 + 1) * 1024]); pa[e] = cvt_pk_bf16(a2p[(size_t)k0 * 1024], a2p[(size_t)(k0 + 1) * 1024]); }
                bw[ks] = __builtin_bit_cast(bf16x8, (u32x4){pw[0], pw[1], pw[2], pw[3]}); ba[ks] = __builtin_bit_cast(bf16x8, (u32x4){pa[0], pa[1], pa[2], pa[3]}); }
        }
        const float w0v = a->in[I_W0][(l * 2 + dir) * 1024 + ch], a0v = a->in[I_A0][(l * 2 + dir) * 1024 + ch];
        const float kkv = a->in[I_KK][l * 1024 + ch], kav = a->in[I_KA][l * 1024 + ch], rkv = a->in[I_RK][l * 1024 + ch];
        float swr[3], swk[3], swv[3], swz[3];
        const int zcol = 3072 + 128 * zq + 64 * dir + lane;
#pragma unroll
        for (int j = 0; j < 3; ++j) { swr[j] = scw[j * NRW + ch]; swk[j] = scw[j * NRW + 1024 + ch]; swv[j] = scw[j * NRW + 2048 + ch]; swz[j] = scw[j * NRW + zcol]; }
        float S[2][8];
#pragma unroll
        for (int r = 0; r < 2; ++r)
#pragma unroll
            for (int k = 0; k < 8; ++k) S[r][k] = 0.f;
        unsigned short pr[6], pk[6], pv[6], pz[10];
#define SCAN_LOADS(blk_) do { const int blk__ = (blk_); const bool isctx__ = blk__ < 16; const int jj__ = isctx__ ? blk__ : blk__ - 16; const int Tseq__ = isctx__ ? TC : TL; \
            const int mbase__ = isctx__ ? (MLAT + b * TC) : b * TL; const int t0__ = dir == 0 ? 16 * jj__ : Tseq__ - 16 * (jj__ + 1); \
            _Pragma("unroll") for (int e = 0; e < 6; ++e) { const int rr = t0__ + 4 * fq - 1 + e; const bool ok = rr >= 0 && rr < Tseq__; const bf16_t* zz = Zr + (size_t)(mbase__ + (ok ? rr : 0)) * ZR_LD + ch; \
                pr[e] = ok ? zz[0] : (unsigned short)0; pk[e] = ok ? zz[1024] : (unsigned short)0; pv[e] = ok ? zz[2048] : (unsigned short)0; } \
            _Pragma("unroll") for (int e = 0; e < 10; ++e) { const int rr = t0__ + 8 * zth - 1 + e; const bool ok = rr >= 0 && rr < Tseq__; \
                pz[e] = ok ? Zr[(size_t)(mbase__ + rr) * ZR_LD + zcol] : (unsigned short)0; } } while (0)
#define SCAN_PREP(blk_) do { const int blk__ = (blk_); const bool isctx__ = blk__ < 16; const int jj__ = isctx__ ? blk__ : blk__ - 16; const int Tseq__ = isctx__ ? TC : TL; \
            const int mbase__ = isctx__ ? (MLAT + b * TC) : b * TL; const int t0__ = dir == 0 ? 16 * jj__ : Tseq__ - 16 * (jj__ + 1); \
            float r4[4], k4[4], v4[4]; \
            _Pragma("unroll") for (int j = 0; j < 4; ++j) { r4[j] = swr[0] * bf2f(pr[j]) + swr[1] * bf2f(pr[j + 1]) + swr[2] * bf2f(pr[j + 2]); \
                k4[j] = swk[0] * bf2f(pk[j]) + swk[1] * bf2f(pk[j + 1]) + swk[2] * bf2f(pk[j + 2]); v4[j] = swv[0] * bf2f(pv[j]) + swv[1] * bf2f(pv[j + 1]) + swv[2] * bf2f(pv[j + 2]); } \
            _Pragma("unroll") for (int j = 0; j < 8; ++j) { float zv = swz[0] * bf2f(pz[j]) + swz[1] * bf2f(pz[j + 1]) + swz[2] * bf2f(pz[j + 2]); if (zq == 0) zv = fast_tanh(zv); \
                ZA[((dir * 2 + zq) * 16 + 8 * zth + j) * 72 + lane] = f2bf(zv); } \
            __syncthreads(); \
            f32x4 lw = (f32x4){0.f, 0.f, 0.f, 0.f}, la = (f32x4){0.f, 0.f, 0.f, 0.f}; \
            _Pragma("unroll") for (int ks = 0; ks < 2; ++ks) { \
                const bf16x8 aw = *(const LAS bf16x8*)(ZA + ((dir * 2 + 0) * 16 + fr) * 72 + 32 * ks + 8 * fq); const bf16x8 aa = *(const LAS bf16x8*)(ZA + ((dir * 2 + 1) * 16 + fr) * 72 + 32 * ks + 8 * fq); \
                lw = __builtin_amdgcn_mfma_f32_16x16x32_bf16(aw, bw[ks], lw, 0, 0, 0); la = __builtin_amdgcn_mfma_f32_16x16x32_bf16(aa, ba[ks], la, 0, 0, 0); } \
            float dc4[4], av4[4], kr4[4], kd4[4]; \
            _Pragma("unroll") for (int j = 0; j < 4; ++j) { const float wlog = -softplus_f(-(w0v + lw[j])) - 0.5f; dc4[j] = fast_exp(-fast_exp(wlog)); av4[j] = fast_sigmoid(a0v + la[j]); \
                kr4[j] = k4[j] * kkv; kd4[j] = k4[j] * (1.0f + (av4[j] - 1.0f) * kav); \
                const float pn = row16_sum(kr4[j] * kr4[j]); const float pb = row16_sum(r4[j] * kd4[j] * rkv); \
                if (fr == 0) *(LAS f32x2*)(PART + ((dir * 16 + 4 * fq + j) * 4 + wq) * 2) = (f32x2){pn, pb}; } \
            __syncthreads(); \
            _Pragma("unroll") for (int j = 0; j < 4; ++j) { const int ti = 4 * fq + j; const f32x4 p0 = *(const LAS f32x4*)(PART + (dir * 16 + ti) * 8), p1 = *(const LAS f32x4*)(PART + (dir * 16 + ti) * 8 + 4); \
                const float nrm = (p0[0] + p0[2]) + (p1[0] + p1[2]); const float kap = kr4[j] * rsqrtf(fmaxf(nrm, 1e-12f)); \
                const int sidx = dir ? 15 - ti : ti; LAS float* o = OPS + ((dir * 16 + sidx) * 6) * 64 + 16 * wq + fr; \
                o[0] = kap; o[64] = dc4[j]; o[128] = kap * av4[j]; o[192] = kd4[j]; o[256] = r4[j]; o[320] = v4[j]; \
                if (dir == 0 && wq == 0 && fr == 0) BON[(size_t)(mbase__ + t0__ + ti) * 16 + h] = (p0[1] + p0[3]) + (p1[1] + p1[3]); } \
            __syncthreads(); } while (0)
        __syncthreads();
        SCAN_LOADS(0);
        SCAN_PREP(0);
        for (int blk = 0; blk < 144; ++blk) {
            const bool isctx = blk < 16; const int jj = isctx ? blk : blk - 16; const int Tseq = isctx ? TC : TL;
            const int mbase = isctx ? (MLAT + b * TC) : b * TL;
            if (blk + 1 < 144) SCAN_LOADS(blk + 1);
#pragma unroll 4
            for (int s = 0; s < 16; ++s) {
                const LAS float* o = OPS + ((dir * 16 + s) * 6) * 64 + 8 * cg;
                const f32x4 ka0 = *(const LAS f32x4*)(o), ka1 = *(const LAS f32x4*)(o + 4);
                const f32x4 d0 = *(const LAS f32x4*)(o + 64), d1 = *(const LAS f32x4*)(o + 68);
                const f32x4 b0 = *(const LAS f32x4*)(o + 128), b1 = *(const LAS f32x4*)(o + 132);
                const f32x4 k0 = *(const LAS f32x4*)(o + 192), k1 = *(const LAS f32x4*)(o + 196);
                const f32x4 r0 = *(const LAS f32x4*)(o + 256), r1 = *(const LAS f32x4*)(o + 260);
                const f32x2 v2 = *(const LAS f32x2*)(OPS + ((dir * 16 + s) * 6 + 5) * 64 + 16 * wq + 2 * rp);
                float u[2], y[2];
#pragma unroll
                for (int r = 0; r < 2; ++r) {
                    float us = 0.f, ys = 0.f;
#pragma unroll
                    for (int k = 0; k < 4; ++k) { us += S[r][k] * ka0[k] + S[r][4 + k] * ka1[k]; if (dir == 1) ys += S[r][k] * r0[k] + S[r][4 + k] * r1[k]; }
                    u[r] = oct_sum(us); y[r] = ys;
                }
#pragma unroll
                for (int r = 0; r < 2; ++r) {
                    const float vr = r == 0 ? v2.x : v2.y;
#pragma unroll
                    for (int k = 0; k < 4; ++k) { S[r][k] = S[r][k] * d0[k] - u[r] * b0[k] + vr * k0[k]; S[r][4 + k] = S[r][4 + k] * d1[k] - u[r] * b1[k] + vr * k1[k]; }
                }
                if (dir == 0) {
#pragma unroll
                    for (int r = 0; r < 2; ++r) { float ys = 0.f;
#pragma unroll
                        for (int k = 0; k < 4; ++k) ys += S[r][k] * r0[k] + S[r][4 + k] * r1[k];
                        y[r] = ys; }
                }
                y[0] = oct_sum(y[0]); y[1] = oct_sum(y[1]);
                if (cg == 0) *(LAS f32x2*)(YL + (dir * 16 + s) * 64 + 16 * wq + 2 * rp) = (f32x2){y[0], y[1]};
            }
            __syncthreads();
            for (int idx = t.tid; idx < 2048; idx += 512) { const int d_ = idx >> 10, s = (idx >> 6) & 15, c = idx & 63;
                const int tl = d_ == 0 ? 16 * jj + s : Tseq - 1 - (16 * jj + s);
                (d_ ? Yb : Yf)[(size_t)(mbase + tl) * 1024 + 64 * h + c] = f2bf(YL[idx]); }
            if (blk + 1 < 144) SCAN_PREP(blk + 1);
        }
#undef SCAN_LOADS
#undef SCAN_PREP
    }
}


typedef short bf16x4 __attribute__((ext_vector_type(4)));
__device__ __forceinline__ bf16x4 pack4(const f32x4 v) { const u32x2 p = {cvt_pk_bf16(v[0], v[1]), cvt_pk_bf16(v[2], v[3])}; return __builtin_bit_cast(bf16x4, p); }
#define MFMA16(a_, b_, c_) __builtin_amdgcn_mfma_f32_16x16x16bf16_1k((a_), (b_), (c_), 0, 0, 0)
__device__ __forceinline__ void ph_scan3(KArgP a, int l, LAS unsigned char* lds, const Th& t) {
    LAS unsigned short* ZA = (LAS unsigned short*)(lds);
    LAS float* PART = (LAS float*)(lds + 9216);
    LAS float* YL = (LAS float*)(lds + 10240);
    LAS unsigned short* TS = (LAS unsigned short*)(lds + 18432);
    LAS unsigned short* CS = (LAS unsigned short*)(lds + 35840);
    LAS float* GAM = (LAS float*)(lds + 51200);
    const bf16_t* Zr = (const bf16_t*)(a->ws + WS_ZR);
    bf16_t* Yf = (bf16_t*)(a->ws + WS_Y); bf16_t* Yb = Yf + (size_t)MALL * 1024;
    float* BON = (float*)(a->ws + WS_BON);
    const float* scw = a->in[I_SHIFT] + (size_t)l * 3 * NRW;
    const int lane = t.lane, wv = t.wv, dir = wv >> 2, wq = wv & 3, fr = lane & 15, fq = lane >> 4;
    LAS unsigned short* TSd = TS + dir * (4 * 16 * 68); LAS unsigned short* CSd = CS + dir * (3 * 64 * 20);
    for (int unit = t.bid; unit < 256; unit += t.G) {
        const int b = unit >> 4, h = unit & 15;
        const int cl = 16 * wq + fr, ch = 64 * h + cl;
        bf16x8 bw[2], ba[2];
        {
            const float* w2p = a->in[I_W2] + ((size_t)(l * 2 + dir) * 64) * 1024 + ch; const float* a2p = a->in[I_A2] + ((size_t)(l * 2 + dir) * 64) * 1024 + ch;
#pragma unroll
            for (int ks = 0; ks < 2; ++ks) { unsigned pw[4], pa[4];
#pragma unroll
                for (int e = 0; e < 4; ++e) { const int k0 = 32 * ks + 8 * fq + 2 * e;
                    pw[e] = cvt_pk_bf16(w2p[(size_t)k0 * 1024], w2p[(size_t)(k0 + 1) * 1024]); pa[e] = cvt_pk_bf16(a2p[(size_t)k0 * 1024], a2p[(size_t)(k0 + 1) * 1024]); }
                bw[ks] = __builtin_bit_cast(bf16x8, (u32x4){pw[0], pw[1], pw[2], pw[3]}); ba[ks] = __builtin_bit_cast(bf16x8, (u32x4){pa[0], pa[1], pa[2], pa[3]}); }
        }
        const float w0v = a->in[I_W0][(l * 2 + dir) * 1024 + ch], a0v = a->in[I_A0][(l * 2 + dir) * 1024 + ch];
        const float kkv = a->in[I_KK][l * 1024 + ch], kav = a->in[I_KA][l * 1024 + ch], rkv = a->in[I_RK][l * 1024 + ch];
        float swr[3], swk[3], swv[3], swz[3], swy[3];
        const int zcol = 3072 + 64 * dir + lane;
#pragma unroll
        for (int j = 0; j < 3; ++j) { swr[j] = scw[j * NRW + ch]; swk[j] = scw[j * NRW + 1024 + ch]; swv[j] = scw[j * NRW + 2048 + ch]; swz[j] = scw[j * NRW + zcol]; swy[j] = scw[j * NRW + zcol + 128]; }
        f32x4 Sreg[4];
#pragma unroll
        for (int k = 0; k < 4; ++k) Sreg[k] = (f32x4){0.f, 0.f, 0.f, 0.f};
        f32x4 Idm;
#pragma unroll
        for (int j = 0; j < 4; ++j) Idm[j] = (4 * fq + j == fr) ? 1.0f : 0.0f;
        unsigned short pr[6], pk[6], pv[6], pz[6], py[6];
#define SCAN_LOADS(blk_) do { const int blk__ = (blk_); const bool isctx__ = blk__ < 16; const int jj__ = isctx__ ? blk__ : blk__ - 16; const int Tseq__ = isctx__ ? TC : TL; \
            const int mbase__ = isctx__ ? (MLAT + b * TC) : b * TL; const int t0__ = dir == 0 ? 16 * jj__ : Tseq__ - 16 * (jj__ + 1); \
            _Pragma("unroll") for (int e = 0; e < 6; ++e) { int rr = t0__ + 4 * fq - 1 + e; rr = rr < 0 ? 0 : (rr >= Tseq__ ? Tseq__ - 1 : rr); const bf16_t* zz = Zr + (size_t)(mbase__ + rr) * ZR_LD + ch; \
                pr[e] = zz[0]; pk[e] = zz[1024]; pv[e] = zz[2048]; } \
            _Pragma("unroll") for (int e = 0; e < 6; ++e) { int rr = t0__ + 4 * wq - 1 + e; rr = rr < 0 ? 0 : (rr >= Tseq__ ? Tseq__ - 1 : rr); const bf16_t* zz = Zr + (size_t)(mbase__ + rr) * ZR_LD + zcol; \
                pz[e] = zz[0]; py[e] = zz[128]; } } while (0)
        __syncthreads();
        SCAN_LOADS(0);
        for (int blk = 0; blk < 144; ++blk) {
            const bool isctx = blk < 16; const int jj = isctx ? blk : blk - 16; const int Tseq = isctx ? TC : TL;
            const int mbase = isctx ? (MLAT + b * TC) : b * TL; const int t0 = dir == 0 ? 16 * jj : Tseq - 16 * (jj + 1);
            if (fq == 0 && t0 == 0) { pr[0] = 0; pk[0] = 0; pv[0] = 0; }
            if (fq == 3 && t0 + 16 == Tseq) { pr[5] = 0; pk[5] = 0; pv[5] = 0; }
            if (wq == 0 && t0 == 0) { pz[0] = 0; py[0] = 0; }
            if (wq == 3 && t0 + 16 == Tseq) { pz[5] = 0; py[5] = 0; }
            float r4[4], k4[4], v4[4];
#pragma unroll
            for (int j = 0; j < 4; ++j) { r4[j] = swr[0] * bf2f(pr[j]) + swr[1] * bf2f(pr[j + 1]) + swr[2] * bf2f(pr[j + 2]);
                k4[j] = swk[0] * bf2f(pk[j]) + swk[1] * bf2f(pk[j + 1]) + swk[2] * bf2f(pk[j + 2]); v4[j] = swv[0] * bf2f(pv[j]) + swv[1] * bf2f(pv[j + 1]) + swv[2] * bf2f(pv[j + 2]); }
#pragma unroll
            for (int j = 0; j < 4; ++j) { const float zw = fast_tanh(swz[0] * bf2f(pz[j]) + swz[1] * bf2f(pz[j + 1]) + swz[2] * bf2f(pz[j + 2])); const float za = swy[0] * bf2f(py[j]) + swy[1] * bf2f(py[j + 1]) + swy[2] * bf2f(py[j + 2]);
                ZA[((dir * 2 + 0) * 16 + 4 * wq + j) * 72 + lane] = f2bf(zw); ZA[((dir * 2 + 1) * 16 + 4 * wq + j) * 72 + lane] = f2bf(za); }
            lds_barrier();
            if (blk + 1 < 144) SCAN_LOADS(blk + 1);
            f32x4 lw = (f32x4){0.f, 0.f, 0.f, 0.f}, la = (f32x4){0.f, 0.f, 0.f, 0.f};
#pragma unroll
            for (int ks = 0; ks < 2; ++ks) {
                const bf16x8 aw = *(const LAS bf16x8*)(ZA + ((dir * 2 + 0) * 16 + fr) * 72 + 32 * ks + 8 * fq); const bf16x8 aa = *(const LAS bf16x8*)(ZA + ((dir * 2 + 1) * 16 + fr) * 72 + 32 * ks + 8 * fq);
                lw = __builtin_amdgcn_mfma_f32_16x16x32_bf16(aw, bw[ks], lw, 0, 0, 0); la = __builtin_amdgcn_mfma_f32_16x16x32_bf16(aa, ba[ks], la, 0, 0, 0); }
            float dc4[4], av4[4], kr4[4], kd4[4];
#pragma unroll
            for (int j = 0; j < 4; ++j) { dc4[j] = __builtin_amdgcn_exp2f(-0.87503877f * fast_sigmoid(w0v + lw[j])); av4[j] = fast_sigmoid(a0v + la[j]);
                kr4[j] = k4[j] * kkv; kd4[j] = k4[j] * (1.0f + (av4[j] - 1.0f) * kav);
                const float pn = row16_sum(kr4[j] * kr4[j]); const float pb = row16_sum(r4[j] * kd4[j] * rkv);
                if (fr == 0) *(LAS f32x2*)(PART + ((dir * 16 + 4 * fq + j) * 4 + wq) * 2) = (f32x2){pn, pb}; }
            lds_barrier();
            {
                float kap[4], bet[4];
#pragma unroll
                for (int j = 0; j < 4; ++j) { const int ti = 4 * fq + j; const f32x4 p0 = *(const LAS f32x4*)(PART + (dir * 16 + ti) * 8), p1 = *(const LAS f32x4*)(PART + (dir * 16 + ti) * 8 + 4);
                    const float nrm = (p0[0] + p0[2]) + (p1[0] + p1[2]); kap[j] = kr4[j] * rsqrtf(fmaxf(nrm, 1e-12f)); bet[j] = kap[j] * av4[j];
                    if (dir == 0 && wq == 0 && fr == 0) BON[(size_t)(mbase + t0 + ti) * 16 + h] = (p0[1] + p0[3]) + (p1[1] + p1[3]); }
                const float g = (dc4[0] * dc4[1]) * (dc4[2] * dc4[3]);
                const float g0 = __shfl(g, fr), g1 = __shfl(g, fr + 16), g2 = __shfl(g, fr + 32), g3 = __shfl(g, fr + 48);
                const float gall = (g0 * g1) * (g2 * g3);
                const float pre = dir == 0 ? (fq == 0 ? 1.0f : fq == 1 ? g0 : fq == 2 ? g0 * g1 : g0 * g1 * g2) : (fq == 3 ? 1.0f : fq == 2 ? g3 : fq == 1 ? g3 * g2 : g3 * g2 * g1);
                float dcs[4], kps[4], bts[4], kds[4], rs[4], vs[4];
#pragma unroll
                for (int e = 0; e < 4; ++e) { dcs[e] = dir ? dc4[3 - e] : dc4[e]; kps[e] = dir ? kap[3 - e] : kap[e]; bts[e] = dir ? bet[3 - e] : bet[e];
                    kds[e] = dir ? kd4[3 - e] : kd4[e]; rs[e] = dir ? r4[3 - e] : r4[e]; vs[e] = dir ? v4[3 - e] : v4[e]; }
                const int sg = dir ? 3 - fq : fq;
                float run = pre; f32x4 kpv, bpv, vvv;
#pragma unroll
                for (int e = 0; e < 4; ++e) { const float gm1 = run; run *= dcs[e]; const float inv = __builtin_amdgcn_rcpf(run);
                    const float ktv = kps[e] * gm1, rtv = rs[e] * (dir ? gm1 : run), khv = kds[e] * inv, bhv = bts[e] * inv;
                    kpv[e] = khv * gall; bpv[e] = -(bhv * gall); vvv[e] = vs[e];
                    const int so = (4 * sg + e) * 68 + cl;
                    TSd[so] = f2bf(ktv); TSd[16 * 68 + so] = f2bf(rtv); TSd[2 * 16 * 68 + so] = f2bf(khv); TSd[3 * 16 * 68 + so] = f2bf(bhv); }
                *(LAS bf16x4*)(CSd + cl * 20 + 4 * sg) = pack4(kpv); *(LAS bf16x4*)(CSd + 64 * 20 + cl * 20 + 4 * sg) = pack4(bpv); *(LAS bf16x4*)(CSd + 2 * 64 * 20 + cl * 20 + 4 * sg) = pack4(vvv);
                if (fq == 0) GAM[dir * 64 + cl] = gall;
            }
            lds_barrier();
            {
                bf16x4 kt[4], rt[4], kh[4], bh[4];
#pragma unroll
                for (int ks = 0; ks < 4; ++ks) { const int o = fr * 68 + 16 * ks + 4 * fq;
                    kt[ks] = *(const LAS bf16x4*)(TSd + o); rt[ks] = *(const LAS bf16x4*)(TSd + 16 * 68 + o); kh[ks] = *(const LAS bf16x4*)(TSd + 2 * 16 * 68 + o); bh[ks] = *(const LAS bf16x4*)(TSd + 3 * 16 * 68 + o); }
                const bf16x4 vtf = *(const LAS bf16x4*)(CSd + 2 * 64 * 20 + cl * 20 + 4 * fq);
                f32x4 AkD = (f32x4){0.f, 0.f, 0.f, 0.f}, ND = AkD, ArkD = AkD, ArbD = AkD, NtD = AkD;
#pragma unroll
                for (int ks = 0; ks < 4; ++ks) { AkD = MFMA16(kh[ks], kt[ks], AkD); ND = MFMA16(bh[ks], kt[ks], ND); ArkD = MFMA16(kh[ks], rt[ks], ArkD); ArbD = MFMA16(bh[ks], rt[ks], ArbD); NtD = MFMA16(kt[ks], bh[ks], NtD); }
#pragma unroll
                for (int j = 0; j < 4; ++j) { const int i = 4 * fq + j; const bool st = i < fr; const bool inc = dir ? (i < fr) : (i <= fr);
                    AkD[j] = st ? AkD[j] : 0.f; ND[j] = st ? ND[j] : 0.f; ArkD[j] = inc ? ArkD[j] : 0.f; ArbD[j] = inc ? -ArbD[j] : 0.f; NtD[j] = (fr < i) ? NtD[j] : 0.f; }
                const f32x4 Z4 = (f32x4){0.f, 0.f, 0.f, 0.f};
                const bf16x4 pN = pack4(ND), pNt = pack4(NtD);
                const f32x4 N2 = MFMA16(pNt, pN, Z4), N2t = MFMA16(pN, pNt, Z4);
                const bf16x4 pN2 = pack4(N2), pN2t = pack4(N2t);
                const f32x4 N4 = MFMA16(pN2t, pN2, Z4), N4t = MFMA16(pN2, pN2t, Z4);
                const f32x4 N8 = MFMA16(pack4(N4t), pack4(N4), Z4);
                const bf16x4 pImNt = pack4(Idm - NtD), pIpN2 = pack4(Idm + N2);
                const f32x4 T1t = MFMA16(pIpN2, pImNt, Z4);
                const f32x4 T2 = MFMA16(pack4(Idm + N4t), pack4(Idm + N8), Z4);
                const f32x4 TD = MFMA16(pack4(T1t), pack4(T2), Z4);
                bf16x4 sb[4];
#pragma unroll
                for (int ks = 0; ks < 4; ++ks) sb[ks] = pack4(Sreg[ks]);
                f32x4 Pt = Z4, Yt = Z4;
#pragma unroll
                for (int ks = 0; ks < 4; ++ks) { Pt = MFMA16(kt[ks], sb[ks], Pt); Yt = MFMA16(rt[ks], sb[ks], Yt); }
                const f32x4 Qt = MFMA16(pack4(AkD), vtf, Pt);
                const f32x4 Ut = MFMA16(pack4(TD), pack4(Qt), Z4);
                const bf16x4 ub = pack4(Ut);
                Yt = MFMA16(pack4(ArkD), vtf, Yt); Yt = MFMA16(pack4(ArbD), ub, Yt);
#pragma unroll
                for (int ks = 0; ks < 4; ++ks) {
                    const f32x4 gm = *(const LAS f32x4*)(GAM + dir * 64 + 16 * ks + 4 * fq);
                    const bf16x4 kpf = *(const LAS bf16x4*)(CSd + (16 * ks + fr) * 20 + 4 * fq), bpf = *(const LAS bf16x4*)(CSd + 64 * 20 + (16 * ks + fr) * 20 + 4 * fq);
                    f32x4 c = Sreg[ks] * gm; c = MFMA16(kpf, vtf, c); c = MFMA16(bpf, ub, c); Sreg[ks] = c; }
                bf16_t* yo = (dir ? Yb : Yf) + (size_t)mbase * 1024 + 64 * h + cl;
#pragma unroll
                for (int j = 0; j < 4; ++j) { const int sidx = 4 * fq + j; const int tl = dir == 0 ? 16 * jj + sidx : Tseq - 1 - (16 * jj + sidx); yo[(size_t)tl * 1024] = f2bf(Yt[j]); }
            }
        }
#undef SCAN_LOADS
    }
}

__device__ __forceinline__ void ph_scan4(KArgP a, int l, LAS unsigned char* lds, const Th& t) {
    LAS unsigned short* ZA = (LAS unsigned short*)(lds);
    LAS float* PART = (LAS float*)(lds + 9216);
    LAS unsigned short* TS = (LAS unsigned short*)(lds + 10496);
    LAS unsigned short* CS = (LAS unsigned short*)(lds + 45312);
    LAS float* GAM = (LAS float*)(lds + 76032);
    const bf16_t* Zr = (const bf16_t*)(a->ws + WS_ZR);
    bf16_t* Yf = (bf16_t*)(a->ws + WS_Y); bf16_t* Yb = Yf + (size_t)MALL * 1024;
    float* BON = (float*)(a->ws + WS_BON); float* DUMMY = (float*)(a->ws + WS_CTL + 512 * 1024);
    const float* scw = a->in[I_SHIFT] + (size_t)l * 3 * NRW;
    LAS bf16x8* BF = (LAS bf16x8*)(lds + 77056);
    const int lane = t.lane, wv = t.wv, dir = wv >> 2, wq = wv & 3, fr = lane & 15, fq = lane >> 4;
    for (int unit = t.bid; unit < 256; unit += t.G) {
        const int b = unit >> 4, h = unit & 15;
        const int cl = 16 * wq + fr, ch = 64 * h + cl;
        {
            bf16x8 bw[2], ba[2];
            const float* w2p = a->in[I_W2] + ((size_t)(l * 2 + dir) * 64) * 1024 + ch; const float* a2p = a->in[I_A2] + ((size_t)(l * 2 + dir) * 64) * 1024 + ch;
#pragma unroll
            for (int ks = 0; ks < 2; ++ks) { unsigned pw[4], pa[4];
#pragma unroll
                for (int e = 0; e < 4; ++e) { const int k0 = 32 * ks + 8 * fq + 2 * e;
                    pw[e] = cvt_pk_bf16(w2p[(size_t)k0 * 1024], w2p[(size_t)(k0 + 1) * 1024]); pa[e] = cvt_pk_bf16(a2p[(size_t)k0 * 1024], a2p[(size_t)(k0 + 1) * 1024]); }
                bw[ks] = __builtin_bit_cast(bf16x8, (u32x4){pw[0], pw[1], pw[2], pw[3]}); ba[ks] = __builtin_bit_cast(bf16x8, (u32x4){pa[0], pa[1], pa[2], pa[3]}); }
            __syncthreads();
#pragma unroll
            for (int ks = 0; ks < 2; ++ks) { BF[(ks * 2 + 0) * 512 + t.tid] = bw[ks]; BF[(ks * 2 + 1) * 512 + t.tid] = ba[ks]; }
        }
        const float w0v = a->in[I_W0][(l * 2 + dir) * 1024 + ch], a0v = a->in[I_A0][(l * 2 + dir) * 1024 + ch];
        const float kkv = a->in[I_KK][l * 1024 + ch], kav = a->in[I_KA][l * 1024 + ch], rkv = a->in[I_RK][l * 1024 + ch];
        float swr[3], swk[3], swv[3], swz[3], swy[3];
        const int zcol = 3072 + 64 * dir + lane;
#pragma unroll
        for (int j = 0; j < 3; ++j) { swr[j] = scw[j * NRW + ch]; swk[j] = scw[j * NRW + 1024 + ch]; swv[j] = scw[j * NRW + 2048 + ch]; swz[j] = scw[j * NRW + zcol]; swy[j] = scw[j * NRW + zcol + 128]; }
        f32x4 Sreg[4];
#pragma unroll
        for (int k = 0; k < 4; ++k) Sreg[k] = (f32x4){0.f, 0.f, 0.f, 0.f};
        f32x4 Idm;
#pragma unroll
        for (int j = 0; j < 4; ++j) Idm[j] = (4 * fq + j == fr) ? 1.0f : 0.0f;
        unsigned short pr[6], pk[6], pv[6], pz[6], py[6];
#define SCAN_LOADS(blk_) do { const int blk__ = (blk_); const bool isctx__ = blk__ < 16; const int jj__ = isctx__ ? blk__ : blk__ - 16; const int Tseq__ = isctx__ ? TC : TL; \
            const int mbase__ = isctx__ ? (MLAT + b * TC) : b * TL; const int t0__ = dir == 0 ? 16 * jj__ : Tseq__ - 16 * (jj__ + 1); \
            _Pragma("unroll") for (int e = 0; e < 6; ++e) { int rr = t0__ + 4 * fq - 1 + e; rr = rr < 0 ? 0 : (rr >= Tseq__ ? Tseq__ - 1 : rr); const bf16_t* zz = Zr + (size_t)(mbase__ + rr) * ZR_LD + ch; \
                pr[e] = zz[0]; pk[e] = zz[1024]; pv[e] = zz[2048]; } \
            _Pragma("unroll") for (int e = 0; e < 6; ++e) { int rr = t0__ + 4 * wq - 1 + e; rr = rr < 0 ? 0 : (rr >= Tseq__ ? Tseq__ - 1 : rr); const bf16_t* zz = Zr + (size_t)(mbase__ + rr) * ZR_LD + zcol; \
                pz[e] = zz[0]; py[e] = zz[128]; } } while (0)
        float r4[4], k4[4], v4[4], dc4[4], av4[4], kr4[4], kd4[4];
        bf16x4 pAk, pArk, pArb, pT;
#define BLKINFO(blk_) const int blk__ = (blk_); const bool isctx__ = blk__ < 16; const int jj__ = isctx__ ? blk__ : blk__ - 16; const int Tseq__ = isctx__ ? TC : TL; \
            const int mbase__ = isctx__ ? (MLAT + b * TC) : b * TL; const int t0__ = dir == 0 ? 16 * jj__ : Tseq__ - 16 * (jj__ + 1); (void)mbase__; (void)t0__
#define SC_E1(blk_) do { BLKINFO(blk_); \
            if (fq == 0 && t0__ == 0) { pr[0] = 0; pk[0] = 0; pv[0] = 0; } \
            if (fq == 3 && t0__ + 16 == Tseq__) { pr[5] = 0; pk[5] = 0; pv[5] = 0; } \
            if (wq == 0 && t0__ == 0) { pz[0] = 0; py[0] = 0; } \
            if (wq == 3 && t0__ + 16 == Tseq__) { pz[5] = 0; py[5] = 0; } \
            _Pragma("unroll") for (int j = 0; j < 4; ++j) { r4[j] = swr[0] * bf2f(pr[j]) + swr[1] * bf2f(pr[j + 1]) + swr[2] * bf2f(pr[j + 2]); \
                k4[j] = swk[0] * bf2f(pk[j]) + swk[1] * bf2f(pk[j + 1]) + swk[2] * bf2f(pk[j + 2]); v4[j] = swv[0] * bf2f(pv[j]) + swv[1] * bf2f(pv[j + 1]) + swv[2] * bf2f(pv[j + 2]); } \
            _Pragma("unroll") for (int j = 0; j < 4; ++j) { const float zw = fast_tanh(swz[0] * bf2f(pz[j]) + swz[1] * bf2f(pz[j + 1]) + swz[2] * bf2f(pz[j + 2])); const float za = swy[0] * bf2f(py[j]) + swy[1] * bf2f(py[j + 1]) + swy[2] * bf2f(py[j + 2]); \
                ZA[((dir * 2 + 0) * 16 + 4 * wq + j) * 72 + lane] = f2bf(zw); ZA[((dir * 2 + 1) * 16 + 4 * wq + j) * 72 + lane] = f2bf(za); } } while (0)
#define SC_E2() do { \
            f32x4 lw = (f32x4){0.f, 0.f, 0.f, 0.f}, la = (f32x4){0.f, 0.f, 0.f, 0.f}; \
            _Pragma("unroll") for (int ks = 0; ks < 2; ++ks) { \
                const bf16x8 aw = *(const LAS bf16x8*)(ZA + ((dir * 2 + 0) * 16 + fr) * 72 + 32 * ks + 8 * fq); const bf16x8 aa = *(const LAS bf16x8*)(ZA + ((dir * 2 + 1) * 16 + fr) * 72 + 32 * ks + 8 * fq); \
                lw = __builtin_amdgcn_mfma_f32_16x16x32_bf16(aw, BF[(ks * 2 + 0) * 512 + t.tid], lw, 0, 0, 0); la = __builtin_amdgcn_mfma_f32_16x16x32_bf16(aa, BF[(ks * 2 + 1) * 512 + t.tid], la, 0, 0, 0); } \
            _Pragma("unroll") for (int j = 0; j < 4; ++j) { dc4[j] = __builtin_amdgcn_exp2f(-0.87503877f * fast_sigmoid(w0v + lw[j])); av4[j] = fast_sigmoid(a0v + la[j]); \
                kr4[j] = k4[j] * kkv; kd4[j] = k4[j] * (1.0f + (av4[j] - 1.0f) * kav); \
                const float pn = row16_sum(kr4[j] * kr4[j]); const float pb = row16_sum(r4[j] * kd4[j] * rkv); \
                *(LAS f32x2*)(PART + (fr == 0 ? ((dir * 16 + 4 * fq + j) * 4 + wq) * 2 : 256 + 2 * (lane & 7))) = (f32x2){pn, pb}; } } while (0)
#define SC_E3(blk_, buf_) do { BLKINFO(blk_); \
            LAS unsigned short* TSd = TS + ((buf_) * 2 + dir) * (4 * 16 * 68); LAS unsigned short* CSd = CS + ((buf_) * 2 + dir) * (3 * 64 * 20); \
            float kap[4], bet[4]; \
            _Pragma("unroll") for (int j = 0; j < 4; ++j) { const int ti = 4 * fq + j; const f32x4 p0 = *(const LAS f32x4*)(PART + (dir * 16 + ti) * 8), p1 = *(const LAS f32x4*)(PART + (dir * 16 + ti) * 8 + 4); \
                const float nrm = (p0[0] + p0[2]) + (p1[0] + p1[2]); kap[j] = kr4[j] * rsqrtf(fmaxf(nrm, 1e-12f)); bet[j] = kap[j] * av4[j]; \
                float* bo = (dir == 0 && wq == 0 && fr == 0) ? BON + (size_t)(mbase__ + t0__ + ti) * 16 + h : DUMMY + lane; *bo = (p0[1] + p0[3]) + (p1[1] + p1[3]); } \
            const float g = (dc4[0] * dc4[1]) * (dc4[2] * dc4[3]); \
            const float g0 = __shfl(g, fr), g1 = __shfl(g, fr + 16), g2 = __shfl(g, fr + 32), g3 = __shfl(g, fr + 48); \
            const float gall = (g0 * g1) * (g2 * g3); \
            const float pre = dir == 0 ? (fq == 0 ? 1.0f : fq == 1 ? g0 : fq == 2 ? g0 * g1 : g0 * g1 * g2) : (fq == 3 ? 1.0f : fq == 2 ? g3 : fq == 1 ? g3 * g2 : g3 * g2 * g1); \
            float dcs[4], kps[4], bts[4], kds[4], rs[4], vs[4]; \
            _Pragma("unroll") for (int e = 0; e < 4; ++e) { dcs[e] = dir ? dc4[3 - e] : dc4[e]; kps[e] = dir ? kap[3 - e] : kap[e]; bts[e] = dir ? bet[3 - e] : bet[e]; \
                kds[e] = dir ? kd4[3 - e] : kd4[e]; rs[e] = dir ? r4[3 - e] : r4[e]; vs[e] = dir ? v4[3 - e] : v4[e]; } \
            const int sg = dir ? 3 - fq : fq; \
            float run = pre; f32x4 kpv, bpv, vvv; \
            _Pragma("unroll") for (int e = 0; e < 4; ++e) { const float gm1 = run; run *= dcs[e]; const float inv = __builtin_amdgcn_rcpf(run); \
                const float ktv = kps[e] * gm1, rtv = rs[e] * (dir ? gm1 : run), khv = kds[e] * inv, bhv = bts[e] * inv; \
                kpv[e] = khv * gall; bpv[e] = -(bhv * gall); vvv[e] = vs[e]; \
                const int so = (4 * sg + e) * 68 + cl; \
                TSd[so] = f2bf(ktv); TSd[16 * 68 + so] = f2bf(rtv); TSd[2 * 16 * 68 + so] = f2bf(khv); TSd[3 * 16 * 68 + so] = f2bf(bhv); } \
            *(LAS bf16x4*)(CSd + cl * 20 + 4 * sg) = pack4(kpv); *(LAS bf16x4*)(CSd + 64 * 20 + cl * 20 + 4 * sg) = pack4(bpv); *(LAS bf16x4*)(CSd + 2 * 64 * 20 + cl * 20 + 4 * sg) = pack4(vvv); \
            GAM[((buf_) * 2 + dir) * 64 + cl] = gall; } while (0)
#define SC_MA(buf_) do { \
            const LAS unsigned short* TSd = TS + ((buf_) * 2 + dir) * (4 * 16 * 68); \
            bf16x4 kt[4], rt[4], kh[4], bh[4]; \
            _Pragma("unroll") for (int ks = 0; ks < 4; ++ks) { const int o = fr * 68 + 16 * ks + 4 * fq; \
                kt[ks] = *(const LAS bf16x4*)(TSd + o); rt[ks] = *(const LAS bf16x4*)(TSd + 16 * 68 + o); kh[ks] = *(const LAS bf16x4*)(TSd + 2 * 16 * 68 + o); bh[ks] = *(const LAS bf16x4*)(TSd + 3 * 16 * 68 + o); } \
            f32x4 AkD = (f32x4){0.f, 0.f, 0.f, 0.f}, ND = AkD, ArkD = AkD, ArbD = AkD, NtD = AkD; \
            _Pragma("unroll") for (int ks = 0; ks < 4; ++ks) { AkD = MFMA16(kh[ks], kt[ks], AkD); ND = MFMA16(bh[ks], kt[ks], ND); ArkD = MFMA16(kh[ks], rt[ks], ArkD); ArbD = MFMA16(bh[ks], rt[ks], ArbD); NtD = MFMA16(kt[ks], bh[ks], NtD); } \
            _Pragma("unroll") for (int j = 0; j < 4; ++j) { const int i = 4 * fq + j; const bool st = i < fr; const bool inc = dir ? (i < fr) : (i <= fr); \
                AkD[j] = st ? AkD[j] : 0.f; ND[j] = st ? ND[j] : 0.f; ArkD[j] = inc ? ArkD[j] : 0.f; ArbD[j] = inc ? -ArbD[j] : 0.f; NtD[j] = (fr < i) ? NtD[j] : 0.f; } \
            const f32x4 Z4 = (f32x4){0.f, 0.f, 0.f, 0.f}; \
            const bf16x4 pN = pack4(ND), pNt = pack4(NtD); \
            const f32x4 N2 = MFMA16(pNt, pN, Z4), N2t = MFMA16(pN, pNt, Z4); \
            const bf16x4 pN2 = pack4(N2), pN2t = pack4(N2t); \
            const f32x4 N4 = MFMA16(pN2t, pN2, Z4), N4t = MFMA16(pN2, pN2t, Z4); \
            const f32x4 N8 = MFMA16(pack4(N4t), pack4(N4), Z4); \
            const f32x4 T1t = MFMA16(pack4(Idm + N2), pack4(Idm - NtD), Z4); \
            const f32x4 T2 = MFMA16(pack4(Idm + N4t), pack4(Idm + N8), Z4); \
            const f32x4 TD = MFMA16(pack4(T1t), pack4(T2), Z4); \
            pAk = pack4(AkD); pArk = pack4(ArkD); pArb = pack4(ArbD); pT = pack4(TD); } while (0)
#define SC_MB(blk_, buf_) do { BLKINFO(blk_); \
            const LAS unsigned short* TSd = TS + ((buf_) * 2 + dir) * (4 * 16 * 68); const LAS unsigned short* CSd = CS + ((buf_) * 2 + dir) * (3 * 64 * 20); \
            bf16x4 kt[4], rt[4], sb[4]; \
            _Pragma("unroll") for (int ks = 0; ks < 4; ++ks) { const int o = fr * 68 + 16 * ks + 4 * fq; kt[ks] = *(const LAS bf16x4*)(TSd + o); rt[ks] = *(const LAS bf16x4*)(TSd + 16 * 68 + o); sb[ks] = pack4(Sreg[ks]); } \
            const bf16x4 vtf = *(const LAS bf16x4*)(CSd + 2 * 64 * 20 + cl * 20 + 4 * fq); \
            const f32x4 Z4 = (f32x4){0.f, 0.f, 0.f, 0.f}; f32x4 Pt = Z4, Yt = Z4; \
            _Pragma("unroll") for (int ks = 0; ks < 4; ++ks) { Pt = MFMA16(kt[ks], sb[ks], Pt); Yt = MFMA16(rt[ks], sb[ks], Yt); } \
            const f32x4 Qt = MFMA16(pAk, vtf, Pt); \
            const f32x4 Ut = MFMA16(pT, pack4(Qt), Z4); \
            const bf16x4 ub = pack4(Ut); \
            Yt = MFMA16(pArk, vtf, Yt); Yt = MFMA16(pArb, ub, Yt); \
            _Pragma("unroll") for (int ks = 0; ks < 4; ++ks) { \
                const f32x4 gm = *(const LAS f32x4*)(GAM + ((buf_) * 2 + dir) * 64 + 16 * ks + 4 * fq); \
                const bf16x4 kpf = *(const LAS bf16x4*)(CSd + (16 * ks + fr) * 20 + 4 * fq), bpf = *(const LAS bf16x4*)(CSd + 64 * 20 + (16 * ks + fr) * 20 + 4 * fq); \
                f32x4 c = Sreg[ks] * gm; c = MFMA16(kpf, vtf, c); c = MFMA16(bpf, ub, c); Sreg[ks] = c; } \
            bf16_t* yo = (dir ? Yb : Yf) + (size_t)mbase__ * 1024 + 64 * h + cl; \
            _Pragma("unroll") for (int j = 0; j < 4; ++j) { const int sidx = 4 * fq + j; const int tl = dir == 0 ? 16 * jj__ + sidx : Tseq__ - 1 - (16 * jj__ + sidx); yo[(size_t)tl * 1024] = f2bf(Yt[j]); } } while (0)
        __syncthreads();
        SCAN_LOADS(0);
        SC_E1(0); lds_barrier();
        SCAN_LOADS(1);
        SC_E2(); lds_barrier();
        SC_E3(0, 0); lds_barrier();
        for (int blk = 0; blk < 144; ++blk) {
            const int nb = blk + 1 < 144 ? blk + 1 : 143, nb2 = blk + 2 < 144 ? blk + 2 : 143, buf = blk & 1;
            SC_E1(nb);
            lds_barrier();
            SCAN_LOADS(nb2);
            SC_E2(); SC_MA(buf);
            lds_barrier();
            SC_E3(nb, buf ^ 1); SC_MB(blk, buf);
            lds_barrier();
        }
#undef BLKINFO
#undef SC_E1
#undef SC_E2
#undef SC_E3
#undef SC_MA
#undef SC_MB
#undef SCAN_LOADS
    }
}

__device__ __forceinline__ void row16_sum8(float (&x)[8]) {
#define R16_STEP(ctl) \
    "v_add_f32_dpp %0, %0, %0 " ctl " row_mask:0xf bank_mask:0xf\n v_add_f32_dpp %1, %1, %1 " ctl " row_mask:0xf bank_mask:0xf\n v_add_f32_dpp %2, %2, %2 " ctl " row_mask:0xf bank_mask:0xf\n v_add_f32_dpp %3, %3, %3 " ctl " row_mask:0xf bank_mask:0xf\n" \
    "v_add_f32_dpp %4, %4, %4 " ctl " row_mask:0xf bank_mask:0xf\n v_add_f32_dpp %5, %5, %5 " ctl " row_mask:0xf bank_mask:0xf\n v_add_f32_dpp %6, %6, %6 " ctl " row_mask:0xf bank_mask:0xf\n v_add_f32_dpp %7, %7, %7 " ctl " row_mask:0xf bank_mask:0xf\n"
    asm volatile("s_nop 1\n" R16_STEP("quad_perm:[1,0,3,2]") R16_STEP("quad_perm:[2,3,0,1]") R16_STEP("row_half_mirror") R16_STEP("row_mirror")
                 : "+v"(x[0]), "+v"(x[1]), "+v"(x[2]), "+v"(x[3]), "+v"(x[4]), "+v"(x[5]), "+v"(x[6]), "+v"(x[7]));
#undef R16_STEP
}

__device__ __forceinline__ void ph_scan5(KArgP a, int l, LAS unsigned char* lds, const Th& t) {
    LAS unsigned short* ZA = (LAS unsigned short*)(lds);
    LAS float* PART = (LAS float*)(lds + 9216);
    LAS unsigned short* TS = (LAS unsigned short*)(lds + 10496);
    LAS unsigned short* CS = (LAS unsigned short*)(lds + 45312);
    LAS float* GAM = (LAS float*)(lds + 76032);
    LAS bf16x8* BF = (LAS bf16x8*)(lds + 77056);
    const bf16_t* Zr = (const bf16_t*)(a->ws + WS_ZR);
    bf16_t* Yf = (bf16_t*)(a->ws + WS_Y); bf16_t* Yb = Yf + (size_t)MALL * 1024;
    float* BON = (float*)(a->ws + WS_BON);
    const float* scw = a->in[I_SHIFT] + (size_t)l * 3 * NRW;
    const int lane = t.lane, wv = t.wv, dir = wv >> 2, wq = wv & 3, fr = lane & 15, fq = lane >> 4;
    const int sg = dir ? 3 - fq : fq;
    const __amdgpu_buffer_rsrc_t rsZ = __builtin_amdgcn_make_buffer_rsrc((void*)(Zr - ZR_LD), 0, -1, 0x00020000);
    const __amdgpu_buffer_rsrc_t rsY = __builtin_amdgcn_make_buffer_rsrc((void*)(dir ? Yb : Yf), 0, -1, 0x00020000);
    const __amdgpu_buffer_rsrc_t rsB = __builtin_amdgcn_make_buffer_rsrc((void*)BON, 0, -1, 0x00020000);
    for (int unit = t.bid; unit < 256; unit += t.G) {
        const int b = unit >> 4, h = unit & 15;
        const int cl = 16 * wq + fr, ch = 64 * h + cl;
        {
            bf16x8 bw[2], ba[2];
            const float* w2p = a->in[I_W2] + ((size_t)(l * 2 + dir) * 64) * 1024 + ch; const float* a2p = a->in[I_A2] + ((size_t)(l * 2 + dir) * 64) * 1024 + ch;
#pragma unroll
            for (int ks = 0; ks < 2; ++ks) { unsigned pw[4], pa[4];
#pragma unroll
                for (int e = 0; e < 4; ++e) { const int k0 = 32 * ks + 8 * fq + 2 * e;
                    pw[e] = cvt_pk_bf16(w2p[(size_t)k0 * 1024], w2p[(size_t)(k0 + 1) * 1024]); pa[e] = cvt_pk_bf16(a2p[(size_t)k0 * 1024], a2p[(size_t)(k0 + 1) * 1024]); }
                bw[ks] = __builtin_bit_cast(bf16x8, (u32x4){pw[0], pw[1], pw[2], pw[3]}); ba[ks] = __builtin_bit_cast(bf16x8, (u32x4){pa[0], pa[1], pa[2], pa[3]}); }
            __syncthreads();
#pragma unroll
            for (int ks = 0; ks < 2; ++ks) { BF[(ks * 2 + 0) * 512 + t.tid] = bw[ks]; BF[(ks * 2 + 1) * 512 + t.tid] = ba[ks]; }
        }
        const float w0v = a->in[I_W0][(l * 2 + dir) * 1024 + ch], a0v = a->in[I_A0][(l * 2 + dir) * 1024 + ch];
        const float kkv = a->in[I_KK][l * 1024 + ch], kav = a->in[I_KA][l * 1024 + ch], rkv = a->in[I_RK][l * 1024 + ch];
        float swr[3], swk[3], swv[3], swz[3], swy[3];
        const int zcol = 3072 + 64 * dir + lane;
#pragma unroll
        for (int j = 0; j < 3; ++j) { const int jr = dir ? 2 - j : j;
            swr[j] = scw[jr * NRW + ch]; swk[j] = scw[jr * NRW + 1024 + ch]; swv[j] = scw[jr * NRW + 2048 + ch]; swz[j] = scw[jr * NRW + zcol]; swy[j] = scw[jr * NRW + zcol + 128]; }
        const int vo_in = (4 * fq * ZR_LD + ch) * 2, vo_z = zcol * 2, vo_y = (4 * sg * 1024 + 64 * h + cl) * 2;
        f32x4 Sreg[4];
#pragma unroll
        for (int k = 0; k < 4; ++k) Sreg[k] = (f32x4){0.f, 0.f, 0.f, 0.f};
        f32x4 Idm;
#pragma unroll
        for (int j = 0; j < 4; ++j) Idm[j] = (4 * fq + j == fr) ? 1.0f : 0.0f;
        unsigned short pr[6], pk[6], pv[6], pz[6], py[6];
#define SC_DESC(k_, rb_, fl_) do { const int k__ = (k_); const bool c__ = k__ < 16; const int jj__ = c__ ? k__ : k__ - 16; const int T__ = c__ ? TC : TL; \
            const int t0__ = dir == 0 ? 16 * jj__ : T__ - 16 * (jj__ + 1); rb_ = (c__ ? (MLAT + b * TC) : b * TL) + t0__; fl_ = (t0__ == 0 ? 1 : 0) | (t0__ + 16 == T__ ? 2 : 0); } while (0)
#define SC5_LOADS(rb_) do { int so__ = ((rb_) + (dir ? 5 : 0)) * (ZR_LD * 2); const int st__ = dir ? -(ZR_LD * 2) : (ZR_LD * 2); const int zo__ = 4 * wq * (ZR_LD * 2); \
            _Pragma("unroll") for (int e = 0; e < 6; ++e) { \
                pr[e] = __builtin_amdgcn_raw_buffer_load_b16(rsZ, vo_in, so__, 0); pk[e] = __builtin_amdgcn_raw_buffer_load_b16(rsZ, vo_in + 2048, so__, 0); pv[e] = __builtin_amdgcn_raw_buffer_load_b16(rsZ, vo_in, so__ + 4096, 0); \
                pz[e] = __builtin_amdgcn_raw_buffer_load_b16(rsZ, vo_z, so__ + zo__, 0); py[e] = __builtin_amdgcn_raw_buffer_load_b16(rsZ, vo_z + 256, so__ + zo__, 0); so__ += st__; } } while (0)
        float r4[4], k4[4], v4[4], dc4[4], av4[4], kr4[4], kd4[4];
        bf16x4 pAk, pArk, pArb, pT;
#define SC5_E1(fl_, NEXT_) do { const bool first__ = ((fl_) & 1) != 0, last__ = ((fl_) & 2) != 0; \
            const bool zl__ = first__ && fq == 0, zh__ = last__ && fq == 3; const bool m0__ = dir ? zh__ : zl__, m5__ = dir ? zl__ : zh__; \
            if (m0__) { pr[0] = 0; pk[0] = 0; pv[0] = 0; } \
            if (m5__) { pr[5] = 0; pk[5] = 0; pv[5] = 0; } \
            const bool wl__ = first__ && wq == 0, wh__ = last__ && wq == 3; const bool n0__ = dir ? wh__ : wl__, n5__ = dir ? wl__ : wh__; \
            if (n0__) { pz[0] = 0; py[0] = 0; } \
            if (n5__) { pz[5] = 0; py[5] = 0; } \
            _Pragma("unroll") for (int j = 0; j < 4; ++j) { r4[j] = swr[0] * bf2f(pr[j]) + swr[1] * bf2f(pr[j + 1]) + swr[2] * bf2f(pr[j + 2]); \
                k4[j] = swk[0] * bf2f(pk[j]) + swk[1] * bf2f(pk[j + 1]) + swk[2] * bf2f(pk[j + 2]); v4[j] = swv[0] * bf2f(pv[j]) + swv[1] * bf2f(pv[j + 1]) + swv[2] * bf2f(pv[j + 2]); } \
            float zs__[4], za__[4]; \
            _Pragma("unroll") for (int j = 0; j < 4; ++j) { zs__[j] = swz[0] * bf2f(pz[j]) + swz[1] * bf2f(pz[j + 1]) + swz[2] * bf2f(pz[j + 2]); za__[j] = swy[0] * bf2f(py[j]) + swy[1] * bf2f(py[j + 1]) + swy[2] * bf2f(py[j + 2]); } \
            NEXT_;   \
            _Pragma("unroll") for (int j = 0; j < 4; ++j) { const float zw = fast_tanh(zs__[j]); \
                ZA[((dir * 2 + 0) * 16 + 4 * wq + j) * 72 + lane] = f2bf(zw); ZA[((dir * 2 + 1) * 16 + 4 * wq + j) * 72 + lane] = f2bf(za__[j]); } } while (0)
#define SC5_E2() do { \
            f32x4 lw = (f32x4){0.f, 0.f, 0.f, 0.f}, la = (f32x4){0.f, 0.f, 0.f, 0.f}; \
            _Pragma("unroll") for (int ks = 0; ks < 2; ++ks) { \
                const bf16x8 aw = *(const LAS bf16x8*)(ZA + ((dir * 2 + 0) * 16 + fr) * 72 + 32 * ks + 8 * fq); const bf16x8 aa = *(const LAS bf16x8*)(ZA + ((dir * 2 + 1) * 16 + fr) * 72 + 32 * ks + 8 * fq); \
                lw = __builtin_amdgcn_mfma_f32_16x16x32_bf16(aw, BF[(ks * 2 + 0) * 512 + t.tid], lw, 0, 0, 0); la = __builtin_amdgcn_mfma_f32_16x16x32_bf16(aa, BF[(ks * 2 + 1) * 512 + t.tid], la, 0, 0, 0); } \
            float red__[8]; \
            _Pragma("unroll") for (int j = 0; j < 4; ++j) { dc4[j] = __builtin_amdgcn_exp2f(-0.87503877f * fast_sigmoid(w0v + lw[j])); av4[j] = fast_sigmoid(a0v + la[j]); \
                kr4[j] = k4[j] * kkv; kd4[j] = k4[j] * (1.0f + (av4[j] - 1.0f) * kav); red__[2 * j] = kr4[j] * kr4[j]; red__[2 * j + 1] = r4[j] * kd4[j] * rkv; } \
            row16_sum8(red__); \
            _Pragma("unroll") for (int j = 0; j < 4; ++j) \
                *(LAS f32x2*)(PART + (fr == 0 ? ((dir * 16 + 4 * fq + j) * 4 + wq) * 2 : 256 + 2 * (lane & 7))) = (f32x2){red__[2 * j], red__[2 * j + 1]}; } while (0)
#define SC5_E3(rb_, buf_) do { \
            LAS unsigned short* TSd = TS + ((buf_) * 2 + dir) * (4 * 16 * 68); LAS unsigned short* CSd = CS + ((buf_) * 2 + dir) * (3 * 64 * 20); \
            float kap[4], bet[4], bs__[4]; \
            _Pragma("unroll") for (int j = 0; j < 4; ++j) { const int ti = 4 * fq + j; const f32x4 p0 = *(const LAS f32x4*)(PART + (dir * 16 + ti) * 8), p1 = *(const LAS f32x4*)(PART + (dir * 16 + ti) * 8 + 4); \
                const float nrm = (p0[0] + p0[2]) + (p1[0] + p1[2]); kap[j] = kr4[j] * rsqrtf(fmaxf(nrm, 1e-12f)); bet[j] = kap[j] * av4[j]; \
                bs__[j] = (p0[1] + p0[3]) + (p1[1] + p1[3]); } \
            if (wv == 0) { if (fr == 0) { const int bso__ = __builtin_amdgcn_readfirstlane(((rb_) * 16 + h) * 4); \
                _Pragma("unroll") for (int j = 0; j < 4; ++j) __builtin_amdgcn_raw_buffer_store_b32(__float_as_uint(bs__[j]), rsB, fq * 256 + j * 64, bso__, 0); } } \
            const float g = (dc4[0] * dc4[1]) * (dc4[2] * dc4[3]); \
            const float ga = __shfl(g, fr + (dir ? 48 : 0)), gb = __shfl(g, fr + (dir ? 32 : 16)), gc = __shfl(g, fr + (dir ? 16 : 32)), gd = __shfl(g, fr + (dir ? 0 : 48));     \
            const float gall = (ga * gb) * (gc * gd); \
            const float pre = (sg >= 1 ? ga : 1.0f) * ((sg >= 2 ? gb : 1.0f) * (sg >= 3 ? gc : 1.0f)); \
            float run = pre; f32x4 kpv, bpv, vvv; \
            _Pragma("unroll") for (int e = 0; e < 4; ++e) { const float gm1 = run; run *= dc4[e]; const float inv = __builtin_amdgcn_rcpf(run); \
                const float ktv = kap[e] * gm1, rtv = r4[e] * (dir ? gm1 : run), khv = kd4[e] * inv, bhv = bet[e] * inv; \
                kpv[e] = khv * gall; bpv[e] = -(bhv * gall); vvv[e] = v4[e]; \
                const int so = (4 * sg + e) * 68 + cl; \
                TSd[so] = f2bf(ktv); TSd[16 * 68 + so] = f2bf(rtv); TSd[2 * 16 * 68 + so] = f2bf(khv); TSd[3 * 16 * 68 + so] = f2bf(bhv); } \
            *(LAS bf16x4*)(CSd + cl * 20 + 4 * sg) = pack4(kpv); *(LAS bf16x4*)(CSd + 64 * 20 + cl * 20 + 4 * sg) = pack4(bpv); *(LAS bf16x4*)(CSd + 2 * 64 * 20 + cl * 20 + 4 * sg) = pack4(vvv); \
            GAM[((buf_) * 2 + dir) * 64 + cl] = gall; } while (0)
#define SC5_MA(buf_) do { \
            const LAS unsigned short* TSd = TS + ((buf_) * 2 + dir) * (4 * 16 * 68); \
            bf16x4 kt[4], rt[4], kh[4], bh[4]; \
            _Pragma("unroll") for (int ks = 0; ks < 4; ++ks) { const int o = fr * 68 + 16 * ks + 4 * fq; \
                kt[ks] = *(const LAS bf16x4*)(TSd + o); rt[ks] = *(const LAS bf16x4*)(TSd + 16 * 68 + o); kh[ks] = *(const LAS bf16x4*)(TSd + 2 * 16 * 68 + o); bh[ks] = *(const LAS bf16x4*)(TSd + 3 * 16 * 68 + o); } \
            f32x4 AkD = (f32x4){0.f, 0.f, 0.f, 0.f}, ND = AkD, ArkD = AkD, ArbD = AkD, NtD = AkD; \
            _Pragma("unroll") for (int ks = 0; ks < 4; ++ks) { AkD = MFMA16(kh[ks], kt[ks], AkD); ND = MFMA16(bh[ks], kt[ks], ND); ArkD = MFMA16(kh[ks], rt[ks], ArkD); ArbD = MFMA16(bh[ks], rt[ks], ArbD); NtD = MFMA16(kt[ks], bh[ks], NtD); } \
            _Pragma("unroll") for (int j = 0; j < 4; ++j) { const int i = 4 * fq + j; const bool st = i < fr; const bool inc = dir ? (i < fr) : (i <= fr); \
                AkD[j] = st ? AkD[j] : 0.f; ND[j] = st ? ND[j] : 0.f; ArkD[j] = inc ? ArkD[j] : 0.f; ArbD[j] = inc ? -ArbD[j] : 0.f; NtD[j] = (fr < i) ? NtD[j] : 0.f; } \
            const f32x4 Z4 = (f32x4){0.f, 0.f, 0.f, 0.f}; \
            const bf16x4 pN = pack4(ND), pNt = pack4(NtD); \
            const f32x4 N2 = MFMA16(pNt, pN, Z4), N2t = MFMA16(pN, pNt, Z4); \
            const bf16x4 pN2 = pack4(N2), pN2t = pack4(N2t); \
            const f32x4 N4 = MFMA16(pN2t, pN2, Z4), N4t = MFMA16(pN2, pN2t, Z4); \
            const f32x4 N8 = MFMA16(pack4(N4t), pack4(N4), Z4); \
            const f32x4 T1t = MFMA16(pack4(Idm + N2), pack4(Idm - NtD), Z4); \
            const f32x4 T2 = MFMA16(pack4(Idm + N4t), pack4(Idm + N8), Z4); \
            const f32x4 TD = MFMA16(pack4(T1t), pack4(T2), Z4); \
            pAk = pack4(AkD); pArk = pack4(ArkD); pArb = pack4(ArbD); pT = pack4(TD); } while (0)
#define SC5_MB(rb_, buf_) do { \
            const LAS unsigned short* TSd = TS + ((buf_) * 2 + dir) * (4 * 16 * 68); const LAS unsigned short* CSd = CS + ((buf_) * 2 + dir) * (3 * 64 * 20); \
            bf16x4 kt[4], rt[4], sb[4]; \
            _Pragma("unroll") for (int ks = 0; ks < 4; ++ks) { const int o = fr * 68 + 16 * ks + 4 * fq; kt[ks] = *(const LAS bf16x4*)(TSd + o); rt[ks] = *(const LAS bf16x4*)(TSd + 16 * 68 + o); sb[ks] = pack4(Sreg[ks]); } \
            const bf16x4 vtf = *(const LAS bf16x4*)(CSd + 2 * 64 * 20 + cl * 20 + 4 * fq); \
            const f32x4 Z4 = (f32x4){0.f, 0.f, 0.f, 0.f}; f32x4 Pt = Z4, Yt = Z4; \
            _Pragma("unroll") for (int ks = 0; ks < 4; ++ks) { Pt = MFMA16(kt[ks], sb[ks], Pt); Yt = MFMA16(rt[ks], sb[ks], Yt); } \
            const f32x4 Qt = MFMA16(pAk, vtf, Pt); \
            const f32x4 Ut = MFMA16(pT, pack4(Qt), Z4); \
            const bf16x4 ub = pack4(Ut); \
            Yt = MFMA16(pArk, vtf, Yt); Yt = MFMA16(pArb, ub, Yt); \
            _Pragma("unroll") for (int ks = 0; ks < 4; ++ks) { \
                const f32x4 gm = *(const LAS f32x4*)(GAM + ((buf_) * 2 + dir) * 64 + 16 * ks + 4 * fq); \
                const bf16x4 kpf = *(const LAS bf16x4*)(CSd + (16 * ks + fr) * 20 + 4 * fq), bpf = *(const LAS bf16x4*)(CSd + 64 * 20 + (16 * ks + fr) * 20 + 4 * fq); \
                f32x4 c = Sreg[ks] * gm; c = MFMA16(kpf, vtf, c); c = MFMA16(bpf, ub, c); Sreg[ks] = c; } \
            int ys__ = ((rb_) + (dir ? 3 : 0)) * 2048; const int yst__ = dir ? -2048 : 2048;     \
            _Pragma("unroll") for (int j = 0; j < 4; ++j) { __builtin_amdgcn_raw_buffer_store_b16(f2bf(Yt[j]), rsY, vo_y, ys__, 0); ys__ += yst__; } } while (0)
        int rbA, rbB, rbC, flA, flB, flC;
        SC_DESC(0, rbA, flA); SC_DESC(1, rbB, flB);
        __syncthreads();
        SC5_LOADS(rbA);
        SC5_E1(flA, SC5_LOADS(rbB)); lds_barrier();
        SC5_E2(); lds_barrier();
        SC5_E3(rbA, 0); lds_barrier();
        const unsigned long long tl0_ = (MK_TMASK & 0x8000) ? __builtin_amdgcn_s_memrealtime() : 0ull;
        for (int blk = 0; blk < 144; ++blk) {
            const int nb2 = blk + 2 < 144 ? blk + 2 : 143, buf = blk & 1;
            SC_DESC(nb2, rbC, flC);
            SC5_E1(flB, SC5_LOADS(rbC));
            lds_barrier();
            SC5_E2(); SC5_MA(buf);
            lds_barrier();
            SC5_E3(rbB, buf ^ 1); SC5_MB(rbA, buf);
            lds_barrier();
            rbA = rbB; flA = flB; rbB = rbC; flB = flC;
        }
        if ((MK_TMASK & 0x8000) && t.bid == 0 && t.tid == 0) { unsigned long long* tp = (unsigned long long*)(a->ws + WS_CTL + 768 * 1024); *tp = *tp + (__builtin_amdgcn_s_memrealtime() - tl0_); }
#undef SC_DESC
#undef SC5_LOADS
#undef SC5_E1
#undef SC5_E2
#undef SC5_E3
#undef SC5_MA
#undef SC5_MB
    }
}

__device__ __forceinline__ void ph_readout(KArgP a, int l, const Th& t) {
    const bf16_t* Zr = (const bf16_t*)(a->ws + WS_ZR);
    bf16_t* Yf = (bf16_t*)(a->ws + WS_Y); const bf16_t* Yb = Yf + (size_t)MALL * 1024;
    const float* BON = (const float*)(a->ws + WS_BON);
    bf16_t* AG = (bf16_t*)(a->ws + WS_AG);
    const float* scw = a->in[I_SHIFT] + (size_t)l * 3 * NRW;
    const int Mrows = l == 0 ? MALL : MLAT;
    const int lane = t.lane, ch0 = lane * 16, head = lane >> 2;
    const int nwv = t.G * 8, R = (Mrows + nwv - 1) / nwv, r0 = (t.bid * 8 + t.wv) * R, r1 = (r0 + R < Mrows) ? r0 + R : Mrows;
    if (r0 < r1) {
        float swv[3][16], lgv[16], lbv[16], swg[3][4];
#pragma unroll
        for (int j = 0; j < 3; ++j) {
#pragma unroll
            for (int i = 0; i < 4; ++i) { const f32x4 x = *(const f32x4*)(scw + j * NRW + 2048 + ch0 + 4 * i); swv[j][4 * i] = x[0]; swv[j][4 * i + 1] = x[1]; swv[j][4 * i + 2] = x[2]; swv[j][4 * i + 3] = x[3]; }
            const f32x4 y = *(const f32x4*)(scw + j * NRW + 3328 + 4 * (lane & 31)); swg[j][0] = y[0]; swg[j][1] = y[1]; swg[j][2] = y[2]; swg[j][3] = y[3]; }
#pragma unroll
        for (int i = 0; i < 4; ++i) { const f32x4 x = *(const f32x4*)(a->in[I_LNXG] + l * 1024 + ch0 + 4 * i), y = *(const f32x4*)(a->in[I_LNXB] + l * 1024 + ch0 + 4 * i);
#pragma unroll
            for (int j = 0; j < 4; ++j) { lgv[4 * i + j] = x[j]; lbv[4 * i + j] = y[j]; } }
        const int zlast = MALL - 1;
#define RO_ZROW(m_, zv_, zg_) do { const int mm_ = (m_) < 0 ? 0 : ((m_) > zlast ? zlast : (m_)); const bf16_t* zz_ = Zr + (size_t)mm_ * ZR_LD; \
            zv_[0] = *(const u32x4*)(zz_ + 2048 + ch0); zv_[1] = *(const u32x4*)(zz_ + 2048 + ch0 + 8); zg_ = *(const u32x2*)(zz_ + 3328 + 4 * (lane & 31)); } while (0)
#define RO_YROW(m_, f_, g_, bn_) do { const size_t mo_ = (size_t)(m_) * 1024 + ch0; f_[0] = *(const u32x4*)(Yf + mo_); f_[1] = *(const u32x4*)(Yf + mo_ + 8); g_[0] = *(const u32x4*)(Yb + mo_); g_[1] = *(const u32x4*)(Yb + mo_ + 8); \
            bn_ = BON[(size_t)(m_) * 16 + head]; } while (0)
        u32x4 z0[2], z1[2], z2[2], zn[2], fC[2], gC[2], fN[2], gN[2]; u32x2 d0, d1, d2, dn; float bonC, bonN;
        RO_ZROW(r0 - 1, z0, d0); RO_ZROW(r0, z1, d1); RO_ZROW(r0 + 1, z2, d2);
        RO_YROW(r0, fC, gC, bonC);
        for (int m = r0; m < r1; ++m) {
            const int mn = m + 1 < r1 ? m + 1 : m;
            RO_ZROW(m + 2, zn, dn);
            RO_YROW(mn, fN, gN, bonN);
            const bool isctx = m >= MLAT; const int tl = isctx ? ((m - MLAT) & (TC - 1)) : (m & (TL - 1)); const int Tseq = isctx ? TC : TL;
            const bool has0 = tl > 0, has2 = tl + 1 < Tseq;
            float y[16], v[16];
#define RO_UNPK(dst_, w_) do { dst_[0] = bflo(w_[0].x); dst_[1] = bfhi(w_[0].x); dst_[2] = bflo(w_[0].y); dst_[3] = bfhi(w_[0].y); dst_[4] = bflo(w_[0].z); dst_[5] = bfhi(w_[0].z); dst_[6] = bflo(w_[0].w); dst_[7] = bfhi(w_[0].w); \
                dst_[8] = bflo(w_[1].x); dst_[9] = bfhi(w_[1].x); dst_[10] = bflo(w_[1].y); dst_[11] = bfhi(w_[1].y); dst_[12] = bflo(w_[1].z); dst_[13] = bfhi(w_[1].z); dst_[14] = bflo(w_[1].w); dst_[15] = bfhi(w_[1].w); } while (0)
            { float yf[16], yb[16]; RO_UNPK(yf, fC); RO_UNPK(yb, gC);
#pragma unroll
              for (int i = 0; i < 16; ++i) y[i] = yf[i] + yb[i]; }
            float sm = 0.f, sq = 0.f;
#pragma unroll
            for (int i = 0; i < 16; ++i) { sm += y[i]; sq += y[i] * y[i]; }
            sm += dpp_f<0xB1>(sm); sq += dpp_f<0xB1>(sq); sm += dpp_f<0x4E>(sm); sq += dpp_f<0x4E>(sq);
            const float mean = sm * (1.0f / 64.0f), var = fmaxf(sq * (1.0f / 64.0f) - mean * mean, 0.f);
            const float rstd = rsqrtf(var + GN_EPS);
            { float zt[16]; RO_UNPK(zt, z1);
#pragma unroll
              for (int i = 0; i < 16; ++i) v[i] = swv[1][i] * zt[i];
              if (has0) { RO_UNPK(zt, z0);
#pragma unroll
                  for (int i = 0; i < 16; ++i) v[i] += swv[0][i] * zt[i]; }
              if (has2) { RO_UNPK(zt, z2);
#pragma unroll
                  for (int i = 0; i < 16; ++i) v[i] += swv[2][i] * zt[i]; } }
            float o[16];
#pragma unroll
            for (int i = 0; i < 16; ++i) o[i] = (y[i] - mean) * rstd * lgv[i] + lbv[i] + bonC * v[i];
            *(u32x4*)(Yf + (size_t)m * 1024 + ch0) = (u32x4){cvt_pk_bf16(o[0], o[1]), cvt_pk_bf16(o[2], o[3]), cvt_pk_bf16(o[4], o[5]), cvt_pk_bf16(o[6], o[7])};
            *(u32x4*)(Yf + (size_t)m * 1024 + ch0 + 8) = (u32x4){cvt_pk_bf16(o[8], o[9]), cvt_pk_bf16(o[10], o[11]), cvt_pk_bf16(o[12], o[13]), cvt_pk_bf16(o[14], o[15])};
            if (lane < 32) {
                float gs[4] = {swg[1][0] * bflo(d1.x), swg[1][1] * bfhi(d1.x), swg[1][2] * bflo(d1.y), swg[1][3] * bfhi(d1.y)};
                if (has0) { gs[0] += swg[0][0] * bflo(d0.x); gs[1] += swg[0][1] * bfhi(d0.x); gs[2] += swg[0][2] * bflo(d0.y); gs[3] += swg[0][3] * bfhi(d0.y); }
                if (has2) { gs[0] += swg[2][0] * bflo(d2.x); gs[1] += swg[2][1] * bfhi(d2.x); gs[2] += swg[2][2] * bflo(d2.y); gs[3] += swg[2][3] * bfhi(d2.y); }
                *(u32x2*)(AG + (size_t)m * 256 + 4 * lane) = (u32x2){cvt_pk_bf16(fast_sigmoid(gs[0]), fast_sigmoid(gs[1])), cvt_pk_bf16(fast_sigmoid(gs[2]), fast_sigmoid(gs[3]))};
            } else {
                *(u32x2*)(AG + (size_t)m * 256 + 128 + 4 * (lane - 32)) = (u32x2){0u, 0u};
            }
            z0[0] = z1[0]; z0[1] = z1[1]; z1[0] = z2[0]; z1[1] = z2[1]; z2[0] = zn[0]; z2[1] = zn[1]; d0 = d1; d1 = d2; d2 = dn;
            fC[0] = fN[0]; fC[1] = fN[1]; gC[0] = gN[0]; gC[1] = gN[1]; bonC = bonN;
        }
#undef RO_ZROW
#undef RO_YROW
#undef RO_UNPK
    }
}

__device__ __forceinline__ float fold32(float a, float b) { const auto r = __builtin_amdgcn_permlane32_swap(__float_as_uint(a), __float_as_uint(b), false, false); return __uint_as_float(r[0]) + __uint_as_float(r[1]); }
__device__ __forceinline__ float fold16(float a, float b) { const auto r = __builtin_amdgcn_permlane16_swap(__float_as_uint(a), __float_as_uint(b), false, false); return __uint_as_float(r[0]) + __uint_as_float(r[1]); }
__device__ __forceinline__ void ln_rows1(float (&v)[16]) {
    float s = 0.f, q = 0.f;
#pragma unroll
    for (int i = 0; i < 16; ++i) { s += v[i]; q += v[i] * v[i]; }
    s += dpp_f<0xB1>(s); q += dpp_f<0xB1>(q); s += dpp_f<0x4E>(s); q += dpp_f<0x4E>(q); s += dpp_f<0x141>(s); q += dpp_f<0x141>(q); s += dpp_f<0x140>(s); q += dpp_f<0x140>(q);
    const int si = __float_as_int(s), qi = __float_as_int(q);
    const float s0 = __int_as_float(__builtin_amdgcn_readlane(si, 0)), s1 = __int_as_float(__builtin_amdgcn_readlane(si, 16)), s2 = __int_as_float(__builtin_amdgcn_readlane(si, 32)), s3 = __int_as_float(__builtin_amdgcn_readlane(si, 48));
    const float q0 = __int_as_float(__builtin_amdgcn_readlane(qi, 0)), q1 = __int_as_float(__builtin_amdgcn_readlane(qi, 16)), q2 = __int_as_float(__builtin_amdgcn_readlane(qi, 32)), q3 = __int_as_float(__builtin_amdgcn_readlane(qi, 48));
    const float mean = ((s0 + s1) + (s2 + s3)) * (1.0f / 1024.0f), var = fmaxf(((q0 + q1) + (q2 + q3)) * (1.0f / 1024.0f) - mean * mean, 0.f);
    const float rstd = rsqrtf(var + LN_EPS), off = -mean * rstd;
#pragma unroll
    for (int i = 0; i < 16; ++i) v[i] = v[i] * rstd + off;
}
__device__ __forceinline__ void ph_ln1(KArgP a, int l, LAS unsigned char* lds, const Th& t) {
    LAS float* RWL = (LAS float*)lds;
    const float* rw = a->in[I_ROUTER] + (size_t)l * 1024 * 16;
    for (int i = t.tid; i < 16384; i += 512) { const int c = i >> 4, e = i & 15; RWL[e * 1024 + c] = rw[i]; }
    __syncthreads();
    const float* MOD = (const float*)(a->ws + WS_MOD) + (size_t)l * 17 * 6144;
    bf16_t* XM = (bf16_t*)(a->ws + WS_XM);
    unsigned char* H2 = a->ws + WS_S;
    float* AFF = (float*)(a->ws + WS_AFF);
    const int Mrows = l == 0 ? MALL : MLAT;
    const int lane = t.lane;
    const int nwv = t.G * 8, R = (Mrows + nwv - 1) / nwv, r0 = (t.bid * 8 + t.wv) * R, r1 = (r0 + R < Mrows) ? r0 + R : Mrows;
    if (r0 < r1) {
        float gg[16], bb[16], sc1[16], sh1[16];
#pragma unroll
        for (int i = 0; i < 4; ++i) { const f32x4 g = *(const f32x4*)(a->in[I_LN1G] + l * 1024 + i * 256 + lane * 4), b = *(const f32x4*)(a->in[I_LN1B] + l * 1024 + i * 256 + lane * 4);
#pragma unroll
            for (int j = 0; j < 4; ++j) { gg[4 * i + j] = g[j]; bb[4 * i + j] = b[j]; sc1[4 * i + j] = 0.f; sh1[4 * i + j] = 0.f; } }
        int s_cur = -1;
        float vn[16];
        load_row16_bf16(XM + (size_t)r0 * 1024, lane, vn);
        for (int m = r0; m < r1; ++m) {
            float v[16];
#pragma unroll
            for (int i = 0; i < 16; ++i) v[i] = vn[i];
            { const int mn = m + 1 < r1 ? m + 1 : m; load_row16_bf16(XM + (size_t)mn * 1024, lane, vn); }
            const int s = m < MLAT ? (m >> 11) : 16;
            if (s != s_cur) { s_cur = s; const float* sh = MOD + (size_t)s * 6144 + 3072; const float* sc = MOD + (size_t)s * 6144 + 4096;
#pragma unroll
                for (int i = 0; i < 4; ++i) { const f32x4 x = *(const f32x4*)(sc + i * 256 + lane * 4), y = *(const f32x4*)(sh + i * 256 + lane * 4);
#pragma unroll
                    for (int j = 0; j < 4; ++j) { sc1[4 * i + j] = 1.0f + x[j]; sh1[4 * i + j] = y[j]; } } }
            bf16_t* xp = XM + (size_t)m * 1024;
            ln_rows1(v);
#pragma unroll
            for (int i = 0; i < 16; ++i) v[i] = v[i] * gg[i] + bb[i];
            store_row16_bf16(xp, lane, v);
            ln_rows1(v);
#pragma unroll
            for (int i = 0; i < 16; ++i) v[i] = v[i] * sc1[i] + sh1[i];
#pragma unroll
            for (int i = 0; i < 4; ++i) *(unsigned*)(H2 + (size_t)m * 1024 + i * 256 + lane * 4) = pk4_fp8(v[4 * i], v[4 * i + 1], v[4 * i + 2], v[4 * i + 3]);
            float p[16];
#pragma unroll
            for (int e = 0; e < 16; ++e) { float acc0 = 0.f, acc1 = 0.f;
#pragma unroll
                for (int i = 0; i < 4; ++i) { const f32x4 w = *(const LAS f32x4*)(RWL + e * 1024 + i * 256 + lane * 4); acc0 += v[4 * i] * w[0] + v[4 * i + 1] * w[1]; acc1 += v[4 * i + 2] * w[2] + v[4 * i + 3] * w[3]; }
                p[e] = acc0 + acc1; if ((e & 3) == 3) asm volatile("" ::: "memory"); }
            float q8[8], u[4];
#pragma unroll
            for (int e = 0; e < 8; ++e) q8[e] = fold32(p[e], p[e + 8]);
#pragma unroll
            for (int e = 0; e < 4; ++e) u[e] = fold16(q8[e], q8[e + 4]);
#pragma unroll
            for (int e = 0; e < 4; ++e) { u[e] += dpp_f<0xB1>(u[e]); }
#pragma unroll
            for (int e = 0; e < 4; ++e) { u[e] += dpp_f<0x4E>(u[e]); }
#pragma unroll
            for (int e = 0; e < 4; ++e) { u[e] += dpp_f<0x141>(u[e]); }
#pragma unroll
            for (int e = 0; e < 4; ++e) { u[e] += dpp_f<0x140>(u[e]); }
            const float ml = fmaxf(fmaxf(u[0], u[1]), fmaxf(u[2], u[3]));
            const int mli = __float_as_int(ml);
            const float mx = fmaxf(fmaxf(__int_as_float(__builtin_amdgcn_readlane(mli, 0)), __int_as_float(__builtin_amdgcn_readlane(mli, 16))), fmaxf(__int_as_float(__builtin_amdgcn_readlane(mli, 32)), __int_as_float(__builtin_amdgcn_readlane(mli, 48))));
            float ex[4];
#pragma unroll
            for (int e = 0; e < 4; ++e) ex[e] = __expf(u[e] - mx);
            const float dl = (ex[0] + ex[1]) + (ex[2] + ex[3]);
            const int dli = __float_as_int(dl);
            const float den = (__int_as_float(__builtin_amdgcn_readlane(dli, 0)) + __int_as_float(__builtin_amdgcn_readlane(dli, 16))) + (__int_as_float(__builtin_amdgcn_readlane(dli, 32)) + __int_as_float(__builtin_amdgcn_readlane(dli, 48)));
            const int k4 = lane & 15;
            const float mine = k4 == 0 ? ex[0] : k4 == 1 ? ex[1] : k4 == 2 ? ex[2] : ex[3];
            if (k4 < 4) AFF[(size_t)m * 16 + 4 * (lane >> 4) + k4] = mine / den;
        }
    }
}

__device__ __forceinline__ void ph_select(KArgP a, int l, const Th& t) {
    const float* AFF = (const float*)(a->ws + WS_AFF);
    int* INV = (int*)(a->ws + WS_INV); int* SELT = (int*)(a->ws + WS_SELT); float* SELG = (float*)(a->ws + WS_SELG);
    const int RPE = l == 0 ? 4608 : 4096;
    const int nunits = l == 0 ? 512 : 256;
    const int lane = t.lane;
    const unsigned long long lt_mask = (lane == 0) ? 0ull : (~0ull >> (64 - lane));
    for (int unit = t.bid * 8 + t.wv; unit < nunits; unit += t.G * 8) {
        const int set = unit >> 4, e = unit & 15;
        const bool isctx = set >= 16; const int Tseq = isctx ? TC : TL, C = isctx ? 32 : 256, nj = Tseq >> 6;
        const int mbase = isctx ? MLAT + (set - 16) * TC : set * TL;
        const int rbase = e * RPE + (isctx ? 4096 + (set - 16) * 32 : set * 256);
        unsigned val[32];
#pragma unroll
        for (int j = 0; j < 32; ++j) val[j] = (j < nj) ? __float_as_uint(AFF[(size_t)(mbase + j * 64 + lane) * 16 + e]) : 0u;
        unsigned thr = 0u;
        for (int bit = 30; bit >= 0; --bit) {
            const unsigned cand = thr | (1u << bit);
            int cnt = 0;
#pragma unroll
            for (int j = 0; j < 32; ++j) cnt += (val[j] >= cand) ? 1 : 0;
            cnt = (int)wave_sum((float)cnt);
            if (cnt >= C) thr = cand;
        }
        int ngt = 0;
#pragma unroll
        for (int j = 0; j < 32; ++j) ngt += (val[j] > thr) ? 1 : 0;
#pragma unroll
        for (int o = 32; o > 0; o >>= 1) ngt += __shfl_xor(ngt, o);
        const int need = C - ngt;
        int base = 0, eqseen = 0;
#pragma unroll
        for (int j = 0; j < 32; ++j) {
            if (j < nj) {
                const bool gt = val[j] > thr, eq = val[j] == thr;
                const unsigned long long meq = __ballot(eq);
                const bool take = gt || (eq && (eqseen + __popcll(meq & lt_mask)) < need);
                const unsigned long long mt = __ballot(take);
                const int m = mbase + j * 64 + lane;
                int slot = -1;
                if (take) { slot = rbase + base + __popcll(mt & lt_mask); SELT[slot] = m; SELG[slot] = __uint_as_float(val[j]); }
                INV[(size_t)m * 16 + e] = slot;
                base += __popcll(mt); eqseen += __popcll(meq);
            }
        }
    }
}

__device__ __forceinline__ void ph_gather(KArgP a, int l, const Th& t) {
    const int* SELT = (const int*)(a->ws + WS_SELT);
    const unsigned char* H2 = a->ws + WS_S; unsigned char* XE = a->ws + WS_XA;
    const int nrows = 16 * (l == 0 ? 4608 : 4096);
    for (int r = t.bid * 8 + t.wv; r < nrows; r += t.G * 8) {
        const int tok = SELT[r];
        const u32x4* src = (const u32x4*)(H2 + (size_t)tok * 1024); u32x4* dst = (u32x4*)(XE + (size_t)r * 1024);
        dst[t.lane] = src[t.lane];
    }
}

__device__ __forceinline__ void ph_combine(KArgP a, int l, const Th& t) {
    const int* INV = (const int*)(a->ws + WS_INV); const bf16_t* YE = (const bf16_t*)(a->ws + WS_Y);
    const float* MOD = (const float*)(a->ws + WS_MOD);
    const bf16_t* XM = (const bf16_t*)(a->ws + WS_XM); bf16_t* XA = (bf16_t*)(a->ws + WS_XA); bf16_t* H = (bf16_t*)(a->ws + WS_S);
    const int Mrows = l == 0 ? MALL : MLAT;
    const int lane = t.lane;
    const int nwv = t.G * 8, R = (Mrows + nwv - 1) / nwv, r0 = (t.bid * 8 + t.wv) * R, r1 = (r0 + R < Mrows) ? r0 + R : Mrows;
    if (r0 < r1) {
        float g2v[16], b2v[16], gtv[16], sc1[16], sh1[16];
#pragma unroll
        for (int i = 0; i < 4; ++i) { const f32x4 g = *(const f32x4*)(a->in[I_LN2G] + l * 1024 + i * 256 + lane * 4), b = *(const f32x4*)(a->in[I_LN2B] + l * 1024 + i * 256 + lane * 4);
#pragma unroll
            for (int j = 0; j < 4; ++j) { g2v[4 * i + j] = g[j]; b2v[4 * i + j] = b[j]; gtv[4 * i + j] = 0.f; sc1[4 * i + j] = 0.f; sh1[4 * i + j] = 0.f; } }
        int s_cur = -1;
#define CB_INV(m_) (lane < 16 ? INV[(size_t)(m_) * 16 + lane] : -1)
#define CB_ISSUE(m_, inv_, x_, w_, wg_, rest_) do { unsigned long long vm_ = __ballot((inv_) >= 0); \
            _Pragma("unroll") for (int q = 0; q < 4; ++q) { const bool ok = vm_ != 0ull; const int e = ok ? (int)__builtin_ctzll(vm_) : 0; int R_ = __builtin_amdgcn_readlane((inv_), e); if (!ok || R_ < 0) R_ = 0; wg_[q] = ok ? 1.0f : 0.0f; if (ok) vm_ &= vm_ - 1ull; \
                const bf16_t* yr = YE + (size_t)R_ * 1024; _Pragma("unroll") for (int i = 0; i < 4; ++i) w_[q][i] = *(const u32x2*)(yr + i * 256 + lane * 4); } \
            rest_ = vm_; load_row16_bf16(XM + (size_t)(m_) * 1024, lane, x_); } while (0)
        int inv_c = CB_INV(r0), inv_n = CB_INV(r0 + 1 < r1 ? r0 + 1 : r0);
        float xC[16], wgC[4]; u32x2 wC[4][4]; unsigned long long restC;
        CB_ISSUE(r0, inv_c, xC, wC, wgC, restC);
        for (int m = r0; m < r1; ++m) {
            const int mn = m + 1 < r1 ? m + 1 : m, mnn = m + 2 < r1 ? m + 2 : mn;
            const int inv_nn = CB_INV(mnn);
            float xN[16], wgN[4]; u32x2 wN[4][4]; unsigned long long restN;
            CB_ISSUE(mn, inv_n, xN, wN, wgN, restN);
            const int s = m < MLAT ? (m >> 11) : 16;
            if (s != s_cur) { s_cur = s; const float* gt2 = MOD + ((size_t)l * 17 + s) * 6144 + 5120; const float* shp = MOD + ((size_t)17 + s) * 6144; const float* scp = shp + 1024;
#pragma unroll
                for (int i = 0; i < 4; ++i) { const f32x4 x = *(const f32x4*)(gt2 + i * 256 + lane * 4);
#pragma unroll
                    for (int j = 0; j < 4; ++j) gtv[4 * i + j] = x[j];
                    if (l == 0) { const f32x4 y = *(const f32x4*)(scp + i * 256 + lane * 4), z = *(const f32x4*)(shp + i * 256 + lane * 4);
#pragma unroll
                        for (int j = 0; j < 4; ++j) { sc1[4 * i + j] = 1.0f + y[j]; sh1[4 * i + j] = z[j]; } } } }
            float acc[16];
#pragma unroll
            for (int i = 0; i < 16; ++i) acc[i] = 0.f;
#pragma unroll
            for (int q = 0; q < 4; ++q)
#pragma unroll
                for (int i = 0; i < 4; ++i) { acc[4 * i] += wgC[q] * bflo(wC[q][i].x); acc[4 * i + 1] += wgC[q] * bfhi(wC[q][i].x); acc[4 * i + 2] += wgC[q] * bflo(wC[q][i].y); acc[4 * i + 3] += wgC[q] * bfhi(wC[q][i].y); }
            while (restC) {
                const int e = (int)__builtin_ctzll(restC); restC &= restC - 1ull; int R_ = __builtin_amdgcn_readlane(inv_c, e); if (R_ < 0) R_ = 0;
                const bf16_t* yr = YE + (size_t)R_ * 1024;
#pragma unroll
                for (int i = 0; i < 4; ++i) { const u32x2 w = *(const u32x2*)(yr + i * 256 + lane * 4); acc[4 * i] += bflo(w.x); acc[4 * i + 1] += bfhi(w.x); acc[4 * i + 2] += bflo(w.y); acc[4 * i + 3] += bfhi(w.y); }
            }
            float v[16];
#pragma unroll
            for (int i = 0; i < 16; ++i) v[i] = ALPHA * xC[i] + gtv[i] * acc[i];
            ln_rows1(v);
#pragma unroll
            for (int i = 0; i < 16; ++i) v[i] = v[i] * g2v[i] + b2v[i];
            if (l == 0) {
                store_row16_bf16(XA + (size_t)m * 1024, lane, v);
                ln_rows1(v);
#pragma unroll
                for (int i = 0; i < 16; ++i) v[i] = v[i] * sc1[i] + sh1[i];
                store_row16_bf16(H + (size_t)m * 1024, lane, v);
#pragma unroll
                for (int i = 0; i < 4; ++i) *(unsigned*)(a->ws + WS_HQ + (size_t)m * 1024 + i * 256 + lane * 4) = pk4_fp8(v[4 * i], v[4 * i + 1], v[4 * i + 2], v[4 * i + 3]);
            } else {
                store_row16(a->out + (size_t)m * 1024, lane, v);
            }
#pragma unroll
            for (int i = 0; i < 16; ++i) xC[i] = xN[i];
#pragma unroll
            for (int q = 0; q < 4; ++q) { wgC[q] = wgN[q];
#pragma unroll
                for (int i = 0; i < 4; ++i) wC[q][i] = wN[q][i]; }
            restC = restN; inv_c = inv_n; inv_n = inv_nn;
        }
#undef CB_INV
#undef CB_ISSUE
    }
}

constexpr int CVT_SPLIT = 17408;
__device__ __forceinline__ void ph_cvt_experts(KArgP a, int l, LAS unsigned char* lds, const Th& t, int tile_lo, int tile_hi, int wave_lo) {
    LAS unsigned char* T = lds + t.wv * (64 * 80);
    const int gw = t.bid * 8 + t.wv - wave_lo, nw = t.G * 8 - wave_lo;
    unsigned char* WE13 = a->ws + WS_WE13; unsigned char* WE2 = a->ws + WS_WE2;
    if (gw < 0 || nw <= 0) return;
    for (int tt = tile_lo + gw; tt < tile_hi; tt += nw) {
        const int e = tt / 1536, r = tt % 1536, which = r >> 9, ti = r & 511;
        if (which < 2) { const float* src = a->in[which == 0 ? I_EW1 : I_EW3] + ((size_t)(l * 16 + e)) * 1024 * 2048; const int kt = ti >> 5, n0 = (ti & 31) * 64;
            cvt_tile_fp8(src, 2048, kt * 64, n0, WE13 + (size_t)e * 4096 * 1024, 1024, cvt_row(2 + which, n0), kt * 64, T, t.lane, pg8::W13_SCALE); }
        else { const float* src = a->in[I_EW2] + ((size_t)(l * 16 + e)) * 2048 * 1024; const int kt = ti >> 4, n0 = (ti & 15) * 64;
            cvt_tile_fp8(src, 1024, kt * 64, n0, WE2 + (size_t)e * 1024 * 2048, 2048, n0, kt * 64, T, t.lane, pg8::W2_SCALE); }
    }
}

__global__ void __launch_bounds__(512, 2) mk_fwd(const Args args) {
    extern __shared__ __attribute__((aligned(16))) unsigned char smem[];
    LAS unsigned char* lds = (LAS unsigned char*)smem;
    volatile LAS unsigned* MISC = (volatile LAS unsigned*)(lds + LDS_MISC);
    if (threadIdx.x < 64) MISC[threadIdx.x] = 0u;
#ifdef MK_FENCE
    __builtin_amdgcn_fence(__ATOMIC_ACQUIRE, "agent"); asm volatile("s_waitcnt vmcnt(0)" ::: "memory");
#endif
    __syncthreads();
    const int lo = args.ph_lo, hi = args.ph_hi;
    XcdBarrier bar; bar.bar = nullptr; bar.x = 0; bar.st = MISC + 8;
    if (hi - lo > 1) bar = xcd_barrier_post((unsigned*)(kargs()->ws + WS_CTL) + CW_BAR, MISC + 8);
    unsigned long long tp_acc = 0, tp_t = 0;
#define TPSEL(k) ((MK_TMASK >> ((k) % NPH)) & 1)
#define IN(k) (lo <= (k) && (k) < hi && ((TPSEL(k) ? (void)(tp_t = __builtin_amdgcn_s_memrealtime()) : (void)0), true))
#define SEAM(k) do { if (lo <= (k) + 1 && (k) + 1 < hi) xcd_barrier(bar); if (TPSEL(k)) tp_acc += __builtin_amdgcn_s_memrealtime() - tp_t; } while (0)
    using namespace pg8;
    for (int l = 0; l < 2; ++l) {
        const int P = l * NPH;
        if (l == 0 && IN(P + 0)) { ph_prologue(kargs(), lds, mk_th()); SEAM(P + 0); }
        if (l == 0 && IN(P + 1)) { ph_lnmod0(kargs(), mk_th()); SEAM(P + 1); }
        if (IN(P + 2)) {
            KArgP a = kargs(); const Th t = mk_th(); const int Mrows = l == 0 ? MALL : MLAT;
            bf16_t* const H = (bf16_t*)(a->ws + WS_S); bf16_t* const Zr = (bf16_t*)(a->ws + WS_ZR); bf16_t* const Zs = (bf16_t*)(a->ws + WS_ZS); bf16_t* const Zg = (bf16_t*)(a->ws + WS_ZG);
            const bf16_t* Wt = (const bf16_t*)(a->ws + WS_WIN) + (size_t)l * NZ * 1024;
            { Gemm g{H, Wt, MALL, ZR_LD, 1024}; Order S; S.init(MALL / 256, ZR_LD / 256, t.G, t.bid); EpiZ E{Zr, Zs, Zg, 0, 0, 1.0f}; gemm_phase<EpiZ, Order>(lds, g, S, E); }
            { Gemm g{(const bf16_t*)(a->ws + WS_HQ), (const bf16_t*)(a->ws + WS_WIN8 + (size_t)l * 4096 * 1024), Mrows, NZ - ZR_LD, opaque_i(1024)}; Order S; S.init(Mrows / 256, (NZ - ZR_LD) / 256, t.G, t.bid);
              EpiZ E{Zr, Zs, Zg, 0, 14, 1.0f / WIN8_SCALE}; gemm_phase<EpiZ, Order, true>(lds, g, S, E); }
            SEAM(P + 2);
        }
        if (IN(P + 3)) { ph_sgu(kargs(), l, lds, mk_th()); ph_scan5(kargs(), l, lds, mk_th()); SEAM(P + 3); }
        if (IN(P + 4)) { ph_readout(kargs(), l, mk_th()); SEAM(P + 4); }
        if (IN(P + 5)) {
            KArgP a = kargs(); const Th t = mk_th(); const int Mrows = l == 0 ? MALL : MLAT;
            Gemm g{(const bf16_t*)(a->ws + WS_AG), (const bf16_t*)(a->ws + WS_G2) + (size_t)l * 1024 * 256, Mrows, 1024, opaque_i(256)}; Order S; S.init(Mrows / 256, 4, t.G, t.bid);
            EpiMulInPlace E{(bf16_t*)(a->ws + WS_Y)}; gemm_phase<EpiMulInPlace, Order>(lds, g, S, E);
            SEAM(P + 5);
        }
        if (IN(P + 6)) {
            KArgP a = kargs(); const Th t = mk_th(); const int Mrows = l == 0 ? MALL : MLAT;
            bf16_t* const Yf = (bf16_t*)(a->ws + WS_Y); bf16_t* const Mg = Yf + (size_t)MALL * 1024; const bf16_t* Zg = (const bf16_t*)(a->ws + WS_ZG);
            { Gemm g{Yf, (const bf16_t*)(a->ws + WS_WA) + (size_t)l * 1024 * 1024, Mrows, 1024, 1024}; Order S; S.init(Mrows / 256, 4, t.G, t.bid);
              EpiGate<false> E{Mg, Zg, 0}; gemm_phase<EpiGate<false>, Order>(lds, g, S, E); }
            { Gemm g{(const bf16_t*)(a->ws + WS_S), (const bf16_t*)(a->ws + WS_WB) + (size_t)l * 1024 * 1024, Mrows, 1024, 1024}; Order S; S.init(Mrows / 256, 4, t.G, t.bid);
              EpiGate<true> E{Mg, Zg, 1024}; gemm_phase<EpiGate<true>, Order>(lds, g, S, E); }
            SEAM(P + 6);
        }
        if (IN(P + 7)) {
            ph_cvt_experts(kargs(), l, lds, mk_th(), 0, CVT_SPLIT, 0);
            __syncthreads();
            KArgP a = kargs(); const Th t = mk_th(); const int Mrows = l == 0 ? MALL : MLAT;
            Gemm g{(const bf16_t*)(a->ws + WS_Y) + (size_t)MALL * 1024, (const bf16_t*)(a->ws + WS_WO) + (size_t)l * 1024 * 1024, Mrows, 1024, 1024}; Order S; S.init(Mrows / 256, 4, t.G, t.bid);
            EpiRes E{a->in[I_X], a->in[I_CTX], l == 0 ? (const bf16_t*)nullptr : (const bf16_t*)(a->ws + WS_XA), (bf16_t*)(a->ws + WS_XM),
                     (const float*)(a->ws + WS_MOD) + (size_t)l * 17 * 6144 + 2048};
            gemm_phase<EpiRes, Order>(lds, g, S, E);
            SEAM(P + 7);
        }
        if (IN(P + 8)) { ph_ln1(kargs(), l, lds, mk_th()); SEAM(P + 8); }
        if (IN(P + 9)) { ph_select(kargs(), l, mk_th());
            { const Th t9 = mk_th(); const int nsel = l == 0 ? 512 : 256; ph_cvt_experts(kargs(), l, lds, t9, CVT_SPLIT, 16 * 1536, (t9.G * 8 > 2 * nsel) ? nsel : 0); }
            SEAM(P + 9); }
        if (IN(P + 11)) {
            KArgP a = kargs(); const Th t = mk_th(); const int nMe = l == 0 ? 18 : 16;
            Gemm g{(const bf16_t*)(a->ws + WS_S), (const bf16_t*)(a->ws + WS_WE13), 16 * nMe * 256, 4096, opaque_i(1024), (const int*)(a->ws + WS_SELT)}; Order S; S.init(16 * nMe, 16, t.G, t.bid, nMe);
            EpiSwiGLU E{a->ws + WS_HID}; gemm_phase<EpiSwiGLU, Order, true, true>(lds, g, S, E);
            SEAM(P + 11);
        }
        if (IN(P + 12)) {
            KArgP a = kargs(); const Th t = mk_th(); const int nMe = l == 0 ? 18 : 16;
            Gemm g{(const bf16_t*)(a->ws + WS_HID), (const bf16_t*)(a->ws + WS_WE2), 16 * nMe * 256, 1024, opaque_i(2048)}; Order S; S.init(16 * nMe, 4, t.G, t.bid, nMe);
            EpiScaleRow E{(bf16_t*)(a->ws + WS_Y), (const float*)(a->ws + WS_SELG)}; gemm_phase<EpiScaleRow, Order, true, false>(lds, g, S, E);
            SEAM(P + 12);
        }
        if (IN(P + 13)) { ph_combine(kargs(), l, mk_th()); SEAM(P + 13); }
    }
#undef IN
#undef SEAM
    if (MK_TMASK != 0 && blockIdx.x == 0 && threadIdx.x == 0) { asm volatile("s_waitcnt vmcnt(0)" ::: "memory");
        if (MK_TMASK & 0x8000) tp_acc += *(volatile unsigned long long*)(args.ws + WS_CTL + 768 * 1024);
        const unsigned long long t0 = __builtin_amdgcn_s_memrealtime();
        while (__builtin_amdgcn_s_memrealtime() - t0 < MK_TAMP * tp_acc) __builtin_amdgcn_s_sleep(8); }
#ifdef MK_FENCE
    asm volatile("s_waitcnt vmcnt(0)" ::: "memory"); __builtin_amdgcn_fence(__ATOMIC_RELEASE, "agent"); asm volatile("s_waitcnt vmcnt(0)" ::: "memory");
#endif
}


#ifdef MK_DELAY
__global__ void mk_delay() { const unsigned long long t0 = __builtin_amdgcn_s_memrealtime(); while (__builtin_amdgcn_s_memrealtime() - t0 < 2000000ull) __builtin_amdgcn_s_sleep(32); }
#endif
#ifdef MK_DUMP
__global__ void __launch_bounds__(512) mk_dump(const Args args) {
    const unsigned char* ws = args.ws; float* out = args.out;
    const bf16_t* Zr = (const bf16_t*)(ws + WS_ZR); const bf16_t* Zs = (const bf16_t*)(ws + WS_ZS); const bf16_t* Zg = (const bf16_t*)(ws + WS_ZG);
    const bf16_t* Yf = (const bf16_t*)(ws + WS_Y); const bf16_t* Yb = Yf + (size_t)MALL * 1024; const bf16_t* YS = (const bf16_t*)(ws + WS_S);
    const float* BON = (const float*)(ws + WS_BON); const bf16_t* AG = (const bf16_t*)(ws + WS_AG); const float* MOD = (const float*)(ws + WS_MOD);
    for (size_t i = (size_t)blockIdx.x * 512 + threadIdx.x; i < (size_t)MLAT * 1024; i += (size_t)gridDim.x * 512) {
        const size_t m = i >> 10; const int c = (int)(i & 1023); float v = 0.f;
#if MK_DUMP == 1
        if (MK_DSEL & 1) v += bf2f(Zr[m * ZR_LD + c]);
        if (MK_DSEL & 2) v += bf2f(Zr[m * ZR_LD + 1024 + c]);
        if (MK_DSEL & 4) v += bf2f(Zr[m * ZR_LD + 2048 + c]);
        if (MK_DSEL & 8) v += bf2f(Zr[m * ZR_LD + 2560 + c]);
        if (MK_DSEL & 16) v += bf2f(Zs[m * 2048 + c]);
        if (MK_DSEL & 32) v += bf2f(Zs[m * 2048 + 1024 + c]);
        if (MK_DSEL & 64) v += bf2f(Zg[m * 2048 + c]);
        if (MK_DSEL & 128) v += bf2f(Zg[m * 2048 + 1024 + c]);
#elif MK_DUMP == 2
        v = bf2f(Yf[m * 1024 + c]) + bf2f(Yb[m * 1024 + c]);
#elif MK_DUMP == 3
        v = bf2f(YS[m * 1024 + c]);
#elif MK_DUMP == 4
        v = BON[m * 16 + (c & 15)] + bf2f(AG[m * 256 + (c & 255)]);
#elif MK_DUMP == 5
        v = bf2f(Yb[m * 1024 + c]);
#elif MK_DUMP == 6
        v = bf2f(Yf[m * 1024 + c]);
#elif MK_DUMP == 7
        v = bf2f(YS[m * 1024 + c]) + MOD[(i % (2 * 17 * 6144))];
#elif MK_DUMP == 8
        v = bf2f(((const bf16_t*)(ws + WS_WIN))[i % ((size_t)2 * NZ * 1024)]);
#endif
        out[i] = v;
    }
}
#endif
extern "C" void kernel_launch(void* const* d_in, const int* in_sizes, int n_in, void* d_out, int out_size, void* d_ws, size_t ws_size, hipStream_t stream) {
    static int grid = 0;
    if (grid == 0) {
        if (n_in != 33 || out_size != MLAT * D || ws_size < WS_END) { fprintf(stderr, "kernel_launch: unexpected problem (n_in %d out %d ws %zu)\n", n_in, out_size, ws_size); grid = -1; return; }
        int dev = 0, cus = 0, per_cu = 0;
        if (hipGetDevice(&dev) != hipSuccess || hipDeviceGetAttribute(&cus, hipDeviceAttributeMultiprocessorCount, dev) != hipSuccess) { grid = -1; return; }
        if (hipFuncSetAttribute((const void*)mk_fwd, hipFuncAttributeMaxDynamicSharedMemorySize, LDS_BYTES) != hipSuccess) { fprintf(stderr, "kernel_launch: hipFuncSetAttribute failed\n"); grid = -1; return; }
        if (hipOccupancyMaxActiveBlocksPerMultiprocessor(&per_cu, (const void*)mk_fwd, 512, LDS_BYTES) != hipSuccess || per_cu < 1) { fprintf(stderr, "kernel_launch: occupancy query says %d\n", per_cu); }
        (void)hipGetLastError();
        grid = cus > 0 ? cus : 256;
    }
    if (grid < 0) return;
    (void)hipMemsetAsync((char*)d_ws + WS_CTL, 0, CTL_ZERO_BYTES, stream);
    Args a{};
    for (int i = 0; i < 33; ++i) a.in[i] = (const float*)d_in[i];
    a.out = (float*)d_out; a.ws = (unsigned char*)d_ws;
#if MK_SINGLE
    a.ph_lo = 0; a.ph_hi = 2 * NPH;
    hipLaunchKernelGGL(mk_fwd, dim3(grid), dim3(512), LDS_BYTES, stream, a);
#else
#ifdef MK_DELAY
    hipLaunchKernelGGL(mk_delay, dim3(1), dim3(64), 0, stream);
#endif
    for (int k = 0; k < 2 * NPH; ++k) {
        if (k == NPH + 0 || k == NPH + 1 || k == 10 || k == NPH + 10) continue;
        if (k > MK_STOP) break;
        a.ph_lo = k; a.ph_hi = k + 1;
        hipLaunchKernelGGL(mk_fwd, dim3(grid), dim3(512), LDS_BYTES, stream, a);
#ifdef MK_TWICE
        if (k == 2) hipLaunchKernelGGL(mk_fwd, dim3(grid), dim3(512), LDS_BYTES, stream, a);
#endif
    }
#ifdef MK_DUMP
    hipLaunchKernelGGL(mk_dump, dim3(1024), dim3(512), 0, stream, a);
#endif
#endif
}
```

```cpp
#include <hip/hip_runtime.h>
#include <cstdio>
#include <cstdint>

#ifndef MK_TMASK
#define MK_TMASK 0
#endif
#define MK_TAMP 4
#ifndef MK_STOP
#define MK_DSEL 255
#define MK_STOP 99
#endif
#ifndef MK_SINGLE
#define MK_SINGLE 1
#endif

#define GAS __attribute__((address_space(1)))
#define LAS __attribute__((address_space(3)))

typedef unsigned short bf16_t;
typedef short bf16x8 __attribute__((ext_vector_type(8)));
typedef float f32x4 __attribute__((ext_vector_type(4)));
typedef float f32x2 __attribute__((ext_vector_type(2)));
typedef unsigned u32x4 __attribute__((ext_vector_type(4)));
typedef unsigned u32x2 __attribute__((ext_vector_type(2)));

constexpr int D = 1024, NB = 16, TL = 2048, TC = 256;
constexpr int MLAT = NB * TL;
constexpr int MCTX = NB * TC;
constexpr int MALL = MLAT + MCTX;
constexpr int NRW = 3456;
constexpr int NIN = 7552;
constexpr int ZR_LD = 3584;
constexpr int NZ = 7680;
constexpr int NEXP = 16, DFF = 2048;
constexpr float WIN8_SCALE = 32.f;
constexpr float ALPHA = 1.41421356237309515f;
constexpr float LN_EPS = 1e-5f, GN_EPS = 64e-5f;
constexpr int NPH = 14;

constexpr size_t MiB = 1u << 20;
constexpr size_t WS_CTL = 0, CTL_ZERO_BYTES = 1 * MiB;
constexpr size_t WS_MOD = 1 * MiB;
constexpr size_t WS_WIN = 2 * MiB;
constexpr size_t WS_WA = 32 * MiB, WS_WB = 36 * MiB, WS_WO = 40 * MiB;
constexpr size_t WS_G2 = 44 * MiB;
constexpr size_t WS_WSG = 45 * MiB;
constexpr size_t WS_AFF = 46 * MiB;
constexpr size_t WS_INV = 49 * MiB;
constexpr size_t WS_BON = 52 * MiB;
constexpr size_t WS_SELT = 55 * MiB;
constexpr size_t WS_SELG = 55 * MiB + 512 * 1024;
constexpr size_t WS_CXM = 56 * MiB;
constexpr size_t WS_AG = 72 * MiB;
constexpr size_t WS_S = 90 * MiB;
constexpr size_t WS_Y = 162 * MiB;
constexpr size_t WS_XA = 306 * MiB;
constexpr size_t WS_XM = WS_XA + 72 * MiB;
constexpr size_t WS_Z = 450 * MiB;
#ifdef MK_RELOC
constexpr size_t WS_ZS = WS_Z, WS_ZG = WS_ZS + 144 * MiB, WS_ZR = WS_ZG + 144 * MiB;
#else
constexpr size_t WS_ZS = WS_Z + 252 * MiB, WS_ZG = WS_ZS + 144 * MiB, WS_ZR = WS_Z;
#endif
constexpr size_t WS_HID = WS_Z, WS_WE13 = WS_Z + 288 * MiB, WS_WE2 = WS_WE13 + 128 * MiB;
constexpr size_t WS_HQ = 990 * MiB;
constexpr size_t WS_WIN8 = 1026 * MiB;
constexpr size_t WS_END = 1034 * MiB;
static_assert(WS_WE2 + 64 * MiB <= WS_END, "ws map");
constexpr int CW_BAR = 4096;

constexpr int LDS_BYTES = 147456;
constexpr int LDS_MISC = LDS_BYTES - 256;

__device__ __forceinline__ float bf2f(unsigned short b) { return __uint_as_float(((unsigned)b) << 16); }
__device__ __forceinline__ float bflo(unsigned u) { return __uint_as_float(u << 16); }
__device__ __forceinline__ float bfhi(unsigned u) { return __uint_as_float(u & 0xffff0000u); }
typedef __bf16 bf16x2_t __attribute__((ext_vector_type(2)));
__device__ __forceinline__ unsigned cvt_pk_bf16(float lo, float hi) { const f32x2 v = {lo, hi}; const bf16x2_t b = __builtin_convertvector(v, bf16x2_t); return __builtin_bit_cast(unsigned, b); }
__device__ __forceinline__ unsigned short f2bf(float f) { return (unsigned short)(cvt_pk_bf16(f, 0.f) & 0xffffu); }
__device__ __forceinline__ float fast_exp(float x) { return __builtin_amdgcn_exp2f(x * 1.44269504088896341f); }
__device__ __forceinline__ float fast_sigmoid(float x) { return __builtin_amdgcn_rcpf(1.0f + fast_exp(-x)); }
__device__ __forceinline__ float fast_tanh(float x) { const float e = fast_exp(2.0f * x); return 1.0f - 2.0f * __builtin_amdgcn_rcpf(e + 1.0f); }
__device__ __forceinline__ float softplus_f(float x) { return fmaxf(x, 0.f) + __logf(1.0f + fast_exp(-fabsf(x))); }

template <int CTRL> __device__ __forceinline__ float dpp_f(float v) { return __int_as_float(__builtin_amdgcn_update_dpp(0, __float_as_int(v), CTRL, 0xf, 0xf, true)); }
__device__ __forceinline__ float quad_sum(float v) { v += dpp_f<0xB1>(v); v += dpp_f<0x4E>(v); return v; }
__device__ __forceinline__ float oct_sum(float v) { v = quad_sum(v); v += dpp_f<0x141>(v); return v; }
__device__ __forceinline__ float wave_sum(float v) {
    v += dpp_f<0xB1>(v); v += dpp_f<0x4E>(v); v += dpp_f<0x141>(v); v += dpp_f<0x140>(v);
    const int vi = __float_as_int(v);
    const float s0 = __int_as_float(__builtin_amdgcn_readlane(vi, 0)), s1 = __int_as_float(__builtin_amdgcn_readlane(vi, 16)), s2 = __int_as_float(__builtin_amdgcn_readlane(vi, 32)), s3 = __int_as_float(__builtin_amdgcn_readlane(vi, 48));
    return (s0 + s1) + (s2 + s3);
}
__device__ __forceinline__ void lds_barrier() { asm volatile("s_waitcnt lgkmcnt(0)" ::: "memory"); __builtin_amdgcn_s_barrier(); asm volatile("" ::: "memory"); }
__device__ __forceinline__ void wave_lds_fence() { asm volatile("s_waitcnt lgkmcnt(0)" ::: "memory"); __builtin_amdgcn_wave_barrier(); asm volatile("" ::: "memory"); }

__device__ __forceinline__ float clamp_e4m3(float x) { return __builtin_amdgcn_fmed3f(x, -448.0f, 448.0f); }
__device__ __forceinline__ unsigned pk4_fp8(float a, float b, float c, float d) { int p = __builtin_amdgcn_cvt_pk_fp8_f32(clamp_e4m3(a), clamp_e4m3(b), 0, false); p = __builtin_amdgcn_cvt_pk_fp8_f32(clamp_e4m3(c), clamp_e4m3(d), p, true); return (unsigned)p; }
__device__ __forceinline__ f32x2 gelu_pk(f32x2 v) {
    const f32x2 av = __builtin_elementwise_abs(v), d = av * 0.2316418882f + 1.0f;
    f32x2 t; t.x = __builtin_amdgcn_rcpf(d.x); t.y = __builtin_amdgcn_rcpf(d.y);
    f32x2 q = t * 0.5307027145f + (-0.7265760135f); q = q * t + 0.7107068705f; q = q * t + (-0.142248368f); q = q * t + 0.127414796f; q = q * t;
    const f32x2 s = (v * v) * (-0.72134752044f);
    f32x2 e; e.x = __builtin_amdgcn_exp2f(s.x); e.y = __builtin_amdgcn_exp2f(s.y);
    const f32x2 m = v * (q * e), r = v - m;
    f32x2 o; o.x = v.x < 0.f ? m.x : r.x; o.y = v.y < 0.f ? m.y : r.y; return o;
}

#define XB_TMO      128
#define XB_XCNT(j)  (256  + 64 * (j))
#define XB_XSUB(j)  (1280 + 64 * (j))
#define XB_XGEN(j)  (2304 + 64 * (j))
#define XB_TOP      3328
#define XB_TOPGEN   3392
#define XCD_BAR_WORDS 3456
#define XB_SPIN_CAP (1u << 22)
__device__ __forceinline__ unsigned xb_ld(unsigned* p)              { return __hip_atomic_load(p, __ATOMIC_RELAXED, __HIP_MEMORY_SCOPE_AGENT); }
__device__ __forceinline__ unsigned xb_add(unsigned* p, unsigned v) { return __hip_atomic_fetch_add(p, v, __ATOMIC_RELAXED, __HIP_MEMORY_SCOPE_AGENT); }
__device__ __forceinline__ unsigned xb_xcc_id() { return (unsigned)__builtin_amdgcn_s_getreg((3 << 11) | 20) & 0xFu; }
#define XB_SPIN(cond, bar) do { unsigned _sp = 0; while (cond) { __builtin_amdgcn_s_sleep(1); \
    if ((++_sp & 255u) == 0u) { if (xb_ld(&(bar)[XB_TMO])) break; if (_sp > XB_SPIN_CAP) { atomicAdd(&(bar)[XB_TMO], 1u); break; } } } } while (0)
struct XcdBarrier { unsigned* bar; unsigned x; volatile LAS unsigned* st; };
__device__ __forceinline__ XcdBarrier xcd_barrier_post(unsigned* bar, volatile LAS unsigned* st) {
    XcdBarrier b; b.bar = bar; b.x = xb_xcc_id(); b.st = st;
    if (threadIdx.x == 0) (void)xb_add(&bar[XB_XCNT(b.x)], 1u);
    return b;
}
__device__ __forceinline__ void xcd_barrier_complete(unsigned* bar, unsigned x, unsigned& nloc, unsigned& nx) {
    const unsigned G = gridDim.x * gridDim.y * gridDim.z;
    unsigned sum, cnt, mine, sp = 0u;
    for (;;) {
        sum = 0u; cnt = 0u;
#pragma nounroll
        for (unsigned j = 0; j < 16; ++j) { const unsigned c = xb_ld(&bar[XB_XCNT(j)]); sum += c; cnt += (c > 0u) ? 1u : 0u; }
        mine = xb_ld(&bar[XB_XCNT(x)]);
        if (sum == G) break;
        __builtin_amdgcn_s_sleep(1);
        if ((++sp & 255u) == 0u) { if (xb_ld(&bar[XB_TMO])) break; if (sp > XB_SPIN_CAP) { atomicAdd(&bar[XB_TMO], 1u); break; } }
    }
    nloc = mine > 0u ? mine : 1u; nx = cnt > 0u ? cnt : 1u;
}
__device__ __forceinline__ void xcd_barrier(const XcdBarrier& b) {
    asm volatile("s_waitcnt vmcnt(0)" ::: "memory");
    __syncthreads();
    if (threadIdx.x == 0) {
        unsigned* bar = b.bar;
        __builtin_amdgcn_s_waitcnt(0);
        unsigned nloc = b.st[0], nx = b.st[1];
        if (nloc == 0u) { xcd_barrier_complete(bar, b.x, nloc, nx); b.st[0] = nloc; b.st[1] = nx; }
        const unsigned old = xb_add(&bar[XB_XSUB(b.x)], 1u);
        const unsigned gen = old / nloc;
        if (old + 1u == (gen + 1u) * nloc) {
            __builtin_amdgcn_fence(__ATOMIC_RELEASE, "agent");
            asm volatile("s_waitcnt vmcnt(0)" ::: "memory");
            const unsigned og = xb_add(&bar[XB_TOP], 1u);
            const unsigned tg = og / nx;
            if (og + 1u == (tg + 1u) * nx) xb_add(&bar[XB_TOPGEN], 1u);
            else XB_SPIN(xb_ld(&bar[XB_TOPGEN]) == tg, bar);
            __builtin_amdgcn_fence(__ATOMIC_ACQUIRE, "agent");
            xb_add(&bar[XB_XGEN(b.x)], 1u);
            asm volatile("s_waitcnt vmcnt(0)" ::: "memory");
        } else {
            XB_SPIN(xb_ld(&bar[XB_XGEN(b.x)]) == gen, bar);
            __builtin_amdgcn_fence(__ATOMIC_ACQUIRE, "agent");
            asm volatile("s_waitcnt vmcnt(0)" ::: "memory");
        }
    }
    __syncthreads();
}

namespace pg8 {
constexpr int BM = 256, BK = 64, HALF = 128, HTB = HALF * BK * 2, STAGE_BYTES = 8 * HTB, NXCD = 8, WGM = 8;
__host__ __device__ __forceinline__ int lds_byte(int r, int c) { const int st = (r >> 4) * 2 + (c >> 5), rr = r & 15, cc = c & 31, ob = rr * 64 + cc * 2; return st * 1024 + (ob ^ (((ob >> 9) & 1) << 5)); }
__host__ __device__ __forceinline__ void stage_rc(int b, int& R, int& C) { const int st = b / 1024, sb = b % 1024, swz = sb ^ (((sb >> 9) & 1) << 5); R = (st >> 1) * 16 + swz / 64; C = (st & 1) * 32 + (swz % 64) / 2; }
__host__ __device__ __forceinline__ int perm32(int rho) { const int n = rho >> 4, i = rho & 15; return 8 * (i >> 2) + 4 * n + (i & 3); }
struct Unit { int pm, pn; };
struct Gemm { const bf16_t* A; const bf16_t* Bt; int M, N, K; const int* gidx = nullptr; };

struct Order {
    int nM, nN, nwg, G, c, nMe, nNe;
    __device__ void init(int nM_, int nN_, int G_, int c_, int nMe_ = 0) { nM = nM_; nN = nN_; nwg = nM * nN; G = G_; c = c_; nMe = nMe_; nNe = nN_; }
    __device__ bool next(int i, Unit& u) const {
        const long L = (long)i * G + c; if (L >= nwg) return false;
        int wgid = (int)L; { const int q = nwg / NXCD, r = nwg % NXCD, xcd = wgid % NXCD, off = wgid / NXCD; wgid = (xcd < r ? xcd * (q + 1) : r * (q + 1) + (xcd - r) * q) + off; }
        const int nig = WGM * nN, gid = wgid / nig, fm = gid * WGM, gsz = (nM - fm) < WGM ? (nM - fm) : WGM;
        u.pm = fm + ((wgid % nig) % gsz); u.pn = (wgid % nig) / gsz;
        if (nMe > 0) u.pn += (u.pm / nMe) * nNe;
        return true;
    }
    __device__ __forceinline__ void a_ready(const Unit&) const {}
    __device__ __forceinline__ void done(const Unit&) const {}
};

typedef int i32x8 __attribute__((ext_vector_type(8)));
typedef int i32x4 __attribute__((ext_vector_type(4)));
template <class Epi, class Sched, bool FP8 = false, bool GATHER = false, bool ALIGN_EPI = true>
__device__ __forceinline__ void gemm_phase(LAS unsigned char* lds, const Gemm g, const Sched& S, const Epi& E) {
    int tid = threadIdx.x; asm volatile("" : "+v"(tid));
    const int wid = __builtin_amdgcn_readfirstlane(tid >> 6), lane = tid & 63, wr = wid >> 2, wc = wid & 3, fr = lane & 15, fq = lane >> 4;
    const int Kb = FP8 ? g.K : g.K * 2, nt = Kb / 128;
    unsigned voffA[2], voffB[2];
#pragma unroll
    for (int i = 0; i < 2; ++i) { int R, C; stage_rc(tid * 16 + i * 8192, R, C); const int Rb = Epi::PERM ? ((R & ~31) + perm32(R & 31)) : R;
        voffA[i] = (unsigned)(R * Kb + C * 2); voffB[i] = (unsigned)(Rb * Kb + C * 2); }
    unsigned gv[2][2], gn[2][2];
#pragma unroll
    for (int i = 0; i < 2; ++i) { gv[0][i] = gv[1][i] = gn[0][i] = gn[1][i] = 0u; }
#define PG8_GLOAD(dst, pm_) do { if constexpr (GATHER) { int tz_ = threadIdx.x; asm volatile("" : "+v"(tz_)); _Pragma("unroll") for (int i_ = 0; i_ < 2; ++i_) { int R_, C_; stage_rc(tz_ * 16 + i_ * 8192, R_, C_); \
        _Pragma("unroll") for (int h_ = 0; h_ < 2; ++h_) dst[h_][i_] = (unsigned)g.gidx[(pm_) * BM + h_ * HALF + R_] * (unsigned)Kb + (unsigned)(C_ * 2); } } } while (0)
#define PG8_STAGE_A(bufoff, h_, cur_, ko_, nx_) do { if constexpr (GATHER) { if (nx_) PG8_STAGE(bufoff, rsA, (ko_), gn[h_]); else PG8_STAGE(bufoff, rsA, (ko_), gv[h_]); } \
        else PG8_STAGE(bufoff, rsA, (cur_) + (h_) * hstep + (ko_), voffA); } while (0)
    const unsigned kstep = 128u;
    const unsigned hstep = (unsigned)(HALF * Kb);
    const unsigned tstep = 2u * hstep;
    const __amdgpu_buffer_rsrc_t rsA = __builtin_amdgcn_make_buffer_rsrc((void*)g.A, 0, -1, 0x00020000), rsB = __builtin_amdgcn_make_buffer_rsrc((void*)g.Bt, 0, -1, 0x00020000);
    const unsigned ldsw = (unsigned)wid * 1024u;
    const int aoff = lds_byte(wr * 64 + fr, fq * 8), boff = lds_byte(wc * 32 + fr, fq * 8);
#define PG8_SA(b, h) (((b) * 2 + (h)) * HTB)
#define PG8_SB(b, h) ((4 + (b) * 2 + (h)) * HTB)
#define PG8_STAGE(bufoff, rs_, soff, voff) do { _Pragma("unroll") for (int _i = 0; _i < 2; ++_i) \
        __builtin_amdgcn_raw_ptr_buffer_load_lds((rs_), (LAS void*)(lds + (bufoff) + ldsw + _i * 8192), 16, (int)(voff)[_i], (int)(soff), 0, 0); } while (0)
#define PG8_CAT(x0, x1) __builtin_shufflevector(__builtin_bit_cast(i32x4, (x0)), __builtin_bit_cast(i32x4, (x1)), 0, 1, 2, 3, 4, 5, 6, 7)
#define PG8_LDA(dst, b, h) do { _Pragma("unroll") for (int m = 0; m < 4; ++m) { const bf16x8 x0_ = *(const LAS bf16x8*)(lds + PG8_SA(b, h) + aoff + m * 2048), x1_ = *(const LAS bf16x8*)(lds + PG8_SA(b, h) + aoff + m * 2048 + 1024); \
        if constexpr (FP8) dst##8[m] = PG8_CAT(x0_, x1_); else { dst[m][0] = x0_; dst[m][1] = x1_; } } } while (0)
#define PG8_LDB(dst, b, h) do { _Pragma("unroll") for (int n = 0; n < 2; ++n) { const bf16x8 x0_ = *(const LAS bf16x8*)(lds + PG8_SB(b, h) + boff + n * 2048), x1_ = *(const LAS bf16x8*)(lds + PG8_SB(b, h) + boff + n * 2048 + 1024); \
        if constexpr (FP8) dst##8[n] = PG8_CAT(x0_, x1_); else { dst[n][0] = x0_; dst[n][1] = x1_; } } } while (0)
#define PG8_MMA(ai, bj, At, Bt) do { __builtin_amdgcn_s_setprio(1); \
        if constexpr (FP8) { _Pragma("unroll") for (int m = 0; m < 4; ++m) _Pragma("unroll") for (int n = 0; n < 2; ++n) { \
            f32x16& av_ = accv[ai][bj][m >> 1]; constexpr int dummy_ = 0; (void)dummy_; const int e0_ = ((m & 1) * 2 + n) * 4; \
            f32x4 c_ = (f32x4){av_[e0_], av_[e0_ + 1], av_[e0_ + 2], av_[e0_ + 3]}; \
            c_ = __builtin_amdgcn_mfma_scale_f32_16x16x128_f8f6f4(Bt##8[n], At##8[m], c_, 0, 0, 0, 0, 0, 0); \
            av_[e0_] = c_[0]; av_[e0_ + 1] = c_[1]; av_[e0_ + 2] = c_[2]; av_[e0_ + 3] = c_[3]; } } \
        else { _Pragma("unroll") for (int m = 0; m < 4; ++m) _Pragma("unroll") for (int n = 0; n < 2; ++n) _Pragma("unroll") for (int k = 0; k < 2; ++k) \
            acc[ai][bj][m][n] = __builtin_amdgcn_mfma_f32_16x16x32_bf16(Bt[n][k], At[m][k], acc[ai][bj][m][n], 0, 0, 0); } \
        __builtin_amdgcn_s_setprio(0); } while (0)
#ifdef MK_DRAIN
#define PG8_WAIT_V(n) asm volatile("s_waitcnt vmcnt(0)" ::: "memory")
#else
#define PG8_WAIT_V(n) asm volatile("s_waitcnt vmcnt(" #n ")" ::: "memory")
#endif
#define PG8_WAIT_L(n) asm volatile("s_waitcnt lgkmcnt(" #n ")" ::: "memory")
#define PG8_BAR __builtin_amdgcn_s_barrier()
#define PG8_SCHED __builtin_amdgcn_sched_barrier(0)
    Unit cur, nxt; int ui = 0;
    if (!S.next(0, cur)) return;
    f32x4 acc[2][2][4][2];
#pragma unroll
    for (int a = 0; a < 2; ++a)
#pragma unroll
        for (int b = 0; b < 2; ++b)
#pragma unroll
            for (int m = 0; m < 4; ++m)
#pragma unroll
                for (int n = 0; n < 2; ++n) acc[a][b][m][n] = (f32x4){0.f, 0.f, 0.f, 0.f};
    typedef float f32x16 __attribute__((ext_vector_type(16)));
    f32x16 accv[2][2][2];
#pragma unroll
    for (int a = 0; a < 2; ++a)
#pragma unroll
        for (int b = 0; b < 2; ++b)
#pragma unroll
            for (int q = 0; q < 2; ++q)
#pragma unroll
                for (int e = 0; e < 16; ++e) accv[a][b][q][e] = 0.f;
    bf16x8 At[4][2], B0[2][2], B1[2][2]; i32x8 At8[4], B08[2], B18[2];
    unsigned cA = (unsigned)cur.pm * tstep, cB = (unsigned)cur.pn * tstep;
    S.a_ready(cur);
    PG8_GLOAD(gv, cur.pm);
    PG8_STAGE(PG8_SB(0, 0), rsB, cB, voffB); PG8_STAGE(PG8_SB(0, 1), rsB, cB + hstep, voffB); PG8_STAGE_A(PG8_SA(0, 0), 0, cA, 0u, false); PG8_STAGE_A(PG8_SA(0, 1), 1, cA, 0u, false);
    if (wr == 1) PG8_BAR;
    PG8_WAIT_V(2); PG8_BAR;
    PG8_STAGE(PG8_SB(1, 0), rsB, cB + kstep, voffB); PG8_STAGE_A(PG8_SA(1, 0), 0, cA, kstep, false); PG8_STAGE(PG8_SB(1, 1), rsB, cB + hstep + kstep, voffB);
    PG8_WAIT_V(6); PG8_BAR;
    for (;;) {
        const bool has_next = S.next(ui + 1, nxt);
        const unsigned nA = has_next ? (unsigned)nxt.pm * tstep : cA, nB = has_next ? (unsigned)nxt.pn * tstep : cB;
        if constexpr (GATHER) { if (has_next) PG8_GLOAD(gn, nxt.pm); else { _Pragma("unroll") for (int h_ = 0; h_ < 2; ++h_) _Pragma("unroll") for (int i_ = 0; i_ < 2; ++i_) gn[h_][i_] = gv[h_][i_]; } }
        for (int t = 0; t < nt; t += 2) {
            const bool last = (t == nt - 2);
            const unsigned k1 = (unsigned)(t + 1) * kstep, k2 = last ? 0u : (unsigned)(t + 2) * kstep, k3 = k2 + kstep;
            const unsigned aB = last ? nA : cA;
            const unsigned b2 = last ? nB : cB + (unsigned)(t + 2) * kstep, b3 = b2 + kstep;
            if (last && has_next) S.a_ready(nxt);
            PG8_LDB(B0, 0, 0); PG8_LDB(B1, 0, 1); PG8_SCHED; PG8_LDA(At, 0, 0); PG8_STAGE_A(PG8_SA(1, 1), 1, cA, k1, false);
            PG8_WAIT_V(8); PG8_WAIT_L(0); PG8_BAR; PG8_MMA(0, 0, At, B0); PG8_MMA(0, 1, At, B1); PG8_BAR; PG8_SCHED;
            PG8_LDA(At, 0, 1); PG8_STAGE(PG8_SB(0, 0), rsB, b2, voffB); PG8_STAGE(PG8_SB(0, 1), rsB, b2 + hstep, voffB); PG8_STAGE_A(PG8_SA(0, 0), 0, aB, k2, last);
            PG8_WAIT_V(8); PG8_WAIT_L(0); PG8_BAR; PG8_MMA(1, 0, At, B0); PG8_MMA(1, 1, At, B1); PG8_BAR; PG8_SCHED;
            PG8_LDB(B0, 1, 0); PG8_LDB(B1, 1, 1); PG8_SCHED; PG8_LDA(At, 1, 0); PG8_STAGE_A(PG8_SA(0, 1), 1, aB, k2, last);
            PG8_WAIT_V(8); PG8_WAIT_L(0); PG8_BAR; PG8_MMA(0, 0, At, B0); PG8_MMA(0, 1, At, B1); PG8_BAR; PG8_SCHED;
            PG8_LDA(At, 1, 1); PG8_STAGE(PG8_SB(1, 0), rsB, b3, voffB); PG8_STAGE(PG8_SB(1, 1), rsB, b3 + hstep, voffB); PG8_STAGE_A(PG8_SA(1, 0), 0, aB, k3, last);
            PG8_WAIT_V(8); PG8_WAIT_L(0); PG8_BAR; PG8_MMA(1, 0, At, B0); PG8_MMA(1, 1, At, B1); PG8_BAR; PG8_SCHED;
        }
        if constexpr (ALIGN_EPI) { if (wr == 0) PG8_BAR; }
        if constexpr (FP8) {
#pragma unroll
            for (int a_ = 0; a_ < 2; ++a_)
#pragma unroll
                for (int b_ = 0; b_ < 2; ++b_)
#pragma unroll
                    for (int m = 0; m < 4; ++m)
#pragma unroll
                        for (int n = 0; n < 2; ++n) { const f32x16 av_ = accv[a_][b_][m >> 1]; const int e0_ = ((m & 1) * 2 + n) * 4; acc[a_][b_][m][n] = (f32x4){av_[e0_], av_[e0_ + 1], av_[e0_ + 2], av_[e0_ + 3]}; }
        }
        E(acc, cur, wr, wc, fr, fq); S.done(cur);
        if (!has_next) break;
#pragma unroll
        for (int a = 0; a < 2; ++a)
#pragma unroll
            for (int b = 0; b < 2; ++b)
#pragma unroll
                for (int m = 0; m < 4; ++m)
#pragma unroll
                    for (int n = 0; n < 2; ++n) acc[a][b][m][n] = (f32x4){0.f, 0.f, 0.f, 0.f};
#pragma unroll
        for (int a = 0; a < 2; ++a)
#pragma unroll
            for (int b = 0; b < 2; ++b)
#pragma unroll
                for (int q = 0; q < 2; ++q)
#pragma unroll
                    for (int e = 0; e < 16; ++e) accv[a][b][q][e] = 0.f;
        cur = nxt; cA = nA; cB = nB; ++ui;
        if constexpr (GATHER) { _Pragma("unroll") for (int h_ = 0; h_ < 2; ++h_) _Pragma("unroll") for (int i_ = 0; i_ < 2; ++i_) gv[h_][i_] = gn[h_][i_]; }
        if constexpr (ALIGN_EPI) { if (wr == 1) PG8_BAR; }
    }
    PG8_WAIT_V(0);
    if constexpr (!ALIGN_EPI) { if (wr == 0) PG8_BAR; }
    PG8_BAR;
#undef PG8_SA
#undef PG8_GLOAD
#undef PG8_STAGE_A
#undef PG8_SB
#undef PG8_STAGE
#undef PG8_LDA
#undef PG8_LDB
#undef PG8_MMA
#undef PG8_CAT
#undef PG8_WAIT_V
#undef PG8_WAIT_L
#undef PG8_BAR
#undef PG8_SCHED
}


template <class Epi, class Sched>
__device__ __forceinline__ void gemm_simple(LAS unsigned char* lds, const Gemm g, const Sched& S, const Epi& E) {
    int tid = threadIdx.x; asm volatile("" : "+v"(tid));
    const int wid = __builtin_amdgcn_readfirstlane(tid >> 6), lane = tid & 63, wr = wid >> 2, wc = wid & 3, fr = lane & 15, fq = lane >> 4;
    const int K = g.K, nt = K / BK;
    unsigned voffA[2], voffB[2];
#pragma unroll
    for (int i = 0; i < 2; ++i) { int R, C; stage_rc(tid * 16 + i * 8192, R, C); const int Rb = Epi::PERM ? ((R & ~31) + perm32(R & 31)) : R;
        voffA[i] = (unsigned)(R * K + C) * 2u; voffB[i] = (unsigned)(Rb * K + C) * 2u; }
    const size_t hstep = (size_t)HALF * K * 2, tstep = 2 * hstep;
    const int aoff = lds_byte(wr * 64 + fr, fq * 8), boff = lds_byte(wc * 32 + fr, fq * 8);
    Unit cur;
    for (int ui = 0; S.next(ui, cur); ++ui) {
        f32x4 acc[2][2][4][2];
#pragma unroll
        for (int a = 0; a < 2; ++a)
#pragma unroll
            for (int b = 0; b < 2; ++b)
#pragma unroll
                for (int m = 0; m < 4; ++m)
#pragma unroll
                    for (int n = 0; n < 2; ++n) acc[a][b][m][n] = (f32x4){0.f, 0.f, 0.f, 0.f};
        const char* cA = (const char*)g.A + (size_t)cur.pm * tstep; const char* cB = (const char*)g.Bt + (size_t)cur.pn * tstep;
        for (int t = 0; t < nt; ++t) {
            __syncthreads();
#pragma unroll
            for (int h = 0; h < 2; ++h)
#pragma unroll
                for (int i = 0; i < 2; ++i) {
                    const u32x4 va = *(const u32x4*)(cA + h * hstep + (size_t)t * 128 + voffA[i]);
                    const u32x4 vb = *(const u32x4*)(cB + h * hstep + (size_t)t * 128 + voffB[i]);
                    *(LAS u32x4*)(lds + (0 + h) * HTB + tid * 16 + i * 8192) = va;
                    *(LAS u32x4*)(lds + (4 + h) * HTB + tid * 16 + i * 8192) = vb;
                }
            __syncthreads();
            bf16x8 At[4][2], B0[2][2], B1[2][2];
#pragma unroll
            for (int n = 0; n < 2; ++n)
#pragma unroll
                for (int k = 0; k < 2; ++k) { B0[n][k] = *(const LAS bf16x8*)(lds + 4 * HTB + boff + n * 2048 + k * 1024); B1[n][k] = *(const LAS bf16x8*)(lds + 5 * HTB + boff + n * 2048 + k * 1024); }
#pragma unroll
            for (int ai = 0; ai < 2; ++ai) {
#pragma unroll
                for (int m = 0; m < 4; ++m)
#pragma unroll
                    for (int k = 0; k < 2; ++k) At[m][k] = *(const LAS bf16x8*)(lds + ai * HTB + aoff + m * 2048 + k * 1024);
#pragma unroll
                for (int m = 0; m < 4; ++m)
#pragma unroll
                    for (int n = 0; n < 2; ++n)
#pragma unroll
                        for (int k = 0; k < 2; ++k) {
                            acc[ai][0][m][n] = __builtin_amdgcn_mfma_f32_16x16x32_bf16(B0[n][k], At[m][k], acc[ai][0][m][n], 0, 0, 0);
                            acc[ai][1][m][n] = __builtin_amdgcn_mfma_f32_16x16x32_bf16(B1[n][k], At[m][k], acc[ai][1][m][n], 0, 0, 0); }
            }
        }
        E(acc, cur, wr, wc, fr, fq);
    }
    __syncthreads();
}

__device__ __forceinline__ u32x4 pack8(const f32x4 v0, const f32x4 v1) { u32x4 w; w.x = cvt_pk_bf16(v0[0], v0[1]); w.y = cvt_pk_bf16(v0[2], v0[3]); w.z = cvt_pk_bf16(v1[0], v1[1]); w.w = cvt_pk_bf16(v1[2], v1[3]); return w; }

struct EpiZ {
    static constexpr bool PERM = true;
    bf16_t* Zr; bf16_t* Zs; bf16_t* Zg; int rowoff; int pn0; float sc;
    __device__ __forceinline__ void operator()(const f32x4 (&acc)[2][2][4][2], const Unit& u, int wr, int wc, int fr, int fq) const {
        const int row0 = rowoff + u.pm * BM + wr * 64 + fr; const int pn = u.pn + pn0;
        if (pn < 14) {
            bf16_t* base = Zr + (size_t)row0 * ZR_LD + pn * 256 + wc * 32 + 8 * fq;
#pragma unroll
            for (int ai = 0; ai < 2; ++ai)
#pragma unroll
                for (int m = 0; m < 4; ++m)
#pragma unroll
                    for (int bj = 0; bj < 2; ++bj) *(u32x4*)(base + (size_t)(ai * HALF + m * 16) * ZR_LD + bj * HALF) = pack8(acc[ai][bj][m][0], acc[ai][bj][m][1]);
        } else if (pn < 22) {
            bf16_t* base = Zs + (size_t)row0 * 2048 + (pn - 14) * 256 + wc * 32 + 8 * fq;
#pragma unroll
            for (int ai = 0; ai < 2; ++ai)
#pragma unroll
                for (int m = 0; m < 4; ++m)
#pragma unroll
                    for (int bj = 0; bj < 2; ++bj) { const f32x4 v0 = acc[ai][bj][m][0] * sc, v1 = acc[ai][bj][m][1] * sc;
                        const f32x2 a = gelu_pk((f32x2){v0[0], v0[1]}), b = gelu_pk((f32x2){v0[2], v0[3]}), c = gelu_pk((f32x2){v1[0], v1[1]}), d = gelu_pk((f32x2){v1[2], v1[3]});
                        *(u32x4*)(base + (size_t)(ai * HALF + m * 16) * 2048 + bj * HALF) = pack8((f32x4){a.x, a.y, b.x, b.y}, (f32x4){c.x, c.y, d.x, d.y}); }
        } else {
            bf16_t* base = Zg + (size_t)row0 * 2048 + (pn - 22) * 256 + wc * 32 + 8 * fq;
#pragma unroll
            for (int ai = 0; ai < 2; ++ai)
#pragma unroll
                for (int m = 0; m < 4; ++m)
#pragma unroll
                    for (int bj = 0; bj < 2; ++bj) { f32x4 v0 = acc[ai][bj][m][0] * sc, v1 = acc[ai][bj][m][1] * sc;
#pragma unroll
                        for (int j = 0; j < 4; ++j) { v0[j] = fast_sigmoid(v0[j]); v1[j] = fast_sigmoid(v1[j]); }
                        *(u32x4*)(base + (size_t)(ai * HALF + m * 16) * 2048 + bj * HALF) = pack8(v0, v1); }
        }
    }
};
struct EpiMulInPlace {
    static constexpr bool PERM = true;
    bf16_t* IO;
    __device__ __forceinline__ void operator()(const f32x4 (&acc)[2][2][4][2], const Unit& u, int wr, int wc, int fr, int fq) const {
        bf16_t* base = IO + (size_t)(u.pm * BM + wr * 64 + fr) * 1024 + u.pn * 256 + wc * 32 + 8 * fq;
#pragma unroll
        for (int ai = 0; ai < 2; ++ai)
#pragma unroll
            for (int m = 0; m < 4; ++m)
#pragma unroll
                for (int bj = 0; bj < 2; ++bj) { u32x4* p = (u32x4*)(base + (size_t)(ai * HALF + m * 16) * 1024 + bj * HALF); const u32x4 w = *p;
                    const f32x4 a0 = acc[ai][bj][m][0], a1 = acc[ai][bj][m][1];
                    const f32x4 v0 = (f32x4){bflo(w.x) * a0[0], bfhi(w.x) * a0[1], bflo(w.y) * a0[2], bfhi(w.y) * a0[3]};
                    const f32x4 v1 = (f32x4){bflo(w.z) * a1[0], bfhi(w.z) * a1[1], bflo(w.w) * a1[2], bfhi(w.w) * a1[3]};
                    *p = pack8(v0, v1); }
    }
};
template <bool ACCUM> struct EpiGate {
    static constexpr bool PERM = true;
    bf16_t* OUT; const bf16_t* Zg; int goff;
    __device__ __forceinline__ void operator()(const f32x4 (&acc)[2][2][4][2], const Unit& u, int wr, int wc, int fr, int fq) const {
        const int row0 = u.pm * BM + wr * 64 + fr, col0 = u.pn * 256 + wc * 32 + 8 * fq;
#pragma unroll
        for (int ai = 0; ai < 2; ++ai) {
            u32x4 gt[4][2], od[4][2];
#pragma unroll
            for (int m = 0; m < 4; ++m)
#pragma unroll
                for (int bj = 0; bj < 2; ++bj) { const size_t r = (size_t)(row0 + ai * HALF + m * 16);
                    gt[m][bj] = *(const u32x4*)(Zg + r * 2048 + goff + col0 + bj * HALF);
                    if (ACCUM) od[m][bj] = *(const u32x4*)(OUT + r * 1024 + col0 + bj * HALF); else od[m][bj] = (u32x4){0u, 0u, 0u, 0u}; }
#pragma unroll
            for (int m = 0; m < 4; ++m)
#pragma unroll
                for (int bj = 0; bj < 2; ++bj) { const size_t r = (size_t)(row0 + ai * HALF + m * 16); const u32x4 g = gt[m][bj];
                    const f32x4 a0 = acc[ai][bj][m][0], a1 = acc[ai][bj][m][1];
                    f32x4 v0 = (f32x4){bflo(g.x) * a0[0], bfhi(g.x) * a0[1], bflo(g.y) * a0[2], bfhi(g.y) * a0[3]};
                    f32x4 v1 = (f32x4){bflo(g.z) * a1[0], bfhi(g.z) * a1[1], bflo(g.w) * a1[2], bfhi(g.w) * a1[3]};
                    if (ACCUM) { const u32x4 w = od[m][bj]; v0 += (f32x4){bflo(w.x), bfhi(w.x), bflo(w.y), bfhi(w.y)}; v1 += (f32x4){bflo(w.z), bfhi(w.z), bflo(w.w), bfhi(w.w)}; }
                    *(u32x4*)(OUT + r * 1024 + col0 + bj * HALF) = pack8(v0, v1); }
        }
    }
};
struct EpiRes {
    static constexpr bool PERM = true;
    const float* xlat; const float* xctx; const bf16_t* xb; bf16_t* out; const float* gt;
    __device__ __forceinline__ void operator()(const f32x4 (&acc)[2][2][4][2], const Unit& u, int wr, int wc, int fr, int fq) const {
        const int rt = u.pm * BM; const bool isctx = rt >= MLAT;
        const int s = isctx ? 16 : (rt >> 11);
        const int col0 = u.pn * 256 + wc * 32 + 8 * fq;
        f32x4 gv[2][2];
#pragma unroll
        for (int bj = 0; bj < 2; ++bj)
#pragma unroll
            for (int n = 0; n < 2; ++n) gv[bj][n] = *(const f32x4*)(gt + (size_t)s * 6144 + col0 + bj * HALF + n * 4);
        const size_t ro0 = (size_t)(rt + wr * 64 + fr) * 1024 + col0;
        if (xb != nullptr) {
#pragma unroll
            for (int ai = 0; ai < 2; ++ai)
#pragma unroll
                for (int m = 0; m < 4; ++m)
#pragma unroll
                    for (int bj = 0; bj < 2; ++bj) { const size_t ro = ro0 + (size_t)(ai * HALF + m * 16) * 1024 + bj * HALF; const u32x4 w = *(const u32x4*)(xb + ro);
                        const f32x4 x0 = (f32x4){bflo(w.x), bfhi(w.x), bflo(w.y), bfhi(w.y)}, x1 = (f32x4){bflo(w.z), bfhi(w.z), bflo(w.w), bfhi(w.w)};
                        *(u32x4*)(out + ro) = pack8(x0 * ALPHA + gv[bj][0] * acc[ai][bj][m][0], x1 * ALPHA + gv[bj][1] * acc[ai][bj][m][1]); }
        } else {
            const float* xin = isctx ? xctx - (size_t)MLAT * 1024 : xlat;
#pragma unroll
            for (int ai = 0; ai < 2; ++ai)
#pragma unroll
                for (int m = 0; m < 4; ++m)
#pragma unroll
                    for (int bj = 0; bj < 2; ++bj) { const size_t ro = ro0 + (size_t)(ai * HALF + m * 16) * 1024 + bj * HALF;
                        const f32x4 x0 = *(const f32x4*)(xin + ro), x1 = *(const f32x4*)(xin + ro + 4);
                        *(u32x4*)(out + ro) = pack8(x0 * ALPHA + gv[bj][0] * acc[ai][bj][m][0], x1 * ALPHA + gv[bj][1] * acc[ai][bj][m][1]); }
        }
    }
};
constexpr float W13_SCALE = 32.f, W2_SCALE = 64.f, HID_SCALE = 2.f;
struct EpiSwiGLU {
    static constexpr bool PERM = true;
    unsigned char* HID;
    __device__ __forceinline__ void operator()(const f32x4 (&acc)[2][2][4][2], const Unit& u, int wr, int wc, int fr, int fq) const {
        const int pn = u.pn & 15;
        unsigned char* base = HID + (size_t)(u.pm * BM + wr * 64 + fr) * 2048 + pn * 128 + wc * 32 + 8 * fq;
#pragma unroll
        for (int ai = 0; ai < 2; ++ai)
#pragma unroll
            for (int m = 0; m < 4; ++m) { f32x4 v[2];
#pragma unroll
                for (int n = 0; n < 2; ++n) {
#pragma unroll
                    for (int j = 0; j < 4; ++j) { const float x1 = acc[ai][0][m][n][j] * (1.0f / W13_SCALE); v[n][j] = x1 * fast_sigmoid(x1) * (acc[ai][1][m][n][j] * (HID_SCALE / W13_SCALE)); } }
                *(u32x2*)(base + (size_t)(ai * HALF + m * 16) * 2048) = (u32x2){pk4_fp8(v[0][0], v[0][1], v[0][2], v[0][3]), pk4_fp8(v[1][0], v[1][1], v[1][2], v[1][3])};
                asm volatile("" ::: "memory"); }
    }
};
struct EpiScaleRow {
    static constexpr bool PERM = true;
    bf16_t* YE; const float* gate;
    __device__ __forceinline__ void operator()(const f32x4 (&acc)[2][2][4][2], const Unit& u, int wr, int wc, int fr, int fq) const {
        const int pn = u.pn & 3; const int row0 = u.pm * BM + wr * 64 + fr;
#pragma unroll
        for (int ai = 0; ai < 2; ++ai)
#pragma unroll
            for (int m = 0; m < 4; ++m) { const int r = row0 + ai * HALF + m * 16; const float gs = gate[r] * (1.0f / (HID_SCALE * W2_SCALE));
#pragma unroll
                for (int bj = 0; bj < 2; ++bj)
                    *(u32x4*)(YE + (size_t)r * 1024 + pn * 256 + wc * 32 + 8 * fq + bj * HALF) = pack8(acc[ai][bj][m][0] * gs, acc[ai][bj][m][1] * gs); }
    }
};
}

struct Args { const float* in[33]; float* out; unsigned char* ws; int ph_lo, ph_hi; };
enum { I_X = 0, I_C, I_CTX, I_CCTX, I_ADAW, I_ADAB, I_WIN, I_SHIFT, I_W0, I_W2, I_A0, I_A2, I_G2, I_KK, I_KA, I_RK, I_LNXG, I_LNXB, I_SLNG, I_SLNB, I_SGUW, I_SGUB,
       I_WBA, I_WBB, I_WOUT, I_LN1G, I_LN1B, I_ROUTER, I_EW1, I_EW3, I_EW2, I_LN2G, I_LN2B };

struct Th { int tid, lane, wv, G, bid; };
typedef const Args __attribute__((address_space(4)))* KArgP;
__device__ __forceinline__ KArgP kargs() { KArgP p = (KArgP)__builtin_amdgcn_kernarg_segment_ptr(); asm volatile("" : "+s"(p)); return p; }
__device__ __forceinline__ Th mk_th() { Th t; int tid = threadIdx.x; asm volatile("" : "+v"(tid)); int G = gridDim.x, bid = blockIdx.x; asm volatile("" : "+s"(G), "+s"(bid));
    t.tid = tid; t.lane = tid & 63; t.wv = __builtin_amdgcn_readfirstlane(tid >> 6); t.G = G; t.bid = bid; return t; }
__device__ __forceinline__ int opaque_i(int v) { asm volatile("" : "+s"(v)); return v; }

__device__ __forceinline__ void cvt_tile(const float* src, int ldsrc, int k0, int n0, bf16_t* dst, int ldd, int r0, int kd0, LAS unsigned short* T, int lane) {
    f32x4 vv[16];
#pragma unroll
    for (int it = 0; it < 16; ++it) vv[it] = *(const f32x4*)(src + (size_t)(k0 + it * 4 + (lane >> 4)) * ldsrc + n0 + (lane & 15) * 4);
#pragma unroll
    for (int it = 0; it < 16; ++it) {
        const int kk = it * 4 + (lane >> 4), nn = (lane & 15) * 4; const f32x4 v = vv[it];
        T[(nn + 0) * 72 + kk] = f2bf(v[0]); T[(nn + 1) * 72 + kk] = f2bf(v[1]); T[(nn + 2) * 72 + kk] = f2bf(v[2]); T[(nn + 3) * 72 + kk] = f2bf(v[3]);
    }
    wave_lds_fence();
#pragma unroll 4
    for (int it = 0; it < 8; ++it) {
        const int nn = it * 8 + (lane >> 3), ks = (lane & 7) * 8;
        const u32x4 w = *(const LAS u32x4*)(T + nn * 72 + ks);
        *(u32x4*)(dst + (size_t)(r0 + nn) * ldd + kd0 + ks) = w;
    }
    wave_lds_fence();
}
__device__ __forceinline__ void cvt_tile_fp8(const float* src, int ldsrc, int k0, int n0, unsigned char* dst, int ldd, int r0, int kd0, LAS unsigned char* T, int lane, float scale) {
    const int nn = (lane & 15) * 4, kr = 4 * (lane >> 4);
    f32x4 v[4][4];
#pragma unroll
    for (int blk = 0; blk < 4; ++blk)
#pragma unroll
        for (int j = 0; j < 4; ++j) v[blk][j] = *(const f32x4*)(src + (size_t)(k0 + blk * 16 + kr + j) * ldsrc + n0 + nn);
#pragma unroll
    for (int blk = 0; blk < 4; ++blk)
#pragma unroll
        for (int c = 0; c < 4; ++c) *(LAS unsigned*)(T + (nn + c) * 80 + blk * 16 + kr) = pk4_fp8(v[blk][0][c] * scale, v[blk][1][c] * scale, v[blk][2][c] * scale, v[blk][3][c] * scale);
    wave_lds_fence();
#pragma unroll
    for (int it = 0; it < 4; ++it) {
        const int nn = it * 16 + (lane >> 2), ks = (lane & 3) * 16;
        const u32x4 w = *(const LAS u32x4*)(T + nn * 80 + ks);
        *(u32x4*)(dst + (size_t)(r0 + nn) * ldd + kd0 + ks) = w;
    }
    wave_lds_fence();
}
__device__ __forceinline__ int cvt_row(int mode, int n0) {
    if (mode == 1) return n0 < NRW ? n0 : n0 + 128;
    if (mode == 2) return (n0 >> 7) * 256 + (n0 & 127);
    if (mode == 3) return (n0 >> 7) * 256 + 128 + (n0 & 127);
    return n0;
}
__device__ __forceinline__ void cvt_matrix(const float* src, int K, int N, bf16_t* dst, int ldd, int mode, LAS unsigned short* T, int gw, int nw, int lane) {
    const int ntn = N >> 6, ntile = (K >> 6) * ntn;
    for (int t = gw; t < ntile; t += nw) { const int kt = t / ntn, n0 = (t - kt * ntn) * 64; cvt_tile(src, N, kt * 64, n0, dst, ldd, cvt_row(mode, n0), kt * 64, T, lane); }
}

__device__ __forceinline__ void pro_gemv(KArgP a, LAS unsigned char* lds, const Th& t) {
    LAS float* SL = (LAS float*)lds;
    LAS float* RED = SL + 17 * 1024;
    float* MOD = (float*)(a->ws + WS_MOD);
    for (int i = t.tid; i < 17 * 1024; i += 512) { const int s = i >> 10, k = i & 1023; const float v = s < 16 ? a->in[I_C][s * 1024 + k] : a->in[I_CCTX][k]; SL[i] = v * fast_sigmoid(v); }
    __syncthreads();
    for (int slab = t.bid; slab < 256; slab += t.G) {
        const int l = slab >> 7, j0 = (slab & 127) * 48, col = t.tid % 48, kg = t.tid / 48;
        float acc[17];
#pragma unroll
        for (int s = 0; s < 17; ++s) acc[s] = 0.f;
        if (kg < 10) {
            const float* wp = a->in[I_ADAW] + (size_t)l * 1024 * 6144 + j0 + col;
            for (int k0 = kg; k0 < 1024; k0 += 80) {
                float w[8];
#pragma unroll
                for (int u = 0; u < 8; ++u) { const int k = k0 + 10 * u; w[u] = k < 1024 ? wp[(size_t)k * 6144] : 0.f; }
#pragma unroll
                for (int u = 0; u < 8; ++u) { const int k = (k0 + 10 * u) < 1024 ? (k0 + 10 * u) : 1023;
#pragma unroll
                    for (int s = 0; s < 17; ++s) acc[s] += SL[s * 1024 + k] * w[u]; } }
#pragma unroll
            for (int s = 0; s < 17; ++s) RED[(kg * 17 + s) * 48 + col] = acc[s];
        }
        __syncthreads();
        for (int i = t.tid; i < 17 * 48; i += 512) { const int s = i / 48, cc = i % 48; float sum = 0.f;
#pragma unroll
            for (int g = 0; g < 10; ++g) sum += RED[(g * 17 + s) * 48 + cc];
            MOD[((size_t)l * 17 + s) * 6144 + j0 + cc] = sum + a->in[I_ADAB][l * 6144 + j0 + cc]; }
        __syncthreads();
    }
}
__device__ __forceinline__ void pro_cvt(KArgP a, LAS unsigned char* lds, const Th& t) {
    LAS unsigned short* T = (LAS unsigned short*)(lds + 73728) + t.wv * (64 * 72);
    T = (LAS unsigned short*)(lds) + t.wv * (64 * 72);
    const int gw = t.bid * 8 + t.wv, nw = t.G * 8;
    constexpr int TW = 16 * 54, TL = TW + 3 * 256 + 32;
    for (int tt = gw; tt < 2 * TL; tt += nw) {
        const int l = tt >= TL ? 1 : 0, r = tt - l * TL;
        if (r < TW) { const int kt = r / 54, n0 = (r - kt * 54) * 64;
            cvt_tile(a->in[I_WIN] + (size_t)l * 1024 * NIN, NIN, kt * 64, n0, (bf16_t*)(a->ws + WS_WIN) + (size_t)l * NZ * 1024, 1024, n0, kt * 64, T, t.lane); }
        else if (r < TW + 768) { const int r2 = r - TW, m = r2 >> 8, ti = r2 & 255, kt = ti >> 4, n0 = (ti & 15) * 64;
            const float* src = a->in[m == 0 ? I_WBA : (m == 1 ? I_WBB : I_WOUT)] + (size_t)l * 1024 * 1024;
            bf16_t* dst = (bf16_t*)(a->ws + (m == 0 ? WS_WA : (m == 1 ? WS_WB : WS_WO))) + (size_t)l * 1024 * 1024;
            cvt_tile(src, 1024, kt * 64, n0, dst, 1024, n0, kt * 64, T, t.lane); }
        else { const int r3 = r - (TW + 768), kt = r3 >> 4, n0 = (r3 & 15) * 64;
            cvt_tile(a->in[I_G2] + (size_t)l * 128 * 1024, 1024, kt * 64, n0, (bf16_t*)(a->ws + WS_G2) + (size_t)l * 1024 * 256, 256, n0, kt * 64, T, t.lane); }
    }
    {
        __syncthreads();
        LAS unsigned char* T8 = lds + t.wv * (64 * 80);
        for (int l = 0; l < 2; ++l)
            for (int tt = gw; tt < 16 * 64; tt += nw) { const int kt = tt >> 6, n0 = NRW + (tt & 63) * 64;
                cvt_tile_fp8(a->in[I_WIN] + (size_t)l * 1024 * NIN, NIN, kt * 64, n0, a->ws + WS_WIN8 + (size_t)l * 4096 * 1024, 1024, n0 - NRW, kt * 64, T8, t.lane, WIN8_SCALE); }
        __syncthreads();
    }
    const int gt = t.bid * 512 + t.tid, nt = t.G * 512;
    for (int i = gt; i < 2 * 128 * 1024 / 8; i += nt) {
        const int l = i / (128 * 1024 / 8), r = i % (128 * 1024 / 8);
        *(u32x4*)((bf16_t*)(a->ws + WS_WIN) + ((size_t)l * NZ + NRW) * 1024 + (size_t)r * 8) = (u32x4){0u, 0u, 0u, 0u};
    }
    for (int i = gt; i < 2 * 1024 * 128 / 8; i += nt) {
        const int row = i / 16, c8 = i % 16;
        *(u32x4*)((bf16_t*)(a->ws + WS_G2) + (size_t)row * 256 + 128 + c8 * 8) = (u32x4){0u, 0u, 0u, 0u};
    }
    for (int i = gt; i < 2 * 8 * 128 * 128 / 4; i += nt) {
        const f32x4 v = *(const f32x4*)(a->in[I_SGUW] + (size_t)i * 4);
        *(u32x2*)((bf16_t*)(a->ws + WS_WSG) + (size_t)i * 4) = (u32x2){cvt_pk_bf16(v[0], v[1]), cvt_pk_bf16(v[2], v[3])};
    }
}

__device__ __forceinline__ void ph_prologue(KArgP a, LAS unsigned char* lds, const Th& t) {
    const bool odd = (t.bid & 1) != 0;
    if (!odd) { pro_gemv(a, lds, t); __syncthreads(); }
    pro_cvt(a, lds, t);
    if (odd) { __syncthreads(); pro_gemv(a, lds, t); }
}

__device__ __forceinline__ void ln_rows(float (&v)[16]) {
    float s = 0.f;
#pragma unroll
    for (int i = 0; i < 16; ++i) s += v[i];
    const float mean = wave_sum(s) * (1.0f / 1024.0f);
    float q = 0.f;
#pragma unroll
    for (int i = 0; i < 16; ++i) { v[i] -= mean; q += v[i] * v[i]; }
    const float rstd = rsqrtf(wave_sum(q) * (1.0f / 1024.0f) + LN_EPS);
#pragma unroll
    for (int i = 0; i < 16; ++i) v[i] *= rstd;
}
__device__ __forceinline__ void load_row16(const float* p, int lane, float (&v)[16]) {
#pragma unroll
    for (int i = 0; i < 4; ++i) { const f32x4 x = *(const f32x4*)(p + i * 256 + lane * 4); v[4 * i] = x[0]; v[4 * i + 1] = x[1]; v[4 * i + 2] = x[2]; v[4 * i + 3] = x[3]; }
}
__device__ __forceinline__ void load_row16_bf16(const bf16_t* p, int lane, float (&v)[16]) {
#pragma unroll
    for (int i = 0; i < 4; ++i) { const u32x2 x = *(const u32x2*)(p + i * 256 + lane * 4); v[4 * i] = bflo(x.x); v[4 * i + 1] = bfhi(x.x); v[4 * i + 2] = bflo(x.y); v[4 * i + 3] = bfhi(x.y); }
}
__device__ __forceinline__ void store_row16(float* p, int lane, const float (&v)[16]) {
#pragma unroll
    for (int i = 0; i < 4; ++i) *(f32x4*)(p + i * 256 + lane * 4) = (f32x4){v[4 * i], v[4 * i + 1], v[4 * i + 2], v[4 * i + 3]};
}
__device__ __forceinline__ void store_row16_bf16(bf16_t* p, int lane, const float (&v)[16]) {
#pragma unroll
    for (int i = 0; i < 4; ++i) *(u32x2*)(p + i * 256 + lane * 4) = (u32x2){cvt_pk_bf16(v[4 * i], v[4 * i + 1]), cvt_pk_bf16(v[4 * i + 2], v[4 * i + 3])};
}
__device__ __forceinline__ void modulate16(float (&v)[16], const float* sh, const float* sc, int lane) {
#pragma unroll
    for (int i = 0; i < 4; ++i) { const f32x4 a = *(const f32x4*)(sc + i * 256 + lane * 4), b = *(const f32x4*)(sh + i * 256 + lane * 4);
#pragma unroll
        for (int j = 0; j < 4; ++j) v[4 * i + j] = v[4 * i + j] * (1.0f + a[j]) + b[j]; }
}
__device__ __forceinline__ void affine16(float (&v)[16], const float* g, const float* b, int lane) {
#pragma unroll
    for (int i = 0; i < 4; ++i) { const f32x4 a = *(const f32x4*)(g + i * 256 + lane * 4), c = *(const f32x4*)(b + i * 256 + lane * 4);
#pragma unroll
        for (int j = 0; j < 4; ++j) v[4 * i + j] = v[4 * i + j] * a[j] + c[j]; }
}

__device__ __forceinline__ void ph_lnmod0(KArgP a, const Th& t) {
    const float* MOD = (const float*)(a->ws + WS_MOD);
    bf16_t* H = (bf16_t*)(a->ws + WS_S);
    for (int m = t.bid * 8 + t.wv; m < MALL; m += t.G * 8) {
        const int s = m < MLAT ? (m >> 11) : 16;
        const float* xp = m < MLAT ? a->in[I_X] + (size_t)m * 1024 : a->in[I_CTX] + (size_t)(m - MLAT) * 1024;
        float v[16]; load_row16(xp, t.lane, v); ln_rows(v);
        modulate16(v, MOD + (size_t)s * 6144, MOD + (size_t)s * 6144 + 1024, t.lane);
        store_row16_bf16(H + (size_t)m * 1024, t.lane, v);
#pragma unroll
        for (int i = 0; i < 4; ++i) *(unsigned*)(a->ws + WS_HQ + (size_t)m * 1024 + i * 256 + t.lane * 4) = pk4_fp8(v[4 * i], v[4 * i + 1], v[4 * i + 2], v[4 * i + 3]);
    }
}

__device__ __forceinline__ void sgu_block(KArgP a, int l, LAS unsigned char* lds, const Th& t, int ck, int g0, int ng) {
    LAS float* ST = (LAS float*)lds;
    LAS unsigned short* VT0 = (LAS unsigned short*)(lds + 1024);
    const bf16_t* Zs = (const bf16_t*)(a->ws + WS_ZS);
    bf16_t* YS = (bf16_t*)(a->ws + WS_S);
    const bf16_t* WSG = (const bf16_t*)(a->ws + WS_WSG);
    const float* lng = a->in[I_SLNG] + l * 1024; const float* lnb = a->in[I_SLNB] + l * 1024;
    const int fr = t.lane & 15, fq = t.lane >> 4, m0 = ck * 128;
    const int q = t.tid >> 2, seg = t.tid & 3;
    __syncthreads();
    LAS float* LNP = (LAS float*)(lds + 71680);
    *(LAS f32x4*)(LNP + t.tid * 4) = t.tid < 256 ? *(const f32x4*)(lng + t.tid * 4) : *(const f32x4*)(lnb + (t.tid - 256) * 4);
    {
        const u32x4* p = (const u32x4*)(Zs + (size_t)(m0 + q) * 2048 + 1024 + seg * 256);
        float sm = 0.f, ss = 0.f;
#pragma unroll 16
        for (int j = 0; j < 32; ++j) { const u32x4 w = p[j];
            const float x0 = bflo(w.x), x1 = bfhi(w.x), x2 = bflo(w.y), x3 = bfhi(w.y), x4 = bflo(w.z), x5 = bfhi(w.z), x6 = bflo(w.w), x7 = bfhi(w.w);
            sm += ((x0 + x1) + (x2 + x3)) + ((x4 + x5) + (x6 + x7));
            ss += ((x0 * x0 + x1 * x1) + (x2 * x2 + x3 * x3)) + ((x4 * x4 + x5 * x5) + (x6 * x6 + x7 * x7)); }
        sm = quad_sum(sm); ss = quad_sum(ss);
        if (seg == 0) { const float mean = sm * (1.0f / 1024.0f); const float var = fmaxf(ss * (1.0f / 1024.0f) - mean * mean, 0.f); ST[q * 2] = mean; ST[q * 2 + 1] = rsqrtf(var + LN_EPS); }
    }
    u32x4 vreg[4];
    { const u32x4* p = (const u32x4*)(Zs + (size_t)(m0 + q) * 2048 + 1024 + 128 * g0 + 32 * seg);
#pragma unroll
      for (int j = 0; j < 4; ++j) vreg[j] = p[j]; }
    __syncthreads();
    const float mean = ST[q * 2], rstd = ST[q * 2 + 1];
    const int ct0 = 2 * (t.wv & 3), pt0 = 4 * (t.wv >> 2);
    for (int gi = 0; gi < ng; ++gi) {
        const int g = g0 + gi;
        LAS unsigned short* VT = VT0 + (gi & 1) * (128 * 136);
        const bf16_t* Wg = WSG + (size_t)((l * 8 + g) * 128) * 128;
        bf16x8 bfr[4][4];
#pragma unroll
        for (int ks = 0; ks < 4; ++ks)
#pragma unroll
            for (int j = 0; j < 4; ++j) bfr[ks][j] = *(const bf16x8*)(Wg + (size_t)(16 * (pt0 + j) + fr) * 128 + 32 * ks + 8 * fq);
        u32x2 uu[4][2]; float bias[4];
#pragma unroll
        for (int j = 0; j < 4; ++j) { const int p = 16 * (pt0 + j) + fr; bias[j] = a->in[I_SGUB][(l * 8 + g) * 128 + p];
#pragma unroll
            for (int i = 0; i < 2; ++i) uu[j][i] = *(const u32x2*)(Zs + (size_t)(m0 + p) * 2048 + 128 * g + 16 * (ct0 + i) + 4 * fq); }
#pragma unroll
        for (int j = 0; j < 4; ++j) { const u32x4 w = vreg[j]; const int c0 = 32 * seg + 8 * j; const int ch = 128 * g + c0;
            const f32x4 g0v = *(const LAS f32x4*)(LNP + ch), g1v = *(const LAS f32x4*)(LNP + ch + 4), b0 = *(const LAS f32x4*)(LNP + 1024 + ch), b1 = *(const LAS f32x4*)(LNP + 1024 + ch + 4);
            VT[(c0 + 0) * 136 + q] = f2bf((bflo(w.x) - mean) * rstd * g0v[0] + b0[0]); VT[(c0 + 1) * 136 + q] = f2bf((bfhi(w.x) - mean) * rstd * g0v[1] + b0[1]);
            VT[(c0 + 2) * 136 + q] = f2bf((bflo(w.y) - mean) * rstd * g0v[2] + b0[2]); VT[(c0 + 3) * 136 + q] = f2bf((bfhi(w.y) - mean) * rstd * g0v[3] + b0[3]);
            VT[(c0 + 4) * 136 + q] = f2bf((bflo(w.z) - mean) * rstd * g1v[0] + b1[0]); VT[(c0 + 5) * 136 + q] = f2bf((bfhi(w.z) - mean) * rstd * g1v[1] + b1[1]);
            VT[(c0 + 6) * 136 + q] = f2bf((bflo(w.w) - mean) * rstd * g1v[2] + b1[2]); VT[(c0 + 7) * 136 + q] = f2bf((bfhi(w.w) - mean) * rstd * g1v[3] + b1[3]); }
        if (gi + 1 < ng) { const u32x4* p = (const u32x4*)(Zs + (size_t)(m0 + q) * 2048 + 1024 + 128 * (g + 1) + 32 * seg);
#pragma unroll
            for (int j = 0; j < 4; ++j) vreg[j] = p[j]; }
        lds_barrier();
        f32x4 acc[2][4];
#pragma unroll
        for (int i = 0; i < 2; ++i)
#pragma unroll
            for (int j = 0; j < 4; ++j) acc[i][j] = (f32x4){0.f, 0.f, 0.f, 0.f};
#pragma unroll
        for (int ks = 0; ks < 4; ++ks) {
            bf16x8 af[2];
#pragma unroll
            for (int i = 0; i < 2; ++i) af[i] = *(const LAS bf16x8*)(VT + (16 * (ct0 + i) + fr) * 136 + 32 * ks + 8 * fq);
#pragma unroll
            for (int i = 0; i < 2; ++i)
#pragma unroll
                for (int j = 0; j < 4; ++j) acc[i][j] = __builtin_amdgcn_mfma_f32_16x16x32_bf16(af[i], bfr[ks][j], acc[i][j], 0, 0, 0);
        }
#pragma unroll
        for (int j = 0; j < 4; ++j) { const int p = 16 * (pt0 + j) + fr; const size_t m = (size_t)(m0 + p);
#pragma unroll
            for (int i = 0; i < 2; ++i) { const int c0 = 16 * (ct0 + i) + 4 * fq; const f32x4 r = acc[i][j]; const u32x2 u2 = uu[j][i];
                *(u32x2*)(YS + m * 1024 + 128 * g + c0) = (u32x2){cvt_pk_bf16(bflo(u2.x) * (r[0] + bias[j]), bfhi(u2.x) * (r[1] + bias[j])), cvt_pk_bf16(bflo(u2.y) * (r[2] + bias[j]), bfhi(u2.y) * (r[3] + bias[j]))}; } }
    }
}
__device__ __forceinline__ void ph_sgu(KArgP a, int l, LAS unsigned char* lds, const Th& t) {
    for (int w = t.bid; w < 256; w += t.G) sgu_block(a, l, lds, t, w, 0, 8);
    if (l == 0) for (int w = t.bid; w < 256; w += t.G) sgu_block(a, l, lds, t, 256 + (w >> 3), w & 7, 1);
    __syncthreads();
}

__device__ __forceinline__ void ph_scan(KArgP a, int l, LAS unsigned char* lds, const Th& t) {
    LAS float* OPS = (LAS float*)lds;
    LAS float* W2L = (LAS float*)(lds + 49152);
    LAS float* A2L = (LAS float*)(lds + 81920);
    LAS float* TDL = (LAS float*)(lds + 114688);
    LAS float* YL = (LAS float*)(lds + 131072);
    const bf16_t* Zr = (const bf16_t*)(a->ws + WS_ZR);
    bf16_t* Yf = (bf16_t*)(a->ws + WS_Y); bf16_t* Yb = Yf + (size_t)MALL * 1024;
    float* BON = (float*)(a->ws + WS_BON);
    const float* scw = a->in[I_SHIFT] + (size_t)l * 3 * NRW;
    const int lane = t.lane, wv = t.wv, dir = wv >> 2, wq = wv & 3;
    for (int unit = t.bid; unit < 256; unit += t.G) {
        const int b = unit >> 4, h = unit & 15;
        __syncthreads();
        for (int idx = t.tid; idx < 8192; idx += 512) { const int d_ = idx >> 12, i = (idx >> 6) & 63, c = idx & 63; const size_t o = ((size_t)(l * 2 + d_) * 64 + i) * 1024 + 64 * h + c;
            W2L[idx] = a->in[I_W2][o]; A2L[idx] = a->in[I_A2][o]; }
        const int ch = 64 * h + lane;
        const float w0v = a->in[I_W0][(l * 2 + dir) * 1024 + ch], a0v = a->in[I_A0][(l * 2 + dir) * 1024 + ch];
        const float kkv = a->in[I_KK][l * 1024 + ch], kav = a->in[I_KA][l * 1024 + ch], rkv = a->in[I_RK][l * 1024 + ch];
        float swr[3], swk[3], swv[3], swd[3], swa[3];
#pragma unroll
        for (int j = 0; j < 3; ++j) { swr[j] = scw[j * NRW + ch]; swk[j] = scw[j * NRW + 1024 + ch]; swv[j] = scw[j * NRW + 2048 + ch];
            swd[j] = scw[j * NRW + 3072 + 64 * dir + lane]; swa[j] = scw[j * NRW + 3200 + 64 * dir + lane]; }
        float S[2][8];
#pragma unroll
        for (int r = 0; r < 2; ++r)
#pragma unroll
            for (int k = 0; k < 8; ++k) S[r][k] = 0.f;
        const int rp = lane >> 3, cg = lane & 7;
        __syncthreads();
        for (int blk = 0; blk < 144; ++blk) {
            const bool isctx = blk < 16; const int jj = isctx ? blk : blk - 16; const int Tseq = isctx ? TC : TL;
            const int mbase = isctx ? (MLAT + b * TC) : b * TL;
            float rr[4], kx[4], vx[4], lw[4], la[4];
#pragma unroll
            for (int q = 0; q < 4; ++q) {
                const int s = 4 * wq + q; const int tl = dir == 0 ? 16 * jj + s : Tseq - 1 - (16 * jj + s);
                const bf16_t* z0 = Zr + (size_t)(mbase + tl) * ZR_LD;
                float r_ = 0.f, k_ = 0.f, v_ = 0.f, dw_ = 0.f, da_ = 0.f;
#pragma unroll
                for (int j = 0; j < 3; ++j) { const int tt = tl + j - 1;
                    if (tt >= 0 && tt < Tseq) { const bf16_t* zz = z0 + (j - 1) * ZR_LD;
                        r_ += swr[j] * bf2f(zz[ch]); k_ += swk[j] * bf2f(zz[1024 + ch]); v_ += swv[j] * bf2f(zz[2048 + ch]);
                        dw_ += swd[j] * bf2f(zz[3072 + 64 * dir + lane]); da_ += swa[j] * bf2f(zz[3200 + 64 * dir + lane]); } }
                rr[q] = r_; kx[q] = k_; vx[q] = v_; lw[q] = 0.f; la[q] = 0.f;
                TDL[wv * 512 + lane * 4 + q] = fast_tanh(dw_); TDL[wv * 512 + 256 + lane * 4 + q] = da_;
            }
            wave_lds_fence();
#pragma unroll 8
            for (int i = 0; i < 64; ++i) { const float w2v = W2L[dir * 4096 + i * 64 + lane], a2v = A2L[dir * 4096 + i * 64 + lane];
                const f32x4 td = *(const LAS f32x4*)(TDL + wv * 512 + i * 4), dd = *(const LAS f32x4*)(TDL + wv * 512 + 256 + i * 4);
#pragma unroll
                for (int q = 0; q < 4; ++q) { lw[q] += td[q] * w2v; la[q] += dd[q] * a2v; } }
#pragma unroll
            for (int q = 0; q < 4; ++q) {
                const int s = 4 * wq + q; const int tl = dir == 0 ? 16 * jj + s : Tseq - 1 - (16 * jj + s);
                const float wlog = -softplus_f(-(w0v + lw[q])) - 0.5f; const float dcy = fast_exp(-fast_exp(wlog));
                const float av = fast_sigmoid(a0v + la[q]);
                const float kraw = kx[q] * kkv; const float ssq = wave_sum(kraw * kraw); const float kap = kraw * rsqrtf(fmaxf(ssq, 1e-12f));
                const float kd = kx[q] * (1.0f + (av - 1.0f) * kav);
                LAS float* o = OPS + ((dir * 16 + s) * 6) * 64 + lane;
                o[0] = kap; o[64] = dcy; o[128] = kap * av; o[192] = kd; o[256] = rr[q]; o[320] = vx[q];
                if (dir == 0) { const float bs = wave_sum(rr[q] * kd * rkv); if (lane == 0) BON[(size_t)(mbase + tl) * 16 + h] = bs; }
            }
            __syncthreads();
#pragma unroll 2
            for (int s = 0; s < 16; ++s) {
                const LAS float* o = OPS + ((dir * 16 + s) * 6) * 64 + 8 * cg;
                const f32x4 ka0 = *(const LAS f32x4*)(o), ka1 = *(const LAS f32x4*)(o + 4);
                const f32x4 d0 = *(const LAS f32x4*)(o + 64), d1 = *(const LAS f32x4*)(o + 68);
                const f32x4 b0 = *(const LAS f32x4*)(o + 128), b1 = *(const LAS f32x4*)(o + 132);
                const f32x4 k0 = *(const LAS f32x4*)(o + 192), k1 = *(const LAS f32x4*)(o + 196);
                const f32x4 r0 = *(const LAS f32x4*)(o + 256), r1 = *(const LAS f32x4*)(o + 260);
                const f32x2 v2 = *(const LAS f32x2*)(OPS + ((dir * 16 + s) * 6 + 5) * 64 + 16 * wq + 2 * rp);
                float u[2], y[2];
#pragma unroll
                for (int r = 0; r < 2; ++r) {
                    float us = 0.f, ys = 0.f;
#pragma unroll
                    for (int k = 0; k < 4; ++k) { us += S[r][k] * ka0[k] + S[r][4 + k] * ka1[k]; ys += S[r][k] * r0[k] + S[r][4 + k] * r1[k]; }
                    u[r] = oct_sum(us); y[r] = ys;
                }
#pragma unroll
                for (int r = 0; r < 2; ++r) {
                    const float vr = r == 0 ? v2.x : v2.y;
#pragma unroll
                    for (int k = 0; k < 4; ++k) { S[r][k] = S[r][k] * d0[k] - u[r] * b0[k] + vr * k0[k]; S[r][4 + k] = S[r][4 + k] * d1[k] - u[r] * b1[k] + vr * k1[k]; }
                }
                if (dir == 0) {
#pragma unroll
                    for (int r = 0; r < 2; ++r) { float ys = 0.f;
#pragma unroll
                        for (int k = 0; k < 4; ++k) ys += S[r][k] * r0[k] + S[r][4 + k] * r1[k];
                        y[r] = ys; }
                }
                y[0] = oct_sum(y[0]); y[1] = oct_sum(y[1]);
                if (cg == 0) *(LAS f32x2*)(YL + (dir * 16 + s) * 64 + 16 * wq + 2 * rp) = (f32x2){y[0], y[1]};
            }
            __syncthreads();
            for (int idx = t.tid; idx < 2048; idx += 512) { const int d_ = idx >> 10, s = (idx >> 6) & 15, c = idx & 63;
                const int tl = d_ == 0 ? 16 * jj + s : Tseq - 1 - (16 * jj + s);
                (d_ ? Yb : Yf)[(size_t)(mbase + tl) * 1024 + 64 * h + c] = f2bf(YL[idx]); }
        }
    }
}


__device__ __forceinline__ float row16_sum(float v) { v += dpp_f<0xB1>(v); v += dpp_f<0x4E>(v); v += dpp_f<0x141>(v); v += dpp_f<0x140>(v); return v; }
__device__ __forceinline__ void ph_scan2(KArgP a, int l, LAS unsigned char* lds, const Th& t) {
    LAS float* OPS = (LAS float*)lds;
    LAS unsigned short* ZA = (LAS unsigned short*)(lds + 49152);
    LAS float* PART = (LAS float*)(lds + 58368);
    LAS float* YL = (LAS float*)(lds + 59392);
    const bf16_t* Zr = (const bf16_t*)(a->ws + WS_ZR);
    bf16_t* Yf = (bf16_t*)(a->ws + WS_Y); bf16_t* Yb = Yf + (size_t)MALL * 1024;
    float* BON = (float*)(a->ws + WS_BON);
    const float* scw = a->in[I_SHIFT] + (size_t)l * 3 * NRW;
    const int lane = t.lane, wv = t.wv, dir = wv >> 2, wq = wv & 3, fr = lane & 15, fq = lane >> 4;
    const int zq = wq & 1, zth = wq >> 1;
    const int rp = lane >> 3, cg = lane & 7;
    for (int unit = t.bid; unit < 256; unit += t.G) {
        const int b = unit >> 4, h = unit & 15;
        const int ch = 64 * h + 16 * wq + fr;
        bf16x8 bw[2], ba[2];
        {
            const float* w2p = a->in[I_W2] + ((size_t)(l * 2 + dir) * 64) * 1024 + ch; const float* a2p = a->in[I_A2] + ((size_t)(l * 2 + dir) * 64) * 1024 + ch;
#pragma unroll
            for (int ks = 0; ks < 2; ++ks) { unsigned pw[4], pa[4];
#pragma unroll
                for (int e = 0; e < 4; ++e) { const int k0 = 32 * ks + 8 * fq + 2 * e;
                    pw[e] = cvt_pk_bf16(w2p[(size_t)k0 * 1024], w2p[(size_t)(k0 + 1) * 1024]); pa[e] = cvt_pk_bf16(a2p[(size_t)k0 * 1024], a2p[(size_t)(k0 + 1) * 1024]); }
                bw[ks] = __builtin_bit_cast(bf16x8, (u32x4){pw[0], pw[1], pw[2], pw[3]}); ba[ks] = __builtin_bit_cast(bf16x8, (u32x4){pa[0], pa[1], pa[2], pa[3]}); }
        }
        const float w0v = a->in[I_W0][(l * 2 + dir) * 1024 + ch], a0v = a->in[I_A0][(l * 2 + dir) * 1024 + ch];
        const float kkv = a->in[I_KK][l * 1024 + ch], kav = a->in[I_KA][l * 1024 + ch], rkv = a->in[I_RK][l * 1024 + ch];
        float swr[3], swk[3], swv[3], swz[3];
        const int zcol = 3072 + 128 * zq + 64 * dir + lane;
#pragma unroll
        for (int j = 0; j < 3; ++j) { swr[j] = scw[j * NRW + ch]; swk[j] = scw[j * NRW + 1024 + ch]; swv[j] = scw[j * NRW + 2048 + ch]; swz[j] = scw[j * NRW + zcol]; }
        float S[2][8];
#pragma unroll
        for (int r = 0; r < 2; ++r)
#pragma unroll
            for (int k = 0; k < 8; ++k) S[r][k] = 0.f;
        unsigned short pr[6], pk[6], pv[6], pz[10];
#define SCAN_LOADS(blk_) do { const int blk__ = (blk_); const bool isctx__ = blk__ < 16; const int jj__ = isctx__ ? blk__ : blk__ - 16; const int Tseq__ = isctx__ ? TC : TL; \
            const int mbase__ = isctx__ ? (MLAT + b * TC) : b * TL; const int t0__ = dir == 0 ? 16 * jj__ : Tseq__ - 16 * (jj__ + 1); \
            _Pragma("unroll") for (int e = 0; e < 6; ++e) { const int rr = t0__ + 4 * fq - 1 + e; const bool ok = rr >= 0 && rr < Tseq__; const bf16_t* zz = Zr + (size_t)(mbase__ + (ok ? rr : 0)) * ZR_LD + ch; \
                pr[e] = ok ? zz[0] : (unsigned short)0; pk[e] = ok ? zz[1024] : (unsigned short)0; pv[e] = ok ? zz[2048] : (unsigned short)0; } \
            _Pragma("unroll") for (int e = 0; e < 10; ++e) { const int rr = t0__ + 8 * zth - 1 + e; const bool ok = rr >= 0 && rr < Tseq__; \
                pz[e] = ok ? Zr[(size_t)(mbase__ + rr) * ZR_LD + zcol] : (unsigned short)0; } } while (0)
#define SCAN_PREP(blk_) do { const int blk__ = (blk_); const bool isctx__ = blk__ < 16; const int jj__ = isctx__ ? blk__ : blk__ - 16; const int Tseq__ = isctx__ ? TC : TL; \
            const int mbase__ = isctx__ ? (MLAT + b * TC) : b * TL; const int t0__ = dir == 0 ? 16 * jj__ : Tseq__ - 16 * (jj__ + 1); \
            float r4[4], k4[4], v4[4]; \
            _Pragma("unroll") for (int j = 0; j < 4; ++j) { r4[j] = swr[0] * bf2f(pr[j]) + swr[1] * bf2f(pr[j + 1]) + swr[2] * bf2f(pr[j + 2]); \
                k4[j] = swk[0] * bf2f(pk[j]) + swk[1] * bf2f(pk[j + 1]) + swk[2] * bf2f(pk[j + 2]); v4[j] = swv[0] * bf2f(pv[j]) + swv[1] * bf2f(pv[j + 1]) + swv[2] * bf2f(pv[j + 2]); } \
            _Pragma("unroll") for (int j = 0; j < 8; ++j) { float zv = swz[0] * bf2f(pz[j]) + swz[1] * bf2f(pz[j + 1]) + swz[2] * bf2f(pz[j + 2]); if (zq == 0) zv = fast_tanh(zv); \
                ZA[((dir * 2 + zq) * 16 + 8 * zth + j) * 72 + lane] = f2bf(zv); } \
            __syncthreads(); \
            f32x4 lw = (f32x4){0.f, 0.f, 0.f, 0.f}, la = (f32x4){0.f, 0.f, 0.f, 0.f}; \
            _Pragma("unroll") for (int ks = 0; ks < 2; ++ks) { \
                const bf16x8 aw = *(const LAS bf16x8*)(ZA + ((dir * 2 + 0) * 16 + fr) * 72 + 32 * ks + 8 * fq); const bf16x8 aa = *(const LAS bf16x8*)(ZA + ((dir * 2 + 1) * 16 + fr) * 72 + 32 * ks + 8 * fq); \
                lw = __builtin_amdgcn_mfma_f32_16x16x32_bf16(aw, bw[ks], lw, 0, 0, 0); la = __builtin_amdgcn_mfma_f32_16x16x32_bf16(aa, ba[ks], la, 0, 0, 0); } \
            float dc4[4], av4[4], kr4[4], kd4[4]; \
            _Pragma("unroll") for (int j = 0; j < 4; ++j) { const float wlog = -softplus_f(-(w0v + lw[j])) - 0.5f; dc4[j] = fast_exp(-fast_exp(wlog)); av4[j] = fast_sigmoid(a0v + la[j]); \
                kr4[j] = k4[j] * kkv; kd4[j] = k4[j] * (1.0f + (av4[j] - 1.0f) * kav); \
                const float pn = row16_sum(kr4[j] * kr4[j]); const float pb = row16_sum(r4[j] * kd4[j] * rkv); \
                if (fr == 0) *(LAS f32x2*)(PART + ((dir * 16 + 4 * fq + j) * 4 + wq) * 2) = (f32x2){pn, pb}; } \
            __syncthreads(); \
            _Pragma("unroll") for (int j = 0; j < 4; ++j) { const int ti = 4 * fq + j; const f32x4 p0 = *(const LAS f32x4*)(PART + (dir * 16 + ti) * 8), p1 = *(const LAS f32x4*)(PART + (dir * 16 + ti) * 8 + 4); \
                const float nrm = (p0[0] + p0[2]) + (p1[0] + p1[2]); const float kap = kr4[j] * rsqrtf(fmaxf(nrm, 1e-12f)); \
                const int sidx = dir ? 15 - ti : ti; LAS float* o = OPS + ((dir * 16 + sidx) * 6) * 64 + 16 * wq + fr; \
                o[0] = kap; o[64] = dc4[j]; o[128] = kap * av4[j]; o[192] = kd4[j]; o[256] = r4[j]; o[320] = v4[j]; \
                if (dir == 0 && wq == 0 && fr == 0) BON[(size_t)(mbase__ + t0__ + ti) * 16 + h] = (p0[1] + p0[3]) + (p1[1] + p1[3]); } \
            __syncthreads(); } while (0)
        __syncthreads();
        SCAN_LOADS(0);
        SCAN_PREP(0);
        for (int blk = 0; blk < 144; ++blk) {
            const bool isctx = blk < 16; const int jj = isctx ? blk : blk - 16; const int Tseq = isctx ? TC : TL;
            const int mbase = isctx ? (MLAT + b * TC) : b * TL;
            if (blk + 1 < 144) SCAN_LOADS(blk + 1);
#pragma unroll 4
            for (int s = 0; s < 16; ++s) {
                const LAS float* o = OPS + ((dir * 16 + s) * 6) * 64 + 8 * cg;
                const f32x4 ka0 = *(const LAS f32x4*)(o), ka1 = *(const LAS f32x4*)(o + 4);
                const f32x4 d0 = *(const LAS f32x4*)(o + 64), d1 = *(const LAS f32x4*)(o + 68);
                const f32x4 b0 = *(const LAS f32x4*)(o + 128), b1 = *(const LAS f32x4*)(o + 132);
                const f32x4 k0 = *(const LAS f32x4*)(o + 192), k1 = *(const LAS f32x4*)(o + 196);
                const f32x4 r0 = *(const LAS f32x4*)(o + 256), r1 = *(const LAS f32x4*)(o + 260);
                const f32x2 v2 = *(const LAS f32x2*)(OPS + ((dir * 16 + s) * 6 + 5) * 64 + 16 * wq + 2 * rp);
                float u[2], y[2];
#pragma unroll
                for (int r = 0; r < 2; ++r) {
                    float us = 0.f, ys = 0.f;
#pragma unroll
                    for (int k = 0; k < 4; ++k) { us += S[r][k] * ka0[k] + S[r][4 + k] * ka1[k]; if (dir == 1) ys += S[r][k] * r0[k] + S[r][4 + k] * r1[k]; }
                    u[r] = oct_sum(us); y[r] = ys;
                }
#pragma unroll
                for (int r = 0; r < 2; ++r) {
                    const float vr = r == 0 ? v2.x : v2.y;
#pragma unroll
                    for (int k = 0; k < 4; ++k) { S[r][k] = S[r][k] * d0[k] - u[r] * b0[k] + vr * k0[k]; S[r][4 + k] = S[r][4 + k] * d1[k] - u[r] * b1[k] + vr * k1[k]; }
                }
                if (dir == 0) {
#pragma unroll
                    for (int r = 0; r < 2; ++r) { float ys = 0.f;
#pragma unroll
                        for (int k = 0; k < 4; ++k) ys += S[r][k] * r0[k] + S[r][4 + k] * r1[k];
                        y[r] = ys; }
                }
                y[0] = oct_sum(y[0]); y[1] = oct_sum(y[1]);
                if (cg == 0) *(LAS f32x2*)(YL + (dir * 16 + s) * 64 + 16 * wq + 2 * rp) = (f32x2){y[0], y[1]};
            }
            __syncthreads();
            for (int idx = t.tid; idx < 2048; idx += 512) { const int d_ = idx >> 10, s = (idx >> 6) & 15, c = idx & 63;
                const int tl = d_ == 0 ? 16 * jj + s : Tseq - 1 - (16 * jj + s);
                (d_ ? Yb : Yf)[(size_t)(mbase + tl) * 1024 + 64 * h + c] = f2bf(YL[idx]); }
            if (blk + 1 < 144) SCAN_PREP(blk + 1);
        }
#undef SCAN_LOADS
#undef SCAN_PREP
    }
}


typedef short bf16x4 __attribute__((ext_vector_type(4)));
__device__ __forceinline__ bf16x4 pack4(const f32x4 v) { const u32x2 p = {cvt_pk_bf16(v[0], v[1]), cvt_pk_bf16(v[2], v[3])}; return __builtin_bit_cast(bf16x4, p); }
#define MFMA16(a_, b_, c_) __builtin_amdgcn_mfma_f32_16x16x16bf16_1k((a_), (b_), (c_), 0, 0, 0)
__device__ __forceinline__ void ph_scan3(KArgP a, int l, LAS unsigned char* lds, const Th& t) {
    LAS unsigned short* ZA = (LAS unsigned short*)(lds);
    LAS float* PART = (LAS float*)(lds + 9216);
    LAS float* YL = (LAS float*)(lds + 10240);
    LAS unsigned short* TS = (LAS unsigned short*)(lds + 18432);
    LAS unsigned short* CS = (LAS unsigned short*)(lds + 35840);
    LAS float* GAM = (LAS float*)(lds + 51200);
    const bf16_t* Zr = (const bf16_t*)(a->ws + WS_ZR);
    bf16_t* Yf = (bf16_t*)(a->ws + WS_Y); bf16_t* Yb = Yf + (size_t)MALL * 1024;
    float* BON = (float*)(a->ws + WS_BON);
    const float* scw = a->in[I_SHIFT] + (size_t)l * 3 * NRW;
    const int lane = t.lane, wv = t.wv, dir = wv >> 2, wq = wv & 3, fr = lane & 15, fq = lane >> 4;
    LAS unsigned short* TSd = TS + dir * (4 * 16 * 68); LAS unsigned short* CSd = CS + dir * (3 * 64 * 20);
    for (int unit = t.bid; unit < 256; unit += t.G) {
        const int b = unit >> 4, h = unit & 15;
        const int cl = 16 * wq + fr, ch = 64 * h + cl;
        bf16x8 bw[2], ba[2];
        {
            const float* w2p = a->in[I_W2] + ((size_t)(l * 2 + dir) * 64) * 1024 + ch; const float* a2p = a->in[I_A2] + ((size_t)(l * 2 + dir) * 64) * 1024 + ch;
#pragma unroll
            for (int ks = 0; ks < 2; ++ks) { unsigned pw[4], pa[4];
#pragma unroll
                for (int e = 0; e < 4; ++e) { const int k0 = 32 * ks + 8 * fq + 2 * e;
                    pw[e] = cvt_pk_bf16(w2p[(size_t)k0 * 1024], w2p[(size_t)(k0 + 1) * 1024]); pa[e] = cvt_pk_bf16(a2p[(size_t)k0 * 1024], a2p[(size_t)(k0 + 1) * 1024]); }
                bw[ks] = __builtin_bit_cast(bf16x8, (u32x4){pw[0], pw[1], pw[2], pw[3]}); ba[ks] = __builtin_bit_cast(bf16x8, (u32x4){pa[0], pa[1], pa[2], pa[3]}); }
        }
        const float w0v = a->in[I_W0][(l * 2 + dir) * 1024 + ch], a0v = a->in[I_A0][(l * 2 + dir) * 1024 + ch];
        const float kkv = a->in[I_KK][l * 1024 + ch], kav = a->in[I_KA][l * 1024 + ch], rkv = a->in[I_RK][l * 1024 + ch];
        float swr[3], swk[3], swv[3], swz[3], swy[3];
        const int zcol = 3072 + 64 * dir + lane;
#pragma unroll
        for (int j = 0; j < 3; ++j) { swr[j] = scw[j * NRW + ch]; swk[j] = scw[j * NRW + 1024 + ch]; swv[j] = scw[j * NRW + 2048 + ch]; swz[j] = scw[j * NRW + zcol]; swy[j] = scw[j * NRW + zcol + 128]; }
        f32x4 Sreg[4];
#pragma unroll
        for (int k = 0; k < 4; ++k) Sreg[k] = (f32x4){0.f, 0.f, 0.f, 0.f};
        f32x4 Idm;
#pragma unroll
        for (int j = 0; j < 4; ++j) Idm[j] = (4 * fq + j == fr) ? 1.0f : 0.0f;
        unsigned short pr[6], pk[6], pv[6], pz[6], py[6];
#define SCAN_LOADS(blk_) do { const int blk__ = (blk_); const bool isctx__ = blk__ < 16; const int jj__ = isctx__ ? blk__ : blk__ - 16; const int Tseq__ = isctx__ ? TC : TL; \
            const int mbase__ = isctx__ ? (MLAT + b * TC) : b * TL; const int t0__ = dir == 0 ? 16 * jj__ : Tseq__ - 16 * (jj__ + 1); \
            _Pragma("unroll") for (int e = 0; e < 6; ++e) { int rr = t0__ + 4 * fq - 1 + e; rr = rr < 0 ? 0 : (rr >= Tseq__ ? Tseq__ - 1 : rr); const bf16_t* zz = Zr + (size_t)(mbase__ + rr) * ZR_LD + ch; \
                pr[e] = zz[0]; pk[e] = zz[1024]; pv[e] = zz[2048]; } \
            _Pragma("unroll") for (int e = 0; e < 6; ++e) { int rr = t0__ + 4 * wq - 1 + e; rr = rr < 0 ? 0 : (rr >= Tseq__ ? Tseq__ - 1 : rr); const bf16_t* zz = Zr + (size_t)(mbase__ + rr) * ZR_LD + zcol; \
                pz[e] = zz[0]; py[e] = zz[128]; } } while (0)
        __syncthreads();
        SCAN_LOADS(0);
        for (int blk = 0; blk < 144; ++blk) {
            const bool isctx = blk < 16; const int jj = isctx ? blk : blk - 16; const int Tseq = isctx ? TC : TL;
            const int mbase = isctx ? (MLAT + b * TC) : b * TL; const int t0 = dir == 0 ? 16 * jj : Tseq - 16 * (jj + 1);
            if (fq == 0 && t0 == 0) { pr[0] = 0; pk[0] = 0; pv[0] = 0; }
            if (fq == 3 && t0 + 16 == Tseq) { pr[5] = 0; pk[5] = 0; pv[5] = 0; }
            if (wq == 0 && t0 == 0) { pz[0] = 0; py[0] = 0; }
            if (wq == 3 && t0 + 16 == Tseq) { pz[5] = 0; py[5] = 0; }
            float r4[4], k4[4], v4[4];
#pragma unroll
            for (int j = 0; j < 4; ++j) { r4[j] = swr[0] * bf2f(pr[j]) + swr[1] * bf2f(pr[j + 1]) + swr[2] * bf2f(pr[j + 2]);
                k4[j] = swk[0] * bf2f(pk[j]) + swk[1] * bf2f(pk[j + 1]) + swk[2] * bf2f(pk[j + 2]); v4[j] = swv[0] * bf2f(pv[j]) + swv[1] * bf2f(pv[j + 1]) + swv[2] * bf2f(pv[j + 2]); }
#pragma unroll
            for (int j = 0; j < 4; ++j) { const float zw = fast_tanh(swz[0] * bf2f(pz[j]) + swz[1] * bf2f(pz[j + 1]) + swz[2] * bf2f(pz[j + 2])); const float za = swy[0] * bf2f(py[j]) + swy[1] * bf2f(py[j + 1]) + swy[2] * bf2f(py[j + 2]);
                ZA[((dir * 2 + 0) * 16 + 4 * wq + j) * 72 + lane] = f2bf(zw); ZA[((dir * 2 + 1) * 16 + 4 * wq + j) * 72 + lane] = f2bf(za); }
            lds_barrier();
            if (blk + 1 < 144) SCAN_LOADS(blk + 1);
            f32x4 lw = (f32x4){0.f, 0.f, 0.f, 0.f}, la = (f32x4){0.f, 0.f, 0.f, 0.f};
#pragma unroll
            for (int ks = 0; ks < 2; ++ks) {
                const bf16x8 aw = *(const LAS bf16x8*)(ZA + ((dir * 2 + 0) * 16 + fr) * 72 + 32 * ks + 8 * fq); const bf16x8 aa = *(const LAS bf16x8*)(ZA + ((dir * 2 + 1) * 16 + fr) * 72 + 32 * ks + 8 * fq);
                lw = __builtin_amdgcn_mfma_f32_16x16x32_bf16(aw, bw[ks], lw, 0, 0, 0); la = __builtin_amdgcn_mfma_f32_16x16x32_bf16(aa, ba[ks], la, 0, 0, 0); }
            float dc4[4], av4[4], kr4[4], kd4[4];
#pragma unroll
            for (int j = 0; j < 4; ++j) { dc4[j] = __builtin_amdgcn_exp2f(-0.87503877f * fast_sigmoid(w0v + lw[j])); av4[j] = fast_sigmoid(a0v + la[j]);
                kr4[j] = k4[j] * kkv; kd4[j] = k4[j] * (1.0f + (av4[j] - 1.0f) * kav);
                const float pn = row16_sum(kr4[j] * kr4[j]); const float pb = row16_sum(r4[j] * kd4[j] * rkv);
                if (fr == 0) *(LAS f32x2*)(PART + ((dir * 16 + 4 * fq + j) * 4 + wq) * 2) = (f32x2){pn, pb}; }
            lds_barrier();
            {
                float kap[4], bet[4];
#pragma unroll
                for (int j = 0; j < 4; ++j) { const int ti = 4 * fq + j; const f32x4 p0 = *(const LAS f32x4*)(PART + (dir * 16 + ti) * 8), p1 = *(const LAS f32x4*)(PART + (dir * 16 + ti) * 8 + 4);
                    const float nrm = (p0[0] + p0[2]) + (p1[0] + p1[2]); kap[j] = kr4[j] * rsqrtf(fmaxf(nrm, 1e-12f)); bet[j] = kap[j] * av4[j];
                    if (dir == 0 && wq == 0 && fr == 0) BON[(size_t)(mbase + t0 + ti) * 16 + h] = (p0[1] + p0[3]) + (p1[1] + p1[3]); }
                const float g = (dc4[0] * dc4[1]) * (dc4[2] * dc4[3]);
                const float g0 = __shfl(g, fr), g1 = __shfl(g, fr + 16), g2 = __shfl(g, fr + 32), g3 = __shfl(g, fr + 48);
                const float gall = (g0 * g1) * (g2 * g3);
                const float pre = dir == 0 ? (fq == 0 ? 1.0f : fq == 1 ? g0 : fq == 2 ? g0 * g1 : g0 * g1 * g2) : (fq == 3 ? 1.0f : fq == 2 ? g3 : fq == 1 ? g3 * g2 : g3 * g2 * g1);
                float dcs[4], kps[4], bts[4], kds[4], rs[4], vs[4];
#pragma unroll
                for (int e = 0; e < 4; ++e) { dcs[e] = dir ? dc4[3 - e] : dc4[e]; kps[e] = dir ? kap[3 - e] : kap[e]; bts[e] = dir ? bet[3 - e] : bet[e];
                    kds[e] = dir ? kd4[3 - e] : kd4[e]; rs[e] = dir ? r4[3 - e] : r4[e]; vs[e] = dir ? v4[3 - e] : v4[e]; }
                const int sg = dir ? 3 - fq : fq;
                float run = pre; f32x4 kpv, bpv, vvv;
#pragma unroll
                for (int e = 0; e < 4; ++e) { const float gm1 = run; run *= dcs[e]; const float inv = __builtin_amdgcn_rcpf(run);
                    const float ktv = kps[e] * gm1, rtv = rs[e] * (dir ? gm1 : run), khv = kds[e] * inv, bhv = bts[e] * inv;
                    kpv[e] = khv * gall; bpv[e] = -(bhv * gall); vvv[e] = vs[e];
                    const int so = (4 * sg + e) * 68 + cl;
                    TSd[so] = f2bf(ktv); TSd[16 * 68 + so] = f2bf(rtv); TSd[2 * 16 * 68 + so] = f2bf(khv); TSd[3 * 16 * 68 + so] = f2bf(bhv); }
                *(LAS bf16x4*)(CSd + cl * 20 + 4 * sg) = pack4(kpv); *(LAS bf16x4*)(CSd + 64 * 20 + cl * 20 + 4 * sg) = pack4(bpv); *(LAS bf16x4*)(CSd + 2 * 64 * 20 + cl * 20 + 4 * sg) = pack4(vvv);
                if (fq == 0) GAM[dir * 64 + cl] = gall;
            }
            lds_barrier();
            {
                bf16x4 kt[4], rt[4], kh[4], bh[4];
#pragma unroll
                for (int ks = 0; ks < 4; ++ks) { const int o = fr * 68 + 16 * ks + 4 * fq;
                    kt[ks] = *(const LAS bf16x4*)(TSd + o); rt[ks] = *(const LAS bf16x4*)(TSd + 16 * 68 + o); kh[ks] = *(const LAS bf16x4*)(TSd + 2 * 16 * 68 + o); bh[ks] = *(const LAS bf16x4*)(TSd + 3 * 16 * 68 + o); }
                const bf16x4 vtf = *(const LAS bf16x4*)(CSd + 2 * 64 * 20 + cl * 20 + 4 * fq);
                f32x4 AkD = (f32x4){0.f, 0.f, 0.f, 0.f}, ND = AkD, ArkD = AkD, ArbD = AkD, NtD = AkD;
#pragma unroll
                for (int ks = 0; ks < 4; ++ks) { AkD = MFMA16(kh[ks], kt[ks], AkD); ND = MFMA16(bh[ks], kt[ks], ND); ArkD = MFMA16(kh[ks], rt[ks], ArkD); ArbD = MFMA16(bh[ks], rt[ks], ArbD); NtD = MFMA16(kt[ks], bh[ks], NtD); }
#pragma unroll
                for (int j = 0; j < 4; ++j) { const int i = 4 * fq + j; const bool st = i < fr; const bool inc = dir ? (i < fr) : (i <= fr);
                    AkD[j] = st ? AkD[j] : 0.f; ND[j] = st ? ND[j] : 0.f; ArkD[j] = inc ? ArkD[j] : 0.f; ArbD[j] = inc ? -ArbD[j] : 0.f; NtD[j] = (fr < i) ? NtD[j] : 0.f; }
                const f32x4 Z4 = (f32x4){0.f, 0.f, 0.f, 0.f};
                const bf16x4 pN = pack4(ND), pNt = pack4(NtD);
                const f32x4 N2 = MFMA16(pNt, pN, Z4), N2t = MFMA16(pN, pNt, Z4);
                const bf16x4 pN2 = pack4(N2), pN2t = pack4(N2t);
                const f32x4 N4 = MFMA16(pN2t, pN2, Z4), N4t = MFMA16(pN2, pN2t, Z4);
                const f32x4 N8 = MFMA16(pack4(N4t), pack4(N4), Z4);
                const bf16x4 pImNt = pack4(Idm - NtD), pIpN2 = pack4(Idm + N2);
                const f32x4 T1t = MFMA16(pIpN2, pImNt, Z4);
                const f32x4 T2 = MFMA16(pack4(Idm + N4t), pack4(Idm + N8), Z4);
                const f32x4 TD = MFMA16(pack4(T1t), pack4(T2), Z4);
                bf16x4 sb[4];
#pragma unroll
                for (int ks = 0; ks < 4; ++ks) sb[ks] = pack4(Sreg[ks]);
                f32x4 Pt = Z4, Yt = Z4;
#pragma unroll
                for (int ks = 0; ks < 4; ++ks) { Pt = MFMA16(kt[ks], sb[ks], Pt); Yt = MFMA16(rt[ks], sb[ks], Yt); }
                const f32x4 Qt = MFMA16(pack4(AkD), vtf, Pt);
                const f32x4 Ut = MFMA16(pack4(TD), pack4(Qt), Z4);
                const bf16x4 ub = pack4(Ut);
                Yt = MFMA16(pack4(ArkD), vtf, Yt); Yt = MFMA16(pack4(ArbD), ub, Yt);
#pragma unroll
                for (int ks = 0; ks < 4; ++ks) {
                    const f32x4 gm = *(const LAS f32x4*)(GAM + dir * 64 + 16 * ks + 4 * fq);
                    const bf16x4 kpf = *(const LAS bf16x4*)(CSd + (16 * ks + fr) * 20 + 4 * fq), bpf = *(const LAS bf16x4*)(CSd + 64 * 20 + (16 * ks + fr) * 20 + 4 * fq);
                    f32x4 c = Sreg[ks] * gm; c = MFMA16(kpf, vtf, c); c = MFMA16(bpf, ub, c); Sreg[ks] = c; }
                bf16_t* yo = (dir ? Yb : Yf) + (size_t)mbase * 1024 + 64 * h + cl;
#pragma unroll
                for (int j = 0; j < 4; ++j) { const int sidx = 4 * fq + j; const int tl = dir == 0 ? 16 * jj + sidx : Tseq - 1 - (16 * jj + sidx); yo[(size_t)tl * 1024] = f2bf(Yt[j]); }
            }
        }
#undef SCAN_LOADS
    }
}

__device__ __forceinline__ void ph_scan4(KArgP a, int l, LAS unsigned char* lds, const Th& t) {
    LAS unsigned short* ZA = (LAS unsigned short*)(lds);
    LAS float* PART = (LAS float*)(lds + 9216);
    LAS unsigned short* TS = (LAS unsigned short*)(lds + 10496);
    LAS unsigned short* CS = (LAS unsigned short*)(lds + 45312);
    LAS float* GAM = (LAS float*)(lds + 76032);
    const bf16_t* Zr = (const bf16_t*)(a->ws + WS_ZR);
    bf16_t* Yf = (bf16_t*)(a->ws + WS_Y); bf16_t* Yb = Yf + (size_t)MALL * 1024;
    float* BON = (float*)(a->ws + WS_BON); float* DUMMY = (float*)(a->ws + WS_CTL + 512 * 1024);
    const float* scw = a->in[I_SHIFT] + (size_t)l * 3 * NRW;
    LAS bf16x8* BF = (LAS bf16x8*)(lds + 77056);
    const int lane = t.lane, wv = t.wv, dir = wv >> 2, wq = wv & 3, fr = lane & 15, fq = lane >> 4;
    for (int unit = t.bid; unit < 256; unit += t.G) {
        const int b = unit >> 4, h = unit & 15;
        const int cl = 16 * wq + fr, ch = 64 * h + cl;
        {
            bf16x8 bw[2], ba[2];
            const float* w2p = a->in[I_W2] + ((size_t)(l * 2 + dir) * 64) * 1024 + ch; const float* a2p = a->in[I_A2] + ((size_t)(l * 2 + dir) * 64) * 1024 + ch;
#pragma unroll
            for (int ks = 0; ks < 2; ++ks) { unsigned pw[4], pa[4];
#pragma unroll
                for (int e = 0; e < 4; ++e) { const int k0 = 32 * ks + 8 * fq + 2 * e;
                    pw[e] = cvt_pk_bf16(w2p[(size_t)k0 * 1024], w2p[(size_t)(k0 + 1) * 1024]); pa[e] = cvt_pk_bf16(a2p[(size_t)k0 * 1024], a2p[(size_t)(k0 + 1) * 1024]); }
                bw[ks] = __builtin_bit_cast(bf16x8, (u32x4){pw[0], pw[1], pw[2], pw[3]}); ba[ks] = __builtin_bit_cast(bf16x8, (u32x4){pa[0], pa[1], pa[2], pa[3]}); }
            __syncthreads();
#pragma unroll
            for (int ks = 0; ks < 2; ++ks) { BF[(ks * 2 + 0) * 512 + t.tid] = bw[ks]; BF[(ks * 2 + 1) * 512 + t.tid] = ba[ks]; }
        }
        const float w0v = a->in[I_W0][(l * 2 + dir) * 1024 + ch], a0v = a->in[I_A0][(l * 2 + dir) * 1024 + ch];
        const float kkv = a->in[I_KK][l * 1024 + ch], kav = a->in[I_KA][l * 1024 + ch], rkv = a->in[I_RK][l * 1024 + ch];
        float swr[3], swk[3], swv[3], swz[3], swy[3];
        const int zcol = 3072 + 64 * dir + lane;
#pragma unroll
        for (int j = 0; j < 3; ++j) { swr[j] = scw[j * NRW + ch]; swk[j] = scw[j * NRW + 1024 + ch]; swv[j] = scw[j * NRW + 2048 + ch]; swz[j] = scw[j * NRW + zcol]; swy[j] = scw[j * NRW + zcol + 128]; }
        f32x4 Sreg[4];
#pragma unroll
        for (int k = 0; k < 4; ++k) Sreg[k] = (f32x4){0.f, 0.f, 0.f, 0.f};
        f32x4 Idm;
#pragma unroll
        for (int j = 0; j < 4; ++j) Idm[j] = (4 * fq + j == fr) ? 1.0f : 0.0f;
        unsigned short pr[6], pk[6], pv[6], pz[6], py[6];
#define SCAN_LOADS(blk_) do { const int blk__ = (blk_); const bool isctx__ = blk__ < 16; const int jj__ = isctx__ ? blk__ : blk__ - 16; const int Tseq__ = isctx__ ? TC : TL; \
            const int mbase__ = isctx__ ? (MLAT + b * TC) : b * TL; const int t0__ = dir == 0 ? 16 * jj__ : Tseq__ - 16 * (jj__ + 1); \
            _Pragma("unroll") for (int e = 0; e < 6; ++e) { int rr = t0__ + 4 * fq - 1 + e; rr = rr < 0 ? 0 : (rr >= Tseq__ ? Tseq__ - 1 : rr); const bf16_t* zz = Zr + (size_t)(mbase__ + rr) * ZR_LD + ch; \
                pr[e] = zz[0]; pk[e] = zz[1024]; pv[e] = zz[2048]; } \
            _Pragma("unroll") for (int e = 0; e < 6; ++e) { int rr = t0__ + 4 * wq - 1 + e; rr = rr < 0 ? 0 : (rr >= Tseq__ ? Tseq__ - 1 : rr); const bf16_t* zz = Zr + (size_t)(mbase__ + rr) * ZR_LD + zcol; \
                pz[e] = zz[0]; py[e] = zz[128]; } } while (0)
        float r4[4], k4[4], v4[4], dc4[4], av4[4], kr4[4], kd4[4];
        bf16x4 pAk, pArk, pArb, pT;
#define BLKINFO(blk_) const int blk__ = (blk_); const bool isctx__ = blk__ < 16; const int jj__ = isctx__ ? blk__ : blk__ - 16; const int Tseq__ = isctx__ ? TC : TL; \
            const int mbase__ = isctx__ ? (MLAT + b * TC) : b * TL; const int t0__ = dir == 0 ? 16 * jj__ : Tseq__ - 16 * (jj__ + 1); (void)mbase__; (void)t0__
#define SC_E1(blk_) do { BLKINFO(blk_); \
            if (fq == 0 && t0__ == 0) { pr[0] = 0; pk[0] = 0; pv[0] = 0; } \
            if (fq == 3 && t0__ + 16 == Tseq__) { pr[5] = 0; pk[5] = 0; pv[5] = 0; } \
            if (wq == 0 && t0__ == 0) { pz[0] = 0; py[0] = 0; } \
            if (wq == 3 && t0__ + 16 == Tseq__) { pz[5] = 0; py[5] = 0; } \
            _Pragma("unroll") for (int j = 0; j < 4; ++j) { r4[j] = swr[0] * bf2f(pr[j]) + swr[1] * bf2f(pr[j + 1]) + swr[2] * bf2f(pr[j + 2]); \
                k4[j] = swk[0] * bf2f(pk[j]) + swk[1] * bf2f(pk[j + 1]) + swk[2] * bf2f(pk[j + 2]); v4[j] = swv[0] * bf2f(pv[j]) + swv[1] * bf2f(pv[j + 1]) + swv[2] * bf2f(pv[j + 2]); } \
            _Pragma("unroll") for (int j = 0; j < 4; ++j) { const float zw = fast_tanh(swz[0] * bf2f(pz[j]) + swz[1] * bf2f(pz[j + 1]) + swz[2] * bf2f(pz[j + 2])); const float za = swy[0] * bf2f(py[j]) + swy[1] * bf2f(py[j + 1]) + swy[2] * bf2f(py[j + 2]); \
                ZA[((dir * 2 + 0) * 16 + 4 * wq + j) * 72 + lane] = f2bf(zw); ZA[((dir * 2 + 1) * 16 + 4 * wq + j) * 72 + lane] = f2bf(za); } } while (0)
#define SC_E2() do { \
            f32x4 lw = (f32x4){0.f, 0.f, 0.f, 0.f}, la = (f32x4){0.f, 0.f, 0.f, 0.f}; \
            _Pragma("unroll") for (int ks = 0; ks < 2; ++ks) { \
                const bf16x8 aw = *(const LAS bf16x8*)(ZA + ((dir * 2 + 0) * 16 + fr) * 72 + 32 * ks + 8 * fq); const bf16x8 aa = *(const LAS bf16x8*)(ZA + ((dir * 2 + 1) * 16 + fr) * 72 + 32 * ks + 8 * fq); \
                lw = __builtin_amdgcn_mfma_f32_16x16x32_bf16(aw, BF[(ks * 2 + 0) * 512 + t.tid], lw, 0, 0, 0); la = __builtin_amdgcn_mfma_f32_16x16x32_bf16(aa, BF[(ks * 2 + 1) * 512 + t.tid], la, 0, 0, 0); } \
            _Pragma("unroll") for (int j = 0; j < 4; ++j) { dc4[j] = __builtin_amdgcn_exp2f(-0.87503877f * fast_sigmoid(w0v + lw[j])); av4[j] = fast_sigmoid(a0v + la[j]); \
                kr4[j] = k4[j] * kkv; kd4[j] = k4[j] * (1.0f + (av4[j] - 1.0f) * kav); \
                const float pn = row16_sum(kr4[j] * kr4[j]); const float pb = row16_sum(r4[j] * kd4[j] * rkv); \
                *(LAS f32x2*)(PART + (fr == 0 ? ((dir * 16 + 4 * fq + j) * 4 + wq) * 2 : 256 + 2 * (lane & 7))) = (f32x2){pn, pb}; } } while (0)
#define SC_E3(blk_, buf_) do { BLKINFO(blk_); \
            LAS unsigned short* TSd = TS + ((buf_) * 2 + dir) * (4 * 16 * 68); LAS unsigned short* CSd = CS + ((buf_) * 2 + dir) * (3 * 64 * 20); \
            float kap[4], bet[4]; \
            _Pragma("unroll") for (int j = 0; j < 4; ++j) { const int ti = 4 * fq + j; const f32x4 p0 = *(const LAS f32x4*)(PART + (dir * 16 + ti) * 8), p1 = *(const LAS f32x4*)(PART + (dir * 16 + ti) * 8 + 4); \
                const float nrm = (p0[0] + p0[2]) + (p1[0] + p1[2]); kap[j] = kr4[j] * rsqrtf(fmaxf(nrm, 1e-12f)); bet[j] = kap[j] * av4[j]; \
                float* bo = (dir == 0 && wq == 0 && fr == 0) ? BON + (size_t)(mbase__ + t0__ + ti) * 16 + h : DUMMY + lane; *bo = (p0[1] + p0[3]) + (p1[1] + p1[3]); } \
            const float g = (dc4[0] * dc4[1]) * (dc4[2] * dc4[3]); \
            const float g0 = __shfl(g, fr), g1 = __shfl(g, fr + 16), g2 = __shfl(g, fr + 32), g3 = __shfl(g, fr + 48); \
            const float gall = (g0 * g1) * (g2 * g3); \
            const float pre = dir == 0 ? (fq == 0 ? 1.0f : fq == 1 ? g0 : fq == 2 ? g0 * g1 : g0 * g1 * g2) : (fq == 3 ? 1.0f : fq == 2 ? g3 : fq == 1 ? g3 * g2 : g3 * g2 * g1); \
            float dcs[4], kps[4], bts[4], kds[4], rs[4], vs[4]; \
            _Pragma("unroll") for (int e = 0; e < 4; ++e) { dcs[e] = dir ? dc4[3 - e] : dc4[e]; kps[e] = dir ? kap[3 - e] : kap[e]; bts[e] = dir ? bet[3 - e] : bet[e]; \
                kds[e] = dir ? kd4[3 - e] : kd4[e]; rs[e] = dir ? r4[3 - e] : r4[e]; vs[e] = dir ? v4[3 - e] : v4[e]; } \
            const int sg = dir ? 3 - fq : fq; \
            float run = pre; f32x4 kpv, bpv, vvv; \
            _Pragma("unroll") for (int e = 0; e < 4; ++e) { const float gm1 = run; run *= dcs[e]; const float inv = __builtin_amdgcn_rcpf(run); \
                const float ktv = kps[e] * gm1, rtv = rs[e] * (dir ? gm1 : run), khv = kds[e] * inv, bhv = bts[e] * inv; \
                kpv[e] = khv * gall; bpv[e] = -(bhv * gall); vvv[e] = vs[e]; \
                const int so = (4 * sg + e) * 68 + cl; \
                TSd[so] = f2bf(ktv); TSd[16 * 68 + so] = f2bf(rtv); TSd[2 * 16 * 68 + so] = f2bf(khv); TSd[3 * 16 * 68 + so] = f2bf(bhv); } \
            *(LAS bf16x4*)(CSd + cl * 20 + 4 * sg) = pack4(kpv); *(LAS bf16x4*)(CSd + 64 * 20 + cl * 20 + 4 * sg) = pack4(bpv); *(LAS bf16x4*)(CSd + 2 * 64 * 20 + cl * 20 + 4 * sg) = pack4(vvv); \
            GAM[((buf_) * 2 + dir) * 64 + cl] = gall; } while (0)
#define SC_MA(buf_) do { \
            const LAS unsigned short* TSd = TS + ((buf_) * 2 + dir) * (4 * 16 * 68); \
            bf16x4 kt[4], rt[4], kh[4], bh[4]; \
            _Pragma("unroll") for (int ks = 0; ks < 4; ++ks) { const int o = fr * 68 + 16 * ks + 4 * fq; \
                kt[ks] = *(const LAS bf16x4*)(TSd + o); rt[ks] = *(const LAS bf16x4*)(TSd + 16 * 68 + o); kh[ks] = *(const LAS bf16x4*)(TSd + 2 * 16 * 68 + o); bh[ks] = *(const LAS bf16x4*)(TSd + 3 * 16 * 68 + o); } \
            f32x4 AkD = (f32x4){0.f, 0.f, 0.f, 0.f}, ND = AkD, ArkD = AkD, ArbD = AkD, NtD = AkD; \
            _Pragma("unroll") for (int ks = 0; ks < 4; ++ks) { AkD = MFMA16(kh[ks], kt[ks], AkD); ND = MFMA16(bh[ks], kt[ks], ND); ArkD = MFMA16(kh[ks], rt[ks], ArkD); ArbD = MFMA16(bh[ks], rt[ks], ArbD); NtD = MFMA16(kt[ks], bh[ks], NtD); } \
            _Pragma("unroll") for (int j = 0; j < 4; ++j) { const int i = 4 * fq + j; const bool st = i < fr; const bool inc = dir ? (i < fr) : (i <= fr); \
                AkD[j] = st ? AkD[j] : 0.f; ND[j] = st ? ND[j] : 0.f; ArkD[j] = inc ? ArkD[j] : 0.f; ArbD[j] = inc ? -ArbD[j] : 0.f; NtD[j] = (fr < i) ? NtD[j] : 0.f; } \
            const f32x4 Z4 = (f32x4){0.f, 0.f, 0.f, 0.f}; \
            const bf16x4 pN = pack4(ND), pNt = pack4(NtD); \
            const f32x4 N2 = MFMA16(pNt, pN, Z4), N2t = MFMA16(pN, pNt, Z4); \
            const bf16x4 pN2 = pack4(N2), pN2t = pack4(N2t); \
            const f32x4 N4 = MFMA16(pN2t, pN2, Z4), N4t = MFMA16(pN2, pN2t, Z4); \
            const f32x4 N8 = MFMA16(pack4(N4t), pack4(N4), Z4); \
            const f32x4 T1t = MFMA16(pack4(Idm + N2), pack4(Idm - NtD), Z4); \
            const f32x4 T2 = MFMA16(pack4(Idm + N4t), pack4(Idm + N8), Z4); \
            const f32x4 TD = MFMA16(pack4(T1t), pack4(T2), Z4); \
            pAk = pack4(AkD); pArk = pack4(ArkD); pArb = pack4(ArbD); pT = pack4(TD); } while (0)
#define SC_MB(blk_, buf_) do { BLKINFO(blk_); \
            const LAS unsigned short* TSd = TS + ((buf_) * 2 + dir) * (4 * 16 * 68); const LAS unsigned short* CSd = CS + ((buf_) * 2 + dir) * (3 * 64 * 20); \
            bf16x4 kt[4], rt[4], sb[4]; \
            _Pragma("unroll") for (int ks = 0; ks < 4; ++ks) { const int o = fr * 68 + 16 * ks + 4 * fq; kt[ks] = *(const LAS bf16x4*)(TSd + o); rt[ks] = *(const LAS bf16x4*)(TSd + 16 * 68 + o); sb[ks] = pack4(Sreg[ks]); } \
            const bf16x4 vtf = *(const LAS bf16x4*)(CSd + 2 * 64 * 20 + cl * 20 + 4 * fq); \
            const f32x4 Z4 = (f32x4){0.f, 0.f, 0.f, 0.f}; f32x4 Pt = Z4, Yt = Z4; \
            _Pragma("unroll") for (int ks = 0; ks < 4; ++ks) { Pt = MFMA16(kt[ks], sb[ks], Pt); Yt = MFMA16(rt[ks], sb[ks], Yt); } \
            const f32x4 Qt = MFMA16(pAk, vtf, Pt); \
            const f32x4 Ut = MFMA16(pT, pack4(Qt), Z4); \
            const bf16x4 ub = pack4(Ut); \
            Yt = MFMA16(pArk, vtf, Yt); Yt = MFMA16(pArb, ub, Yt); \
            _Pragma("unroll") for (int ks = 0; ks < 4; ++ks) { \
                const f32x4 gm = *(const LAS f32x4*)(GAM + ((buf_) * 2 + dir) * 64 + 16 * ks + 4 * fq); \
                const bf16x4 kpf = *(const LAS bf16x4*)(CSd + (16 * ks + fr) * 20 + 4 * fq), bpf = *(const LAS bf16x4*)(CSd + 64 * 20 + (16 * ks + fr) * 20 + 4 * fq); \
                f32x4 c = Sreg[ks] * gm; c = MFMA16(kpf, vtf, c); c = MFMA16(bpf, ub, c); Sreg[ks] = c; } \
            bf16_t* yo = (dir ? Yb : Yf) + (size_t)mbase__ * 1024 + 64 * h + cl; \
            _Pragma("unroll") for (int j = 0; j < 4; ++j) { const int sidx = 4 * fq + j; const int tl = dir == 0 ? 16 * jj__ + sidx : Tseq__ - 1 - (16 * jj__ + sidx); yo[(size_t)tl * 1024] = f2bf(Yt[j]); } } while (0)
        __syncthreads();
        SCAN_LOADS(0);
        SC_E1(0); lds_barrier();
        SCAN_LOADS(1);
        SC_E2(); lds_barrier();
        SC_E3(0, 0); lds_barrier();
        for (int blk = 0; blk < 144; ++blk) {
            const int nb = blk + 1 < 144 ? blk + 1 : 143, nb2 = blk + 2 < 144 ? blk + 2 : 143, buf = blk & 1;
            SC_E1(nb);
            lds_barrier();
            SCAN_LOADS(nb2);
            SC_E2(); SC_MA(buf);
            lds_barrier();
            SC_E3(nb, buf ^ 1); SC_MB(blk, buf);
            lds_barrier();
        }
#undef BLKINFO
#undef SC_E1
#undef SC_E2
#undef SC_E3
#undef SC_MA
#undef SC_MB
#undef SCAN_LOADS
    }
}

__device__ __forceinline__ void row16_sum8(float (&x)[8]) {
#define R16_STEP(ctl) \
    "v_add_f32_dpp %0, %0, %0 " ctl " row_mask:0xf bank_mask:0xf\n v_add_f32_dpp %1, %1, %1 " ctl " row_mask:0xf bank_mask:0xf\n v_add_f32_dpp %2, %2, %2 " ctl " row_mask:0xf bank_mask:0xf\n v_add_f32_dpp %3, %3, %3 " ctl " row_mask:0xf bank_mask:0xf\n" \
    "v_add_f32_dpp %4, %4, %4 " ctl " row_mask:0xf bank_mask:0xf\n v_add_f32_dpp %5, %5, %5 " ctl " row_mask:0xf bank_mask:0xf\n v_add_f32_dpp %6, %6, %6 " ctl " row_mask:0xf bank_mask:0xf\n v_add_f32_dpp %7, %7, %7 " ctl " row_mask:0xf bank_mask:0xf\n"
    asm volatile("s_nop 1\n" R16_STEP("quad_perm:[1,0,3,2]") R16_STEP("quad_perm:[2,3,0,1]") R16_STEP("row_half_mirror") R16_STEP("row_mirror")
                 : "+v"(x[0]), "+v"(x[1]), "+v"(x[2]), "+v"(x[3]), "+v"(x[4]), "+v"(x[5]), "+v"(x[6]), "+v"(x[7]));
#undef R16_STEP
}

__device__ __forceinline__ void ph_scan5(KArgP a, int l, LAS unsigned char* lds, const Th& t) {
    LAS unsigned short* ZA = (LAS unsigned short*)(lds);
    LAS float* PART = (LAS float*)(lds + 9216);
    LAS unsigned short* TS = (LAS unsigned short*)(lds + 10496);
    LAS unsigned short* CS = (LAS unsigned short*)(lds + 45312);
    LAS float* GAM = (LAS float*)(lds + 76032);
    LAS bf16x8* BF = (LAS bf16x8*)(lds + 77056);
    const bf16_t* Zr = (const bf16_t*)(a->ws + WS_ZR);
    bf16_t* Yf = (bf16_t*)(a->ws + WS_Y); bf16_t* Yb = Yf + (size_t)MALL * 1024;
    float* BON = (float*)(a->ws + WS_BON);
    const float* scw = a->in[I_SHIFT] + (size_t)l * 3 * NRW;
    const int lane = t.lane, wv = t.wv, dir = wv >> 2, wq = wv & 3, fr = lane & 15, fq = lane >> 4;
    const int sg = dir ? 3 - fq : fq;
    const __amdgpu_buffer_rsrc_t rsZ = __builtin_amdgcn_make_buffer_rsrc((void*)(Zr - ZR_LD), 0, -1, 0x00020000);
    const __amdgpu_buffer_rsrc_t rsY = __builtin_amdgcn_make_buffer_rsrc((void*)(dir ? Yb : Yf), 0, -1, 0x00020000);
    const __amdgpu_buffer_rsrc_t rsB = __builtin_amdgcn_make_buffer_rsrc((void*)BON, 0, -1, 0x00020000);
    for (int unit = t.bid; unit < 256; unit += t.G) {
        const int b = unit >> 4, h = unit & 15;
        const int cl = 16 * wq + fr, ch = 64 * h + cl;
        {
            bf16x8 bw[2], ba[2];
            const float* w2p = a->in[I_W2] + ((size_t)(l * 2 + dir) * 64) * 1024 + ch; const float* a2p = a->in[I_A2] + ((size_t)(l * 2 + dir) * 64) * 1024 + ch;
#pragma unroll
            for (int ks = 0; ks < 2; ++ks) { unsigned pw[4], pa[4];
#pragma unroll
                for (int e = 0; e < 4; ++e) { const int k0 = 32 * ks + 8 * fq + 2 * e;
                    pw[e] = cvt_pk_bf16(w2p[(size_t)k0 * 1024], w2p[(size_t)(k0 + 1) * 1024]); pa[e] = cvt_pk_bf16(a2p[(size_t)k0 * 1024], a2p[(size_t)(k0 + 1) * 1024]); }
                bw[ks] = __builtin_bit_cast(bf16x8, (u32x4){pw[0], pw[1], pw[2], pw[3]}); ba[ks] = __builtin_bit_cast(bf16x8, (u32x4){pa[0], pa[1], pa[2], pa[3]}); }
            __syncthreads();
#pragma unroll
            for (int ks = 0; ks < 2; ++ks) { BF[(ks * 2 + 0) * 512 + t.tid] = bw[ks]; BF[(ks * 2 + 1) * 512 + t.tid] = ba[ks]; }
        }
        const float w0v = a->in[I_W0][(l * 2 + dir) * 1024 + ch], a0v = a->in[I_A0][(l * 2 + dir) * 1024 + ch];
        const float kkv = a->in[I_KK][l * 1024 + ch], kav = a->in[I_KA][l * 1024 + ch], rkv = a->in[I_RK][l * 1024 + ch];
        float swr[3], swk[3], swv[3], swz[3], swy[3];
        const int zcol = 3072 + 64 * dir + lane;
#pragma unroll
        for (int j = 0; j < 3; ++j) { const int jr = dir ? 2 - j : j;
            swr[j] = scw[jr * NRW + ch]; swk[j] = scw[jr * NRW + 1024 + ch]; swv[j] = scw[jr * NRW + 2048 + ch]; swz[j] = scw[jr * NRW + zcol]; swy[j] = scw[jr * NRW + zcol + 128]; }
        const int vo_in = (4 * fq * ZR_LD + ch) * 2, vo_z = zcol * 2, vo_y = (4 * sg * 1024 + 64 * h + cl) * 2;
        f32x4 Sreg[4];
#pragma unroll
        for (int k = 0; k < 4; ++k) Sreg[k] = (f32x4){0.f, 0.f, 0.f, 0.f};
        f32x4 Idm;
#pragma unroll
        for (int j = 0; j < 4; ++j) Idm[j] = (4 * fq + j == fr) ? 1.0f : 0.0f;
        unsigned short pr[6], pk[6], pv[6], pz[6], py[6];
#define SC_DESC(k_, rb_, fl_) do { const int k__ = (k_); const bool c__ = k__ < 16; const int jj__ = c__ ? k__ : k__ - 16; const int T__ = c__ ? TC : TL; \
            const int t0__ = dir == 0 ? 16 * jj__ : T__ - 16 * (jj__ + 1); rb_ = (c__ ? (MLAT + b * TC) : b * TL) + t0__; fl_ = (t0__ == 0 ? 1 : 0) | (t0__ + 16 == T__ ? 2 : 0); } while (0)
#define SC5_LOADS(rb_) do { int so__ = ((rb_) + (dir ? 5 : 0)) * (ZR_LD * 2); const int st__ = dir ? -(ZR_LD * 2) : (ZR_LD * 2); const int zo__ = 4 * wq * (ZR_LD * 2); \
            _Pragma("unroll") for (int e = 0; e < 6; ++e) { \
                pr[e] = __builtin_amdgcn_raw_buffer_load_b16(rsZ, vo_in, so__, 0); pk[e] = __builtin_amdgcn_raw_buffer_load_b16(rsZ, vo_in + 2048, so__, 0); pv[e] = __builtin_amdgcn_raw_buffer_load_b16(rsZ, vo_in, so__ + 4096, 0); \
                pz[e] = __builtin_amdgcn_raw_buffer_load_b16(rsZ, vo_z, so__ + zo__, 0); py[e] = __builtin_amdgcn_raw_buffer_load_b16(rsZ, vo_z + 256, so__ + zo__, 0); so__ += st__; } } while (0)
        float r4[4], k4[4], v4[4], dc4[4], av4[4], kr4[4], kd4[4];
        bf16x4 pAk, pArk, pArb, pT;
#define SC5_E1(fl_, NEXT_) do { const bool first__ = ((fl_) & 1) != 0, last__ = ((fl_) & 2) != 0; \
            const bool zl__ = first__ && fq == 0, zh__ = last__ && fq == 3; const bool m0__ = dir ? zh__ : zl__, m5__ = dir ? zl__ : zh__; \
            if (m0__) { pr[0] = 0; pk[0] = 0; pv[0] = 0; } \
            if (m5__) { pr[5] = 0; pk[5] = 0; pv[5] = 0; } \
            const bool wl__ = first__ && wq == 0, wh__ = last__ && wq == 3; const bool n0__ = dir ? wh__ : wl__, n5__ = dir ? wl__ : wh__; \
            if (n0__) { pz[0] = 0; py[0] = 0; } \
            if (n5__) { pz[5] = 0; py[5] = 0; } \
            _Pragma("unroll") for (int j = 0; j < 4; ++j) { r4[j] = swr[0] * bf2f(pr[j]) + swr[1] * bf2f(pr[j + 1]) + swr[2] * bf2f(pr[j + 2]); \
                k4[j] = swk[0] * bf2f(pk[j]) + swk[1] * bf2f(pk[j + 1]) + swk[2] * bf2f(pk[j + 2]); v4[j] = swv[0] * bf2f(pv[j]) + swv[1] * bf2f(pv[j + 1]) + swv[2] * bf2f(pv[j + 2]); } \
            float zs__[4], za__[4]; \
            _Pragma("unroll") for (int j = 0; j < 4; ++j) { zs__[j] = swz[0] * bf2f(pz[j]) + swz[1] * bf2f(pz[j + 1]) + swz[2] * bf2f(pz[j + 2]); za__[j] = swy[0] * bf2f(py[j]) + swy[1] * bf2f(py[j + 1]) + swy[2] * bf2f(py[j + 2]); } \
            NEXT_;   \
            _Pragma("unroll") for (int j = 0; j < 4; ++j) { const float zw = fast_tanh(zs__[j]); \
                ZA[((dir * 2 + 0) * 16 + 4 * wq + j) * 72 + lane] = f2bf(zw); ZA[((dir * 2 + 1) * 16 + 4 * wq + j) * 72 + lane] = f2bf(za__[j]); } } while (0)
#define SC5_E2() do { \
            f32x4 lw = (f32x4){0.f, 0.f, 0.f, 0.f}, la = (f32x4){0.f, 0.f, 0.f, 0.f}; \
            _Pragma("unroll") for (int ks = 0; ks < 2; ++ks) { \
                const bf16x8 aw = *(const LAS bf16x8*)(ZA + ((dir * 2 + 0) * 16 + fr) * 72 + 32 * ks + 8 * fq); const bf16x8 aa = *(const LAS bf16x8*)(ZA + ((dir * 2 + 1) * 16 + fr) * 72 + 32 * ks + 8 * fq); \
                lw = __builtin_amdgcn_mfma_f32_16x16x32_bf16(aw, BF[(ks * 2 + 0) * 512 + t.tid], lw, 0, 0, 0); la = __builtin_amdgcn_mfma_f32_16x16x32_bf16(aa, BF[(ks * 2 + 1) * 512 + t.tid], la, 0, 0, 0); } \
            float red__[8]; \
            _Pragma("unroll") for (int j = 0; j < 4; ++j) { dc4[j] = __builtin_amdgcn_exp2f(-0.87503877f * fast_sigmoid(w0v + lw[j])); av4[j] = fast_sigmoid(a0v + la[j]); \
                kr4[j] = k4[j] * kkv; kd4[j] = k4[j] * (1.0f + (av4[j] - 1.0f) * kav); red__[2 * j] = kr4[j] * kr4[j]; red__[2 * j + 1] = r4[j] * kd4[j] * rkv; } \
            row16_sum8(red__); \
            _Pragma("unroll") for (int j = 0; j < 4; ++j) \
                *(LAS f32x2*)(PART + (fr == 0 ? ((dir * 16 + 4 * fq + j) * 4 + wq) * 2 : 256 + 2 * (lane & 7))) = (f32x2){red__[2 * j], red__[2 * j + 1]}; } while (0)
#define SC5_E3(rb_, buf_) do { \
            LAS unsigned short* TSd = TS + ((buf_) * 2 + dir) * (4 * 16 * 68); LAS unsigned short* CSd = CS + ((buf_) * 2 + dir) * (3 * 64 * 20); \
            float kap[4], bet[4], bs__[4]; \
            _Pragma("unroll") for (int j = 0; j < 4; ++j) { const int ti = 4 * fq + j; const f32x4 p0 = *(const LAS f32x4*)(PART + (dir * 16 + ti) * 8), p1 = *(const LAS f32x4*)(PART + (dir * 16 + ti) * 8 + 4); \
                const float nrm = (p0[0] + p0[2]) + (p1[0] + p1[2]); kap[j] = kr4[j] * rsqrtf(fmaxf(nrm, 1e-12f)); bet[j] = kap[j] * av4[j]; \
                bs__[j] = (p0[1] + p0[3]) + (p1[1] + p1[3]); } \
            if (wv == 0) { if (fr == 0) { const int bso__ = __builtin_amdgcn_readfirstlane(((rb_) * 16 + h) * 4); \
                _Pragma("unroll") for (int j = 0; j < 4; ++j) __builtin_amdgcn_raw_buffer_store_b32(__float_as_uint(bs__[j]), rsB, fq * 256 + j * 64, bso__, 0); } } \
            const float g = (dc4[0] * dc4[1]) * (dc4[2] * dc4[3]); \
            const float ga = __shfl(g, fr + (dir ? 48 : 0)), gb = __shfl(g, fr + (dir ? 32 : 16)), gc = __shfl(g, fr + (dir ? 16 : 32)), gd = __shfl(g, fr + (dir ? 0 : 48));     \
            const float gall = (ga * gb) * (gc * gd); \
            const float pre = (sg >= 1 ? ga : 1.0f) * ((sg >= 2 ? gb : 1.0f) * (sg >= 3 ? gc : 1.0f)); \
            float run = pre; f32x4 kpv, bpv, vvv; \
            _Pragma("unroll") for (int e = 0; e < 4; ++e) { const float gm1 = run; run *= dc4[e]; const float inv = __builtin_amdgcn_rcpf(run); \
                const float ktv = kap[e] * gm1, rtv = r4[e] * (dir ? gm1 : run), khv = kd4[e] * inv, bhv = bet[e] * inv; \
                kpv[e] = khv * gall; bpv[e] = -(bhv * gall); vvv[e] = v4[e]; \
                const int so = (4 * sg + e) * 68 + cl; \
                TSd[so] = f2bf(ktv); TSd[16 * 68 + so] = f2bf(rtv); TSd[2 * 16 * 68 + so] = f2bf(khv); TSd[3 * 16 * 68 + so] = f2bf(bhv); } \
            *(LAS bf16x4*)(CSd + cl * 20 + 4 * sg) = pack4(kpv); *(LAS bf16x4*)(CSd + 64 * 20 + cl * 20 + 4 * sg) = pack4(bpv); *(LAS bf16x4*)(CSd + 2 * 64 * 20 + cl * 20 + 4 * sg) = pack4(vvv); \
            GAM[((buf_) * 2 + dir) * 64 + cl] = gall; } while (0)
#define SC5_MA(buf_) do { \
            const LAS unsigned short* TSd = TS + ((buf_) * 2 + dir) * (4 * 16 * 68); \
            bf16x4 kt[4], rt[4], kh[4], bh[4]; \
            _Pragma("unroll") for (int ks = 0; ks < 4; ++ks) { const int o = fr * 68 + 16 * ks + 4 * fq; \
                kt[ks] = *(const LAS bf16x4*)(TSd + o); rt[ks] = *(const LAS bf16x4*)(TSd + 16 * 68 + o); kh[ks] = *(const LAS bf16x4*)(TSd + 2 * 16 * 68 + o); bh[ks] = *(const LAS bf16x4*)(TSd + 3 * 16 * 68 + o); } \
            f32x4 AkD = (f32x4){0.f, 0.f, 0.f, 0.f}, ND = AkD, ArkD = AkD, ArbD = AkD, NtD = AkD; \
            _Pragma("unroll") for (int ks = 0; ks < 4; ++ks) { AkD = MFMA16(kh[ks], kt[ks], AkD); ND = MFMA16(bh[ks], kt[ks], ND); ArkD = MFMA16(kh[ks], rt[ks], ArkD); ArbD = MFMA16(bh[ks], rt[ks], ArbD); NtD = MFMA16(kt[ks], bh[ks], NtD); } \
            _Pragma("unroll") for (int j = 0; j < 4; ++j) { const int i = 4 * fq + j; const bool st = i < fr; const bool inc = dir ? (i < fr) : (i <= fr); \
                AkD[j] = st ? AkD[j] : 0.f; ND[j] = st ? ND[j] : 0.f; ArkD[j] = inc ? ArkD[j] : 0.f; ArbD[j] = inc ? -ArbD[j] : 0.f; NtD[j] = (fr < i) ? NtD[j] : 0.f; } \
            const f32x4 Z4 = (f32x4){0.f, 0.f, 0.f, 0.f}; \
            const bf16x4 pN = pack4(ND), pNt = pack4(NtD); \
            const f32x4 N2 = MFMA16(pNt, pN, Z4), N2t = MFMA16(pN, pNt, Z4); \
            const bf16x4 pN2 = pack4(N2), pN2t = pack4(N2t); \
            const f32x4 N4 = MFMA16(pN2t, pN2, Z4), N4t = MFMA16(pN2, pN2t, Z4); \
            const f32x4 N8 = MFMA16(pack4(N4t), pack4(N4), Z4); \
            const f32x4 T1t = MFMA16(pack4(Idm + N2), pack4(Idm - NtD), Z4); \
            const f32x4 T2 = MFMA16(pack4(Idm + N4t), pack4(Idm + N8), Z4); \
            const f32x4 TD = MFMA16(pack4(T1t), pack4(T2), Z4); \
            pAk = pack4(AkD); pArk = pack4(ArkD); pArb = pack4(ArbD); pT = pack4(TD); } while (0)
#define SC5_MB(rb_, buf_) do { \
            const LAS unsigned short* TSd = TS + ((buf_) * 2 + dir) * (4 * 16 * 68); const LAS unsigned short* CSd = CS + ((buf_) * 2 + dir) * (3 * 64 * 20); \
            bf16x4 kt[4], rt[4], sb[4]; \
            _Pragma("unroll") for (int ks = 0; ks < 4; ++ks) { const int o = fr * 68 + 16 * ks + 4 * fq; kt[ks] = *(const LAS bf16x4*)(TSd + o); rt[ks] = *(const LAS bf16x4*)(TSd + 16 * 68 + o); sb[ks] = pack4(Sreg[ks]); } \
            const bf16x4 vtf = *(const LAS bf16x4*)(CSd + 2 * 64 * 20 + cl * 20 + 4 * fq); \
            const f32x4 Z4 = (f32x4){0.f, 0.f, 0.f, 0.f}; f32x4 Pt = Z4, Yt = Z4; \
            _Pragma("unroll") for (int ks = 0; ks < 4; ++ks) { Pt = MFMA16(kt[ks], sb[ks], Pt); Yt = MFMA16(rt[ks], sb[ks], Yt); } \
            const f32x4 Qt = MFMA16(pAk, vtf, Pt); \
            const f32x4 Ut = MFMA16(pT, pack4(Qt), Z4); \
            const bf16x4 ub = pack4(Ut); \
            Yt = MFMA16(pArk, vtf, Yt); Yt = MFMA16(pArb, ub, Yt); \
            _Pragma("unroll") for (int ks = 0; ks < 4; ++ks) { \
                const f32x4 gm = *(const LAS f32x4*)(GAM + ((buf_) * 2 + dir) * 64 + 16 * ks + 4 * fq); \
                const bf16x4 kpf = *(const LAS bf16x4*)(CSd + (16 * ks + fr) * 20 + 4 * fq), bpf = *(const LAS bf16x4*)(CSd + 64 * 20 + (16 * ks + fr) * 20 + 4 * fq); \
                f32x4 c = Sreg[ks] * gm; c = MFMA16(kpf, vtf, c); c = MFMA16(bpf, ub, c); Sreg[ks] = c; } \
            int ys__ = ((rb_) + (dir ? 3 : 0)) * 2048; const int yst__ = dir ? -2048 : 2048;     \
            _Pragma("unroll") for (int j = 0; j < 4; ++j) { __builtin_amdgcn_raw_buffer_store_b16(f2bf(Yt[j]), rsY, vo_y, ys__, 0); ys__ += yst__; } } while (0)
        int rbA, rbB, rbC, flA, flB, flC;
        SC_DESC(0, rbA, flA); SC_DESC(1, rbB, flB);
        __syncthreads();
        SC5_LOADS(rbA);
        SC5_E1(flA, SC5_LOADS(rbB)); lds_barrier();
        SC5_E2(); lds_barrier();
        SC5_E3(rbA, 0); lds_barrier();
        const unsigned long long tl0_ = (MK_TMASK & 0x8000) ? __builtin_amdgcn_s_memrealtime() : 0ull;
        for (int blk = 0; blk < 144; ++blk) {
            const int nb2 = blk + 2 < 144 ? blk + 2 : 143, buf = blk & 1;
            SC_DESC(nb2, rbC, flC);
            SC5_E1(flB, SC5_LOADS(rbC));
            lds_barrier();
            SC5_E2(); SC5_MA(buf);
            lds_barrier();
            SC5_E3(rbB, buf ^ 1); SC5_MB(rbA, buf);
            lds_barrier();
            rbA = rbB; flA = flB; rbB = rbC; flB = flC;
        }
        if ((MK_TMASK & 0x8000) && t.bid == 0 && t.tid == 0) { unsigned long long* tp = (unsigned long long*)(a->ws + WS_CTL + 768 * 1024); *tp = *tp + (__builtin_amdgcn_s_memrealtime() - tl0_); }
#undef SC_DESC
#undef SC5_LOADS
#undef SC5_E1
#undef SC5_E2
#undef SC5_E3
#undef SC5_MA
#undef SC5_MB
    }
}

__device__ __forceinline__ void row16_sum4(float (&x)[4]) {
#define R16_STEP4(ctl) \
    "v_add_f32_dpp %0, %0, %0 " ctl " row_mask:0xf bank_mask:0xf\n v_add_f32_dpp %1, %1, %1 " ctl " row_mask:0xf bank_mask:0xf\n v_add_f32_dpp %2, %2, %2 " ctl " row_mask:0xf bank_mask:0xf\n v_add_f32_dpp %3, %3, %3 " ctl " row_mask:0xf bank_mask:0xf\n"
    asm volatile("s_nop 1\n" R16_STEP4("quad_perm:[1,0,3,2]") R16_STEP4("quad_perm:[2,3,0,1]") R16_STEP4("row_half_mirror") R16_STEP4("row_mirror")
                 : "+v"(x[0]), "+v"(x[1]), "+v"(x[2]), "+v"(x[3]));
#undef R16_STEP4
}
__device__ __forceinline__ void ph_scan6(KArgP a, int l, LAS unsigned char* lds, const Th& t) {
    LAS unsigned short* ZA = (LAS unsigned short*)(lds);
    LAS float* PART = (LAS float*)(lds + 9216);
    LAS unsigned short* TS = (LAS unsigned short*)(lds + 10496);
    LAS unsigned short* CS = (LAS unsigned short*)(lds + 45312);
    LAS float* GAM = (LAS float*)(lds + 76032);
    LAS bf16x8* BF = (LAS bf16x8*)(lds + 77056);
    LAS float* PN = (LAS float*)(lds + 109824);
    const bf16_t* Zr = (const bf16_t*)(a->ws + WS_ZR);
    bf16_t* Yf = (bf16_t*)(a->ws + WS_Y); bf16_t* Yb = Yf + (size_t)MALL * 1024;
    float* BON = (float*)(a->ws + WS_BON);
    const float* scw = a->in[I_SHIFT] + (size_t)l * 3 * NRW;
    const int lane = t.lane, wv = t.wv, dir = wv >> 2, wq = wv & 3, fr = lane & 15, fq = lane >> 4;
    const int sg = dir ? 3 - fq : fq;
    const __amdgpu_buffer_rsrc_t rsZ = __builtin_amdgcn_make_buffer_rsrc((void*)(Zr - ZR_LD), 0, -1, 0x00020000);
    const __amdgpu_buffer_rsrc_t rsY = __builtin_amdgcn_make_buffer_rsrc((void*)(dir ? Yb : Yf), 0, -1, 0x00020000);
    const __amdgpu_buffer_rsrc_t rsB = __builtin_amdgcn_make_buffer_rsrc((void*)BON, 0, -1, 0x00020000);
    for (int unit = t.bid; unit < 256; unit += t.G) {
        const int b = unit >> 4, h = unit & 15;
        const int cl = 16 * wq + fr, ch = 64 * h + cl;
        {
            bf16x8 bw[2], ba[2];
            const float* w2p = a->in[I_W2] + ((size_t)(l * 2 + dir) * 64) * 1024 + ch; const float* a2p = a->in[I_A2] + ((size_t)(l * 2 + dir) * 64) * 1024 + ch;
#pragma unroll
            for (int ks = 0; ks < 2; ++ks) { unsigned pw[4], pa[4];
#pragma unroll
                for (int e = 0; e < 4; ++e) { const int k0 = 32 * ks + 8 * fq + 2 * e;
                    pw[e] = cvt_pk_bf16(w2p[(size_t)k0 * 1024], w2p[(size_t)(k0 + 1) * 1024]); pa[e] = cvt_pk_bf16(a2p[(size_t)k0 * 1024], a2p[(size_t)(k0 + 1) * 1024]); }
                bw[ks] = __builtin_bit_cast(bf16x8, (u32x4){pw[0], pw[1], pw[2], pw[3]}); ba[ks] = __builtin_bit_cast(bf16x8, (u32x4){pa[0], pa[1], pa[2], pa[3]}); }
            __syncthreads();
#pragma unroll
            for (int ks = 0; ks < 2; ++ks) { BF[(ks * 2 + 0) * 512 + t.tid] = bw[ks]; BF[(ks * 2 + 1) * 512 + t.tid] = ba[ks]; }
        }
        const float w0v = a->in[I_W0][(l * 2 + dir) * 1024 + ch], a0v = a->in[I_A0][(l * 2 + dir) * 1024 + ch];
        const float kkv = a->in[I_KK][l * 1024 + ch], kav = a->in[I_KA][l * 1024 + ch], rkv = a->in[I_RK][l * 1024 + ch];
        float swr[3], swk[3], swv[3], swz[3], swy[3];
        const int zcol = 3072 + 64 * dir + lane;
#pragma unroll
        for (int j = 0; j < 3; ++j) { const int jr = dir ? 2 - j : j;
            swr[j] = scw[jr * NRW + ch]; swk[j] = scw[jr * NRW + 1024 + ch]; swv[j] = scw[jr * NRW + 2048 + ch]; swz[j] = scw[jr * NRW + zcol]; swy[j] = scw[jr * NRW + zcol + 128]; }
        const int vo_in = (4 * fq * ZR_LD + ch) * 2, vo_z = zcol * 2, vo_y = (4 * sg * 1024 + 64 * h + cl) * 2;
        f32x4 Sreg[4];
#pragma unroll
        for (int k = 0; k < 4; ++k) Sreg[k] = (f32x4){0.f, 0.f, 0.f, 0.f};
        f32x4 Idm;
#pragma unroll
        for (int j = 0; j < 4; ++j) Idm[j] = (4 * fq + j == fr) ? 1.0f : 0.0f;
        unsigned short pr[6], pk[6], pv[6], pz[6], py[6];
#define SC_DESC(k_, rb_, fl_) do { const int k__ = (k_); const bool c__ = k__ < 16; const int jj__ = c__ ? k__ : k__ - 16; const int T__ = c__ ? TC : TL; \
            const int t0__ = dir == 0 ? 16 * jj__ : T__ - 16 * (jj__ + 1); rb_ = (c__ ? (MLAT + b * TC) : b * TL) + t0__; fl_ = (t0__ == 0 ? 1 : 0) | (t0__ + 16 == T__ ? 2 : 0); } while (0)
#define SC5_LOADS(rb_) do { int so__ = ((rb_) + (dir ? 5 : 0)) * (ZR_LD * 2); const int st__ = dir ? -(ZR_LD * 2) : (ZR_LD * 2); const int zo__ = 4 * wq * (ZR_LD * 2); \
            _Pragma("unroll") for (int e = 0; e < 6; ++e) { \
                pr[e] = __builtin_amdgcn_raw_buffer_load_b16(rsZ, vo_in, so__, 0); pk[e] = __builtin_amdgcn_raw_buffer_load_b16(rsZ, vo_in + 2048, so__, 0); pv[e] = __builtin_amdgcn_raw_buffer_load_b16(rsZ, vo_in, so__ + 4096, 0); \
                pz[e] = __builtin_amdgcn_raw_buffer_load_b16(rsZ, vo_z, so__ + zo__, 0); py[e] = __builtin_amdgcn_raw_buffer_load_b16(rsZ, vo_z + 256, so__ + zo__, 0); so__ += st__; } } while (0)
        float r4[4], k4[4], v4[4], dc4[4], av4[4], kr4[4], kd4[4];
        bf16x4 pAk, pArk, pArb, pT;
#define SC5_E1(fl_, NEXT_) do { const bool first__ = ((fl_) & 1) != 0, last__ = ((fl_) & 2) != 0; \
            const bool zl__ = first__ && fq == 0, zh__ = last__ && fq == 3; const bool m0__ = dir ? zh__ : zl__, m5__ = dir ? zl__ : zh__; \
            if (m0__) { pr[0] = 0; pk[0] = 0; pv[0] = 0; } \
            if (m5__) { pr[5] = 0; pk[5] = 0; pv[5] = 0; } \
            const bool wl__ = first__ && wq == 0, wh__ = last__ && wq == 3; const bool n0__ = dir ? wh__ : wl__, n5__ = dir ? wl__ : wh__; \
            if (n0__) { pz[0] = 0; py[0] = 0; } \
            if (n5__) { pz[5] = 0; py[5] = 0; } \
            _Pragma("unroll") for (int j = 0; j < 4; ++j) { r4[j] = swr[0] * bf2f(pr[j]) + swr[1] * bf2f(pr[j + 1]) + swr[2] * bf2f(pr[j + 2]); \
                k4[j] = swk[0] * bf2f(pk[j]) + swk[1] * bf2f(pk[j + 1]) + swk[2] * bf2f(pk[j + 2]); v4[j] = swv[0] * bf2f(pv[j]) + swv[1] * bf2f(pv[j + 1]) + swv[2] * bf2f(pv[j + 2]); } \
            float zs__[4], za__[4]; \
            _Pragma("unroll") for (int j = 0; j < 4; ++j) { zs__[j] = swz[0] * bf2f(pz[j]) + swz[1] * bf2f(pz[j + 1]) + swz[2] * bf2f(pz[j + 2]); za__[j] = swy[0] * bf2f(py[j]) + swy[1] * bf2f(py[j + 1]) + swy[2] * bf2f(py[j + 2]); } \
            NEXT_;   \
            { float pn__[4]; _Pragma("unroll") for (int j = 0; j < 4; ++j) { kr4[j] = k4[j] * kkv; pn__[j] = kr4[j] * kr4[j]; } row16_sum4(pn__); \
              _Pragma("unroll") for (int j = 0; j < 4; ++j) PN[fr == 0 ? ((dir * 16 + 4 * fq + j) * 4 + wq) : 128 + (lane & 15)] = pn__[j]; } \
            _Pragma("unroll") for (int j = 0; j < 4; ++j) { const float zw = fast_tanh(zs__[j]); \
                ZA[((dir * 2 + 0) * 16 + 4 * wq + j) * 72 + lane] = f2bf(zw); ZA[((dir * 2 + 1) * 16 + 4 * wq + j) * 72 + lane] = f2bf(za__[j]); } } while (0)
#define SC5_E2() do { \
            f32x4 lw = (f32x4){0.f, 0.f, 0.f, 0.f}, la = (f32x4){0.f, 0.f, 0.f, 0.f}; \
            _Pragma("unroll") for (int ks = 0; ks < 2; ++ks) { \
                const bf16x8 aw = *(const LAS bf16x8*)(ZA + ((dir * 2 + 0) * 16 + fr) * 72 + 32 * ks + 8 * fq); const bf16x8 aa = *(const LAS bf16x8*)(ZA + ((dir * 2 + 1) * 16 + fr) * 72 + 32 * ks + 8 * fq); \
                lw = __builtin_amdgcn_mfma_f32_16x16x32_bf16(aw, BF[(ks * 2 + 0) * 512 + t.tid], lw, 0, 0, 0); la = __builtin_amdgcn_mfma_f32_16x16x32_bf16(aa, BF[(ks * 2 + 1) * 512 + t.tid], la, 0, 0, 0); } \
            float red__[4]; \
            _Pragma("unroll") for (int j = 0; j < 4; ++j) { dc4[j] = __builtin_amdgcn_exp2f(-0.87503877f * fast_sigmoid(w0v + lw[j])); av4[j] = fast_sigmoid(a0v + la[j]); \
                kd4[j] = k4[j] * (1.0f + (av4[j] - 1.0f) * kav); red__[j] = r4[j] * kd4[j] * rkv; } \
            if (dir == 0) { row16_sum4(red__);   \
                _Pragma("unroll") for (int j = 0; j < 4; ++j) PART[fr == 0 ? ((4 * fq + j) * 4 + wq) : 256 + (lane & 15)] = red__[j]; } } while (0)
#define SC5_E3(rb_, buf_) do { \
            LAS unsigned short* TSd = TS + ((buf_) * 2 + dir) * (4 * 16 * 68); LAS unsigned short* CSd = CS + ((buf_) * 2 + dir) * (3 * 64 * 20); \
            float kap[4], bet[4]; \
            _Pragma("unroll") for (int j = 0; j < 4; ++j) { const f32x4 p0 = *(const LAS f32x4*)(PN + (dir * 16 + 4 * fq + j) * 4); \
                const float nrm = (p0[0] + p0[1]) + (p0[2] + p0[3]); kap[j] = kr4[j] * rsqrtf(fmaxf(nrm, 1e-12f)); bet[j] = kap[j] * av4[j]; } \
            const float g = (dc4[0] * dc4[1]) * (dc4[2] * dc4[3]); \
            const float ga = __shfl(g, fr + (dir ? 48 : 0)), gb = __shfl(g, fr + (dir ? 32 : 16)), gc = __shfl(g, fr + (dir ? 16 : 32)), gd = __shfl(g, fr + (dir ? 0 : 48));     \
            const float gall = (ga * gb) * (gc * gd); \
            const float pre = (sg >= 1 ? ga : 1.0f) * ((sg >= 2 ? gb : 1.0f) * (sg >= 3 ? gc : 1.0f)); \
            float run = pre; f32x4 kpv, bpv, vvv; \
            _Pragma("unroll") for (int e = 0; e < 4; ++e) { const float gm1 = run; run *= dc4[e]; const float inv = __builtin_amdgcn_rcpf(run); \
                const float ktv = kap[e] * gm1, rtv = r4[e] * (dir ? gm1 : run), khv = kd4[e] * inv, bhv = bet[e] * inv; \
                kpv[e] = khv * gall; bpv[e] = -(bhv * gall); vvv[e] = v4[e]; \
                const int so = (4 * sg + e) * 68 + cl; \
                TSd[so] = f2bf(ktv); TSd[16 * 68 + so] = f2bf(rtv); TSd[2 * 16 * 68 + so] = f2bf(khv); TSd[3 * 16 * 68 + so] = f2bf(bhv); } \
            *(LAS bf16x4*)(CSd + cl * 20 + 4 * sg) = pack4(kpv); *(LAS bf16x4*)(CSd + 64 * 20 + cl * 20 + 4 * sg) = pack4(bpv); *(LAS bf16x4*)(CSd + 2 * 64 * 20 + cl * 20 + 4 * sg) = pack4(vvv); \
            GAM[((buf_) * 2 + dir) * 64 + cl] = gall; } while (0)
#define SC5_MA(buf_) do { \
            const LAS unsigned short* TSd = TS + ((buf_) * 2 + dir) * (4 * 16 * 68); \
            bf16x4 kt[4], rt[4], kh[4], bh[4]; \
            _Pragma("unroll") for (int ks = 0; ks < 4; ++ks) { const int o = fr * 68 + 16 * ks + 4 * fq; \
                kt[ks] = *(const LAS bf16x4*)(TSd + o); rt[ks] = *(const LAS bf16x4*)(TSd + 16 * 68 + o); kh[ks] = *(const LAS bf16x4*)(TSd + 2 * 16 * 68 + o); bh[ks] = *(const LAS bf16x4*)(TSd + 3 * 16 * 68 + o); } \
            f32x4 AkD = (f32x4){0.f, 0.f, 0.f, 0.f}, ND = AkD, ArkD = AkD, ArbD = AkD, NtD = AkD; \
            _Pragma("unroll") for (int ks = 0; ks < 4; ++ks) { AkD = MFMA16(kh[ks], kt[ks], AkD); ND = MFMA16(bh[ks], kt[ks], ND); ArkD = MFMA16(kh[ks], rt[ks], ArkD); ArbD = MFMA16(bh[ks], rt[ks], ArbD); NtD = MFMA16(kt[ks], bh[ks], NtD); } \
            _Pragma("unroll") for (int j = 0; j < 4; ++j) { const int i = 4 * fq + j; const bool st = i < fr; const bool inc = dir ? (i < fr) : (i <= fr); \
                AkD[j] = st ? AkD[j] : 0.f; ND[j] = st ? ND[j] : 0.f; ArkD[j] = inc ? ArkD[j] : 0.f; ArbD[j] = inc ? -ArbD[j] : 0.f; NtD[j] = (fr < i) ? NtD[j] : 0.f; } \
            const f32x4 Z4 = (f32x4){0.f, 0.f, 0.f, 0.f}; \
            const bf16x4 pN = pack4(ND), pNt = pack4(NtD); \
            const f32x4 N2 = MFMA16(pNt, pN, Z4), N2t = MFMA16(pN, pNt, Z4); \
            const bf16x4 pN2 = pack4(N2), pN2t = pack4(N2t); \
            const f32x4 N4 = MFMA16(pN2t, pN2, Z4), N4t = MFMA16(pN2, pN2t, Z4); \
            const f32x4 N8 = MFMA16(pack4(N4t), pack4(N4), Z4); \
            const f32x4 T1t = MFMA16(pack4(Idm + N2), pack4(Idm - NtD), Z4); \
            const f32x4 T2 = MFMA16(pack4(Idm + N4t), pack4(Idm + N8), Z4); \
            const f32x4 TD = MFMA16(pack4(T1t), pack4(T2), Z4); \
            pAk = pack4(AkD); pArk = pack4(ArkD); pArb = pack4(ArbD); pT = pack4(TD); } while (0)
#define SC5_MB(rb_, buf_) do { \
            const LAS unsigned short* TSd = TS + ((buf_) * 2 + dir) * (4 * 16 * 68); const LAS unsigned short* CSd = CS + ((buf_) * 2 + dir) * (3 * 64 * 20); \
            bf16x4 kt[4], rt[4], sb[4]; \
            _Pragma("unroll") for (int ks = 0; ks < 4; ++ks) { const int o = fr * 68 + 16 * ks + 4 * fq; kt[ks] = *(const LAS bf16x4*)(TSd + o); rt[ks] = *(const LAS bf16x4*)(TSd + 16 * 68 + o); sb[ks] = pack4(Sreg[ks]); } \
            const bf16x4 vtf = *(const LAS bf16x4*)(CSd + 2 * 64 * 20 + cl * 20 + 4 * fq); \
            const f32x4 Z4 = (f32x4){0.f, 0.f, 0.f, 0.f}; f32x4 Pt = Z4, Yt = Z4; \
            _Pragma("unroll") for (int ks = 0; ks < 4; ++ks) { Pt = MFMA16(kt[ks], sb[ks], Pt); Yt = MFMA16(rt[ks], sb[ks], Yt); } \
            const f32x4 Qt = MFMA16(pAk, vtf, Pt); \
            const f32x4 Ut = MFMA16(pT, pack4(Qt), Z4); \
            const bf16x4 ub = pack4(Ut); \
            Yt = MFMA16(pArk, vtf, Yt); Yt = MFMA16(pArb, ub, Yt); \
            _Pragma("unroll") for (int ks = 0; ks < 4; ++ks) { \
                const f32x4 gm = *(const LAS f32x4*)(GAM + ((buf_) * 2 + dir) * 64 + 16 * ks + 4 * fq); \
                const bf16x4 kpf = *(const LAS bf16x4*)(CSd + (16 * ks + fr) * 20 + 4 * fq), bpf = *(const LAS bf16x4*)(CSd + 64 * 20 + (16 * ks + fr) * 20 + 4 * fq); \
                f32x4 c = Sreg[ks] * gm; c = MFMA16(kpf, vtf, c); c = MFMA16(bpf, ub, c); Sreg[ks] = c; } \
            int ys__ = ((rb_) + (dir ? 3 : 0)) * 2048; const int yst__ = dir ? -2048 : 2048;     \
            _Pragma("unroll") for (int j = 0; j < 4; ++j) { __builtin_amdgcn_raw_buffer_store_b16(f2bf(Yt[j]), rsY, vo_y, ys__, 0); ys__ += yst__; } } while (0)
        int rbA, rbB, rbC, flA, flB, flC;
        SC_DESC(0, rbA, flA); SC_DESC(1, rbB, flB);
#define SC6_BON(rb_) do { if (wv == 0) { if (fr == 0) { const int bso__ = __builtin_amdgcn_readfirstlane(((rb_) * 16 + h) * 4); \
            _Pragma("unroll") for (int j = 0; j < 4; ++j) { const f32x4 p0 = *(const LAS f32x4*)(PART + (4 * fq + j) * 4); \
                __builtin_amdgcn_raw_buffer_store_b32(__float_as_uint((p0[0] + p0[1]) + (p0[2] + p0[3])), rsB, fq * 256 + j * 64, bso__, 0); } } } } while (0)
        __syncthreads();
        SC5_LOADS(rbA);
        SC5_E1(flA, SC5_LOADS(rbB)); lds_barrier();
        SC5_E2(); SC5_E3(rbA, 0); lds_barrier();
        const unsigned long long tl0_ = (MK_TMASK & 0x8000) ? __builtin_amdgcn_s_memrealtime() : 0ull;
        for (int blk = 0; blk < 144; ++blk) {
            const int nb2 = blk + 2 < 144 ? blk + 2 : 143, buf = blk & 1;
            SC_DESC(nb2, rbC, flC);
            SC6_BON(rbA);
            SC5_E1(flB, SC5_LOADS(rbC));
            lds_barrier();
            SC5_MA(buf); SC5_MB(rbA, buf);
            __builtin_amdgcn_sched_barrier(0);
            SC5_E2(); SC5_E3(rbB, buf ^ 1);
            lds_barrier();
            rbA = rbB; flA = flB; rbB = rbC; flB = flC;
        }
        if ((MK_TMASK & 0x8000) && t.bid == 0 && t.tid == 0) { unsigned long long* tp = (unsigned long long*)(a->ws + WS_CTL + 768 * 1024); *tp = *tp + (__builtin_amdgcn_s_memrealtime() - tl0_); }
#undef SC6_BON
#undef SC_DESC
#undef SC5_LOADS
#undef SC5_E1
#undef SC5_E2
#undef SC5_E3
#undef SC5_MA
#undef SC5_MB
    }
}

__device__ __forceinline__ void ph_scan7(KArgP a, int l, LAS unsigned char* lds, const Th& t) {
    LAS unsigned short* ZA = (LAS unsigned short*)(lds);
    LAS float* PART = (LAS float*)(lds + 9216);
    LAS unsigned short* TS = (LAS unsigned short*)(lds + 10496);
    LAS unsigned short* CS = (LAS unsigned short*)(lds + 45312);
    LAS float* GAM = (LAS float*)(lds + 76032);
    LAS bf16x8* BF = (LAS bf16x8*)(lds + 77056);
    LAS float* PN = (LAS float*)(lds + 109824);
    const bf16_t* Zr = (const bf16_t*)(a->ws + WS_ZR);
    bf16_t* Yf = (bf16_t*)(a->ws + WS_Y); bf16_t* Yb = Yf + (size_t)MALL * 1024;
    float* BON = (float*)(a->ws + WS_BON);
    const float* scw = a->in[I_SHIFT] + (size_t)l * 3 * NRW;
    const int lane = t.lane, wv = t.wv, dir = wv >> 2, wq = wv & 3, fr = lane & 15, fq = lane >> 4;
    const int sg = dir ? 3 - fq : fq;
    const __amdgpu_buffer_rsrc_t rsZ = __builtin_amdgcn_make_buffer_rsrc((void*)(Zr - ZR_LD), 0, -1, 0x00020000);
    const __amdgpu_buffer_rsrc_t rsY = __builtin_amdgcn_make_buffer_rsrc((void*)(dir ? Yb : Yf), 0, -1, 0x00020000);
    const __amdgpu_buffer_rsrc_t rsB = __builtin_amdgcn_make_buffer_rsrc((void*)BON, 0, -1, 0x00020000);
    for (int unit = t.bid; unit < 256; unit += t.G) {
        const int b = unit >> 4, h = unit & 15;
        const int cl = 16 * wq + fr, ch = 64 * h + cl;
        {
            bf16x8 bw[2], ba[2];
            const float* w2p = a->in[I_W2] + ((size_t)(l * 2 + dir) * 64) * 1024 + ch; const float* a2p = a->in[I_A2] + ((size_t)(l * 2 + dir) * 64) * 1024 + ch;
#pragma unroll
            for (int ks = 0; ks < 2; ++ks) { unsigned pw[4], pa[4];
#pragma unroll
                for (int e = 0; e < 4; ++e) { const int k0 = 32 * ks + 8 * fq + 2 * e;
                    pw[e] = cvt_pk_bf16(w2p[(size_t)k0 * 1024], w2p[(size_t)(k0 + 1) * 1024]); pa[e] = cvt_pk_bf16(a2p[(size_t)k0 * 1024], a2p[(size_t)(k0 + 1) * 1024]); }
                bw[ks] = __builtin_bit_cast(bf16x8, (u32x4){pw[0], pw[1], pw[2], pw[3]}); ba[ks] = __builtin_bit_cast(bf16x8, (u32x4){pa[0], pa[1], pa[2], pa[3]}); }
            __syncthreads();
#pragma unroll
            for (int ks = 0; ks < 2; ++ks) { BF[(ks * 2 + 0) * 512 + t.tid] = bw[ks]; BF[(ks * 2 + 1) * 512 + t.tid] = ba[ks]; }
        }
        const float w0v = a->in[I_W0][(l * 2 + dir) * 1024 + ch], a0v = a->in[I_A0][(l * 2 + dir) * 1024 + ch];
        const float kkv = a->in[I_KK][l * 1024 + ch], kav = a->in[I_KA][l * 1024 + ch], rkv = a->in[I_RK][l * 1024 + ch];
        float swr[3], swk[3], swv[3], swz[3], swy[3];
        const int zcol = 3072 + 64 * dir + lane;
#pragma unroll
        for (int j = 0; j < 3; ++j) { const int jr = dir ? 2 - j : j;
            swr[j] = scw[jr * NRW + ch]; swk[j] = scw[jr * NRW + 1024 + ch]; swv[j] = scw[jr * NRW + 2048 + ch]; swz[j] = scw[jr * NRW + zcol]; swy[j] = scw[jr * NRW + zcol + 128]; }
        const int vo_in = (4 * fq * ZR_LD + ch) * 2, vo_z = zcol * 2, vo_y = (4 * sg * 1024 + 64 * h + cl) * 2;
        f32x4 Sreg[4];
#pragma unroll
        for (int k = 0; k < 4; ++k) Sreg[k] = (f32x4){0.f, 0.f, 0.f, 0.f};
        f32x4 Idm;
#pragma unroll
        for (int j = 0; j < 4; ++j) Idm[j] = (4 * fq + j == fr) ? 1.0f : 0.0f;
        unsigned short pr[6], pk[6], pv[6], pz[6], py[6];
#define SC_DESC(k_, rb_, fl_) do { const int k__ = (k_); const bool c__ = k__ < 16; const int jj__ = c__ ? k__ : k__ - 16; const int T__ = c__ ? TC : TL; \
            const int t0__ = dir == 0 ? 16 * jj__ : T__ - 16 * (jj__ + 1); rb_ = (c__ ? (MLAT + b * TC) : b * TL) + t0__; fl_ = (t0__ == 0 ? 1 : 0) | (t0__ + 16 == T__ ? 2 : 0); } while (0)
#define SC5_LOADS(rb_) do { int so__ = ((rb_) + (dir ? 5 : 0)) * (ZR_LD * 2); const int st__ = dir ? -(ZR_LD * 2) : (ZR_LD * 2); const int zo__ = 4 * wq * (ZR_LD * 2); \
            _Pragma("unroll") for (int e = 0; e < 6; ++e) { \
                pr[e] = __builtin_amdgcn_raw_buffer_load_b16(rsZ, vo_in, so__, 0); pk[e] = __builtin_amdgcn_raw_buffer_load_b16(rsZ, vo_in + 2048, so__, 0); pv[e] = __builtin_amdgcn_raw_buffer_load_b16(rsZ, vo_in, so__ + 4096, 0); \
                pz[e] = __builtin_amdgcn_raw_buffer_load_b16(rsZ, vo_z, so__ + zo__, 0); py[e] = __builtin_amdgcn_raw_buffer_load_b16(rsZ, vo_z + 256, so__ + zo__, 0); so__ += st__; } } while (0)
        float r4[4], k4[4], v4[4], dc4[4], av4[4], kr4[4], kd4[4];
        bf16x4 pAk, pArk, pArb, pT;
#define SC7_E1(fl_, zp_, NEXT_) do { LAS unsigned short* ZAw__ = ZA + (zp_) * 55296; LAS float* PNw__ = PN + (zp_) * 2496; const bool first__ = ((fl_) & 1) != 0, last__ = ((fl_) & 2) != 0; \
            const bool zl__ = first__ && fq == 0, zh__ = last__ && fq == 3; const bool m0__ = dir ? zh__ : zl__, m5__ = dir ? zl__ : zh__; \
            if (m0__) { pr[0] = 0; pk[0] = 0; pv[0] = 0; } \
            if (m5__) { pr[5] = 0; pk[5] = 0; pv[5] = 0; } \
            const bool wl__ = first__ && wq == 0, wh__ = last__ && wq == 3; const bool n0__ = dir ? wh__ : wl__, n5__ = dir ? wl__ : wh__; \
            if (n0__) { pz[0] = 0; py[0] = 0; } \
            if (n5__) { pz[5] = 0; py[5] = 0; } \
            _Pragma("unroll") for (int j = 0; j < 4; ++j) { r4[j] = swr[0] * bf2f(pr[j]) + swr[1] * bf2f(pr[j + 1]) + swr[2] * bf2f(pr[j + 2]); \
                k4[j] = swk[0] * bf2f(pk[j]) + swk[1] * bf2f(pk[j + 1]) + swk[2] * bf2f(pk[j + 2]); v4[j] = swv[0] * bf2f(pv[j]) + swv[1] * bf2f(pv[j + 1]) + swv[2] * bf2f(pv[j + 2]); } \
            float zs__[4], za__[4]; \
            _Pragma("unroll") for (int j = 0; j < 4; ++j) { zs__[j] = swz[0] * bf2f(pz[j]) + swz[1] * bf2f(pz[j + 1]) + swz[2] * bf2f(pz[j + 2]); za__[j] = swy[0] * bf2f(py[j]) + swy[1] * bf2f(py[j + 1]) + swy[2] * bf2f(py[j + 2]); } \
            NEXT_;   \
            { float pn__[4]; _Pragma("unroll") for (int j = 0; j < 4; ++j) { kr4[j] = k4[j] * kkv; pn__[j] = kr4[j] * kr4[j]; } row16_sum4(pn__); \
              _Pragma("unroll") for (int j = 0; j < 4; ++j) PNw__[fr == 0 ? ((dir * 16 + 4 * fq + j) * 4 + wq) : 128 + (lane & 15)] = pn__[j]; } \
            _Pragma("unroll") for (int j = 0; j < 4; ++j) { const float zw = fast_tanh(zs__[j]); \
                ZAw__[((dir * 2 + 0) * 16 + 4 * wq + j) * 72 + lane] = f2bf(zw); ZAw__[((dir * 2 + 1) * 16 + 4 * wq + j) * 72 + lane] = f2bf(za__[j]); } } while (0)
#define SC7_E2(zp_) do { const LAS unsigned short* ZAr__ = ZA + (zp_) * 55296; LAS float* PBw__ = PART + (zp_) * 27808; \
            f32x4 lw = (f32x4){0.f, 0.f, 0.f, 0.f}, la = (f32x4){0.f, 0.f, 0.f, 0.f}; \
            _Pragma("unroll") for (int ks = 0; ks < 2; ++ks) { \
                const bf16x8 aw = *(const LAS bf16x8*)(ZAr__ + ((dir * 2 + 0) * 16 + fr) * 72 + 32 * ks + 8 * fq); const bf16x8 aa = *(const LAS bf16x8*)(ZAr__ + ((dir * 2 + 1) * 16 + fr) * 72 + 32 * ks + 8 * fq); \
                lw = __builtin_amdgcn_mfma_f32_16x16x32_bf16(aw, BF[(ks * 2 + 0) * 512 + t.tid], lw, 0, 0, 0); la = __builtin_amdgcn_mfma_f32_16x16x32_bf16(aa, BF[(ks * 2 + 1) * 512 + t.tid], la, 0, 0, 0); } \
            float red__[4]; \
            _Pragma("unroll") for (int j = 0; j < 4; ++j) { dc4[j] = __builtin_amdgcn_exp2f(-0.87503877f * fast_sigmoid(w0v + lw[j])); av4[j] = fast_sigmoid(a0v + la[j]); \
                kd4[j] = k4[j] * (1.0f + (av4[j] - 1.0f) * kav); red__[j] = r4[j] * kd4[j] * rkv; } \
            if (dir == 0) { row16_sum4(red__);   \
                _Pragma("unroll") for (int j = 0; j < 4; ++j) PBw__[fr == 0 ? ((4 * fq + j) * 4 + wq) : 256 + (lane & 15)] = red__[j]; } } while (0)
#define SC7_E3(zp_, buf_) do { const LAS float* PNr__ = PN + (zp_) * 2496; \
            LAS unsigned short* TSd = TS + ((buf_) * 2 + dir) * (4 * 16 * 68); LAS unsigned short* CSd = CS + ((buf_) * 2 + dir) * (3 * 64 * 20); \
            float kap[4], bet[4]; \
            _Pragma("unroll") for (int j = 0; j < 4; ++j) { const f32x4 p0 = *(const LAS f32x4*)(PNr__ + (dir * 16 + 4 * fq + j) * 4); \
                const float nrm = (p0[0] + p0[1]) + (p0[2] + p0[3]); kap[j] = kr4[j] * rsqrtf(fmaxf(nrm, 1e-12f)); bet[j] = kap[j] * av4[j]; } \
            const float g = (dc4[0] * dc4[1]) * (dc4[2] * dc4[3]); \
            const float ga = __shfl(g, fr + (dir ? 48 : 0)), gb = __shfl(g, fr + (dir ? 32 : 16)), gc = __shfl(g, fr + (dir ? 16 : 32)), gd = __shfl(g, fr + (dir ? 0 : 48));     \
            const float gall = (ga * gb) * (gc * gd); \
            const float pre = (sg >= 1 ? ga : 1.0f) * ((sg >= 2 ? gb : 1.0f) * (sg >= 3 ? gc : 1.0f)); \
            float run = pre; f32x4 kpv, bpv, vvv; \
            _Pragma("unroll") for (int e = 0; e < 4; ++e) { const float gm1 = run; run *= dc4[e]; const float inv = __builtin_amdgcn_rcpf(run); \
                const float ktv = kap[e] * gm1, rtv = r4[e] * (dir ? gm1 : run), khv = kd4[e] * inv, bhv = bet[e] * inv; \
                kpv[e] = khv * gall; bpv[e] = -(bhv * gall); vvv[e] = v4[e]; \
                const int so = (4 * sg + e) * 68 + cl; \
                TSd[so] = f2bf(ktv); TSd[16 * 68 + so] = f2bf(rtv); TSd[2 * 16 * 68 + so] = f2bf(khv); TSd[3 * 16 * 68 + so] = f2bf(bhv); } \
            *(LAS bf16x4*)(CSd + cl * 20 + 4 * sg) = pack4(kpv); *(LAS bf16x4*)(CSd + 64 * 20 + cl * 20 + 4 * sg) = pack4(bpv); *(LAS bf16x4*)(CSd + 2 * 64 * 20 + cl * 20 + 4 * sg) = pack4(vvv); \
            GAM[((buf_) * 2 + dir) * 64 + cl] = gall; } while (0)
#define SC5_MA(buf_) do { \
            const LAS unsigned short* TSd = TS + ((buf_) * 2 + dir) * (4 * 16 * 68); \
            bf16x4 kt[4], rt[4], kh[4], bh[4]; \
            _Pragma("unroll") for (int ks = 0; ks < 4; ++ks) { const int o = fr * 68 + 16 * ks + 4 * fq; \
                kt[ks] = *(const LAS bf16x4*)(TSd + o); rt[ks] = *(const LAS bf16x4*)(TSd + 16 * 68 + o); kh[ks] = *(const LAS bf16x4*)(TSd + 2 * 16 * 68 + o); bh[ks] = *(const LAS bf16x4*)(TSd + 3 * 16 * 68 + o); } \
            f32x4 AkD = (f32x4){0.f, 0.f, 0.f, 0.f}, ND = AkD, ArkD = AkD, ArbD = AkD, NtD = AkD; \
            _Pragma("unroll") for (int ks = 0; ks < 4; ++ks) { AkD = MFMA16(kh[ks], kt[ks], AkD); ND = MFMA16(bh[ks], kt[ks], ND); ArkD = MFMA16(kh[ks], rt[ks], ArkD); ArbD = MFMA16(bh[ks], rt[ks], ArbD); NtD = MFMA16(kt[ks], bh[ks], NtD); } \
            _Pragma("unroll") for (int j = 0; j < 4; ++j) { const int i = 4 * fq + j; const bool st = i < fr; const bool inc = dir ? (i < fr) : (i <= fr); \
                AkD[j] = st ? AkD[j] : 0.f; ND[j] = st ? ND[j] : 0.f; ArkD[j] = inc ? ArkD[j] : 0.f; ArbD[j] = inc ? -ArbD[j] : 0.f; NtD[j] = (fr < i) ? NtD[j] : 0.f; } \
            const f32x4 Z4 = (f32x4){0.f, 0.f, 0.f, 0.f}; \
            const bf16x4 pN = pack4(ND), pNt = pack4(NtD); \
            const f32x4 N2 = MFMA16(pNt, pN, Z4), N2t = MFMA16(pN, pNt, Z4); \
            const bf16x4 pN2 = pack4(N2), pN2t = pack4(N2t); \
            const f32x4 N4 = MFMA16(pN2t, pN2, Z4), N4t = MFMA16(pN2, pN2t, Z4); \
            const f32x4 N8 = MFMA16(pack4(N4t), pack4(N4), Z4); \
            const f32x4 T1t = MFMA16(pack4(Idm + N2), pack4(Idm - NtD), Z4); \
            const f32x4 T2 = MFMA16(pack4(Idm + N4t), pack4(Idm + N8), Z4); \
            const f32x4 TD = MFMA16(pack4(T1t), pack4(T2), Z4); \
            pAk = pack4(AkD); pArk = pack4(ArkD); pArb = pack4(ArbD); pT = pack4(TD); } while (0)
#define SC5_MB(rb_, buf_) do { \
            const LAS unsigned short* TSd = TS + ((buf_) * 2 + dir) * (4 * 16 * 68); const LAS unsigned short* CSd = CS + ((buf_) * 2 + dir) * (3 * 64 * 20); \
            bf16x4 kt[4], rt[4], sb[4]; \
            _Pragma("unroll") for (int ks = 0; ks < 4; ++ks) { const int o = fr * 68 + 16 * ks + 4 * fq; kt[ks] = *(const LAS bf16x4*)(TSd + o); rt[ks] = *(const LAS bf16x4*)(TSd + 16 * 68 + o); sb[ks] = pack4(Sreg[ks]); } \
            const bf16x4 vtf = *(const LAS bf16x4*)(CSd + 2 * 64 * 20 + cl * 20 + 4 * fq); \
            const f32x4 Z4 = (f32x4){0.f, 0.f, 0.f, 0.f}; f32x4 Pt = Z4, Yt = Z4; \
            _Pragma("unroll") for (int ks = 0; ks < 4; ++ks) { Pt = MFMA16(kt[ks], sb[ks], Pt); Yt = MFMA16(rt[ks], sb[ks], Yt); } \
            const f32x4 Qt = MFMA16(pAk, vtf, Pt); \
            const f32x4 Ut = MFMA16(pT, pack4(Qt), Z4); \
            const bf16x4 ub = pack4(Ut); \
            Yt = MFMA16(pArk, vtf, Yt); Yt = MFMA16(pArb, ub, Yt); \
            _Pragma("unroll") for (int ks = 0; ks < 4; ++ks) { \
                const f32x4 gm = *(const LAS f32x4*)(GAM + ((buf_) * 2 + dir) * 64 + 16 * ks + 4 * fq); \
                const bf16x4 kpf = *(const LAS bf16x4*)(CSd + (16 * ks + fr) * 20 + 4 * fq), bpf = *(const LAS bf16x4*)(CSd + 64 * 20 + (16 * ks + fr) * 20 + 4 * fq); \
                f32x4 c = Sreg[ks] * gm; c = MFMA16(kpf, vtf, c); c = MFMA16(bpf, ub, c); Sreg[ks] = c; } \
            int ys__ = ((rb_) + (dir ? 3 : 0)) * 2048; const int yst__ = dir ? -2048 : 2048;     \
            _Pragma("unroll") for (int j = 0; j < 4; ++j) { __builtin_amdgcn_raw_buffer_store_b16(f2bf(Yt[j]), rsY, vo_y, ys__, 0); ys__ += yst__; } } while (0)
        int rb0, rb1, rb2, rb3, fl0, fl1, fl2, fl3;
        SC_DESC(0, rb0, fl0); SC_DESC(1, rb1, fl1); SC_DESC(2, rb2, fl2); (void)fl0;
#define SC7_BON(rb_, zp_) do { if (wv == 0) { if (fr == 0) { const int bso__ = __builtin_amdgcn_readfirstlane(((rb_) * 16 + h) * 4); \
            _Pragma("unroll") for (int j = 0; j < 4; ++j) { const f32x4 p0 = *(const LAS f32x4*)(PART + (zp_) * 27808 + (4 * fq + j) * 4); \
                __builtin_amdgcn_raw_buffer_store_b32(__float_as_uint((p0[0] + p0[1]) + (p0[2] + p0[3])), rsB, fq * 256 + j * 64, bso__, 0); } } } } while (0)
        __syncthreads();
        SC5_LOADS(rb0);
        SC7_E1(fl0, 0, SC5_LOADS(rb1)); lds_barrier();
        SC7_E2(0); SC7_E3(0, 0);
        SC7_E1(fl1, 1, SC5_LOADS(rb2)); lds_barrier();
        const unsigned long long tl0_ = (MK_TMASK & 0x8000) ? __builtin_amdgcn_s_memrealtime() : 0ull;
        for (int blk = 0; blk < 144; ++blk) {
            const int nb3 = blk + 3 < 144 ? blk + 3 : 143, buf = blk & 1;
            SC_DESC(nb3, rb3, fl3);
            SC7_BON(rb0, buf);
            SC7_E2(buf ^ 1);
            __builtin_amdgcn_sched_barrier(0);
            SC7_E3(buf ^ 1, buf ^ 1);
            __builtin_amdgcn_sched_barrier(0);
            SC7_E1(fl2, buf, SC5_LOADS(rb3));
            SC5_MA(buf); SC5_MB(rb0, buf);
            lds_barrier();
            rb0 = rb1; rb1 = rb2; rb2 = rb3; fl1 = fl2; fl2 = fl3;
        }
        if ((MK_TMASK & 0x8000) && t.bid == 0 && t.tid == 0) { unsigned long long* tp = (unsigned long long*)(a->ws + WS_CTL + 768 * 1024); *tp = *tp + (__builtin_amdgcn_s_memrealtime() - tl0_); }
#undef SC7_BON
#undef SC_DESC
#undef SC5_LOADS
#undef SC7_E1
#undef SC7_E2
#undef SC7_E3
#undef SC5_MA
#undef SC5_MB
    }
}

__device__ __forceinline__ void ph_readout(KArgP a, int l, const Th& t) {
    const bf16_t* Zr = (const bf16_t*)(a->ws + WS_ZR);
    bf16_t* Yf = (bf16_t*)(a->ws + WS_Y); const bf16_t* Yb = Yf + (size_t)MALL * 1024;
    const float* BON = (const float*)(a->ws + WS_BON);
    bf16_t* AG = (bf16_t*)(a->ws + WS_AG);
    const float* scw = a->in[I_SHIFT] + (size_t)l * 3 * NRW;
    const int Mrows = l == 0 ? MALL : MLAT;
    const int lane = t.lane, ch0 = lane * 16, head = lane >> 2;
    const int nwv = t.G * 8, R = (Mrows + nwv - 1) / nwv, r0 = (t.bid * 8 + t.wv) * R, r1 = (r0 + R < Mrows) ? r0 + R : Mrows;
    if (r0 < r1) {
        float swv[3][16], lgv[16], lbv[16], swg[3][4];
#pragma unroll
        for (int j = 0; j < 3; ++j) {
#pragma unroll
            for (int i = 0; i < 4; ++i) { const f32x4 x = *(const f32x4*)(scw + j * NRW + 2048 + ch0 + 4 * i); swv[j][4 * i] = x[0]; swv[j][4 * i + 1] = x[1]; swv[j][4 * i + 2] = x[2]; swv[j][4 * i + 3] = x[3]; }
            const f32x4 y = *(const f32x4*)(scw + j * NRW + 3328 + 4 * (lane & 31)); swg[j][0] = y[0]; swg[j][1] = y[1]; swg[j][2] = y[2]; swg[j][3] = y[3]; }
#pragma unroll
        for (int i = 0; i < 4; ++i) { const f32x4 x = *(const f32x4*)(a->in[I_LNXG] + l * 1024 + ch0 + 4 * i), y = *(const f32x4*)(a->in[I_LNXB] + l * 1024 + ch0 + 4 * i);
#pragma unroll
            for (int j = 0; j < 4; ++j) { lgv[4 * i + j] = x[j]; lbv[4 * i + j] = y[j]; } }
        const int zlast = MALL - 1;
#define RO_ZROW(m_, zv_, zg_) do { const int mm_ = (m_) < 0 ? 0 : ((m_) > zlast ? zlast : (m_)); const bf16_t* zz_ = Zr + (size_t)mm_ * ZR_LD; \
            zv_[0] = *(const u32x4*)(zz_ + 2048 + ch0); zv_[1] = *(const u32x4*)(zz_ + 2048 + ch0 + 8); zg_ = *(const u32x2*)(zz_ + 3328 + 4 * (lane & 31)); } while (0)
#define RO_YROW(m_, f_, g_, bn_) do { const size_t mo_ = (size_t)(m_) * 1024 + ch0; f_[0] = *(const u32x4*)(Yf + mo_); f_[1] = *(const u32x4*)(Yf + mo_ + 8); g_[0] = *(const u32x4*)(Yb + mo_); g_[1] = *(const u32x4*)(Yb + mo_ + 8); \
            bn_ = BON[(size_t)(m_) * 16 + head]; } while (0)
        u32x4 z0[2], z1[2], z2[2], zn[2], fC[2], gC[2], fN[2], gN[2]; u32x2 d0, d1, d2, dn; float bonC, bonN;
        RO_ZROW(r0 - 1, z0, d0); RO_ZROW(r0, z1, d1); RO_ZROW(r0 + 1, z2, d2);
        RO_YROW(r0, fC, gC, bonC);
        for (int m = r0; m < r1; ++m) {
            const int mn = m + 1 < r1 ? m + 1 : m;
            RO_ZROW(m + 2, zn, dn);
            RO_YROW(mn, fN, gN, bonN);
            const bool isctx = m >= MLAT; const int tl = isctx ? ((m - MLAT) & (TC - 1)) : (m & (TL - 1)); const int Tseq = isctx ? TC : TL;
            const bool has0 = tl > 0, has2 = tl + 1 < Tseq;
            float y[16], v[16];
#define RO_UNPK(dst_, w_) do { dst_[0] = bflo(w_[0].x); dst_[1] = bfhi(w_[0].x); dst_[2] = bflo(w_[0].y); dst_[3] = bfhi(w_[0].y); dst_[4] = bflo(w_[0].z); dst_[5] = bfhi(w_[0].z); dst_[6] = bflo(w_[0].w); dst_[7] = bfhi(w_[0].w); \
                dst_[8] = bflo(w_[1].x); dst_[9] = bfhi(w_[1].x); dst_[10] = bflo(w_[1].y); dst_[11] = bfhi(w_[1].y); dst_[12] = bflo(w_[1].z); dst_[13] = bfhi(w_[1].z); dst_[14] = bflo(w_[1].w); dst_[15] = bfhi(w_[1].w); } while (0)
            { float yf[16], yb[16]; RO_UNPK(yf, fC); RO_UNPK(yb, gC);
#pragma unroll
              for (int i = 0; i < 16; ++i) y[i] = yf[i] + yb[i]; }
            float sm = 0.f, sq = 0.f;
#pragma unroll
            for (int i = 0; i < 16; ++i) { sm += y[i]; sq += y[i] * y[i]; }
            sm += dpp_f<0xB1>(sm); sq += dpp_f<0xB1>(sq); sm += dpp_f<0x4E>(sm); sq += dpp_f<0x4E>(sq);
            const float mean = sm * (1.0f / 64.0f), var = fmaxf(sq * (1.0f / 64.0f) - mean * mean, 0.f);
            const float rstd = rsqrtf(var + GN_EPS);
            { float zt[16]; RO_UNPK(zt, z1);
#pragma unroll
              for (int i = 0; i < 16; ++i) v[i] = swv[1][i] * zt[i];
              if (has0) { RO_UNPK(zt, z0);
#pragma unroll
                  for (int i = 0; i < 16; ++i) v[i] += swv[0][i] * zt[i]; }
              if (has2) { RO_UNPK(zt, z2);
#pragma unroll
                  for (int i = 0; i < 16; ++i) v[i] += swv[2][i] * zt[i]; } }
            float o[16];
#pragma unroll
            for (int i = 0; i < 16; ++i) o[i] = (y[i] - mean) * rstd * lgv[i] + lbv[i] + bonC * v[i];
            *(u32x4*)(Yf + (size_t)m * 1024 + ch0) = (u32x4){cvt_pk_bf16(o[0], o[1]), cvt_pk_bf16(o[2], o[3]), cvt_pk_bf16(o[4], o[5]), cvt_pk_bf16(o[6], o[7])};
            *(u32x4*)(Yf + (size_t)m * 1024 + ch0 + 8) = (u32x4){cvt_pk_bf16(o[8], o[9]), cvt_pk_bf16(o[10], o[11]), cvt_pk_bf16(o[12], o[13]), cvt_pk_bf16(o[14], o[15])};
            if (lane < 32) {
                float gs[4] = {swg[1][0] * bflo(d1.x), swg[1][1] * bfhi(d1.x), swg[1][2] * bflo(d1.y), swg[1][3] * bfhi(d1.y)};
                if (has0) { gs[0] += swg[0][0] * bflo(d0.x); gs[1] += swg[0][1] * bfhi(d0.x); gs[2] += swg[0][2] * bflo(d0.y); gs[3] += swg[0][3] * bfhi(d0.y); }
                if (has2) { gs[0] += swg[2][0] * bflo(d2.x); gs[1] += swg[2][1] * bfhi(d2.x); gs[2] += swg[2][2] * bflo(d2.y); gs[3] += swg[2][3] * bfhi(d2.y); }
                *(u32x2*)(AG + (size_t)m * 256 + 4 * lane) = (u32x2){cvt_pk_bf16(fast_sigmoid(gs[0]), fast_sigmoid(gs[1])), cvt_pk_bf16(fast_sigmoid(gs[2]), fast_sigmoid(gs[3]))};
            } else {
                *(u32x2*)(AG + (size_t)m * 256 + 128 + 4 * (lane - 32)) = (u32x2){0u, 0u};
            }
            z0[0] = z1[0]; z0[1] = z1[1]; z1[0] = z2[0]; z1[1] = z2[1]; z2[0] = zn[0]; z2[1] = zn[1]; d0 = d1; d1 = d2; d2 = dn;
            fC[0] = fN[0]; fC[1] = fN[1]; gC[0] = gN[0]; gC[1] = gN[1]; bonC = bonN;
        }
#undef RO_ZROW
#undef RO_YROW
#undef RO_UNPK
    }
}

__device__ __forceinline__ float fold32(float a, float b) { const auto r = __builtin_amdgcn_permlane32_swap(__float_as_uint(a), __float_as_uint(b), false, false); return __uint_as_float(r[0]) + __uint_as_float(r[1]); }
__device__ __forceinline__ float fold16(float a, float b) { const auto r = __builtin_amdgcn_permlane16_swap(__float_as_uint(a), __float_as_uint(b), false, false); return __uint_as_float(r[0]) + __uint_as_float(r[1]); }
__device__ __forceinline__ void ln_rows1(float (&v)[16]) {
    float s = 0.f, q = 0.f;
#pragma unroll
    for (int i = 0; i < 16; ++i) { s += v[i]; q += v[i] * v[i]; }
    s += dpp_f<0xB1>(s); q += dpp_f<0xB1>(q); s += dpp_f<0x4E>(s); q += dpp_f<0x4E>(q); s += dpp_f<0x141>(s); q += dpp_f<0x141>(q); s += dpp_f<0x140>(s); q += dpp_f<0x140>(q);
    const int si = __float_as_int(s), qi = __float_as_int(q);
    const float s0 = __int_as_float(__builtin_amdgcn_readlane(si, 0)), s1 = __int_as_float(__builtin_amdgcn_readlane(si, 16)), s2 = __int_as_float(__builtin_amdgcn_readlane(si, 32)), s3 = __int_as_float(__builtin_amdgcn_readlane(si, 48));
    const float q0 = __int_as_float(__builtin_amdgcn_readlane(qi, 0)), q1 = __int_as_float(__builtin_amdgcn_readlane(qi, 16)), q2 = __int_as_float(__builtin_amdgcn_readlane(qi, 32)), q3 = __int_as_float(__builtin_amdgcn_readlane(qi, 48));
    const float mean = ((s0 + s1) + (s2 + s3)) * (1.0f / 1024.0f), var = fmaxf(((q0 + q1) + (q2 + q3)) * (1.0f / 1024.0f) - mean * mean, 0.f);
    const float rstd = rsqrtf(var + LN_EPS), off = -mean * rstd;
#pragma unroll
    for (int i = 0; i < 16; ++i) v[i] = v[i] * rstd + off;
}
__device__ __forceinline__ void ph_ln1(KArgP a, int l, LAS unsigned char* lds, const Th& t) {
    LAS float* RWL = (LAS float*)lds;
    const float* rw = a->in[I_ROUTER] + (size_t)l * 1024 * 16;
    for (int i = t.tid; i < 16384; i += 512) { const int c = i >> 4, e = i & 15; RWL[e * 1024 + c] = rw[i]; }
    __syncthreads();
    const float* MOD = (const float*)(a->ws + WS_MOD) + (size_t)l * 17 * 6144;
    bf16_t* XM = (bf16_t*)(a->ws + WS_XM);
    unsigned char* H2 = a->ws + WS_S;
    float* AFF = (float*)(a->ws + WS_AFF);
    const int Mrows = l == 0 ? MALL : MLAT;
    const int lane = t.lane;
    const int nwv = t.G * 8, R = (Mrows + nwv - 1) / nwv, r0 = (t.bid * 8 + t.wv) * R, r1 = (r0 + R < Mrows) ? r0 + R : Mrows;
    if (r0 < r1) {
        float gg[16], bb[16], sc1[16], sh1[16];
#pragma unroll
        for (int i = 0; i < 4; ++i) { const f32x4 g = *(const f32x4*)(a->in[I_LN1G] + l * 1024 + i * 256 + lane * 4), b = *(const f32x4*)(a->in[I_LN1B] + l * 1024 + i * 256 + lane * 4);
#pragma unroll
            for (int j = 0; j < 4; ++j) { gg[4 * i + j] = g[j]; bb[4 * i + j] = b[j]; sc1[4 * i + j] = 0.f; sh1[4 * i + j] = 0.f; } }
        int s_cur = -1;
        float vn[16];
        load_row16_bf16(XM + (size_t)r0 * 1024, lane, vn);
        for (int m = r0; m < r1; ++m) {
            float v[16];
#pragma unroll
            for (int i = 0; i < 16; ++i) v[i] = vn[i];
            { const int mn = m + 1 < r1 ? m + 1 : m; load_row16_bf16(XM + (size_t)mn * 1024, lane, vn); }
            const int s = m < MLAT ? (m >> 11) : 16;
            if (s != s_cur) { s_cur = s; const float* sh = MOD + (size_t)s * 6144 + 3072; const float* sc = MOD + (size_t)s * 6144 + 4096;
#pragma unroll
                for (int i = 0; i < 4; ++i) { const f32x4 x = *(const f32x4*)(sc + i * 256 + lane * 4), y = *(const f32x4*)(sh + i * 256 + lane * 4);
#pragma unroll
                    for (int j = 0; j < 4; ++j) { sc1[4 * i + j] = 1.0f + x[j]; sh1[4 * i + j] = y[j]; } } }
            bf16_t* xp = XM + (size_t)m * 1024;
            ln_rows1(v);
#pragma unroll
            for (int i = 0; i < 16; ++i) v[i] = v[i] * gg[i] + bb[i];
            store_row16_bf16(xp, lane, v);
            ln_rows1(v);
#pragma unroll
            for (int i = 0; i < 16; ++i) v[i] = v[i] * sc1[i] + sh1[i];
#pragma unroll
            for (int i = 0; i < 4; ++i) *(unsigned*)(H2 + (size_t)m * 1024 + i * 256 + lane * 4) = pk4_fp8(v[4 * i], v[4 * i + 1], v[4 * i + 2], v[4 * i + 3]);
            float p[16];
#pragma unroll
            for (int e = 0; e < 16; ++e) { float acc0 = 0.f, acc1 = 0.f;
#pragma unroll
                for (int i = 0; i < 4; ++i) { const f32x4 w = *(const LAS f32x4*)(RWL + e * 1024 + i * 256 + lane * 4); acc0 += v[4 * i] * w[0] + v[4 * i + 1] * w[1]; acc1 += v[4 * i + 2] * w[2] + v[4 * i + 3] * w[3]; }
                p[e] = acc0 + acc1; if ((e & 3) == 3) asm volatile("" ::: "memory"); }
            float q8[8], u[4];
#pragma unroll
            for (int e = 0; e < 8; ++e) q8[e] = fold32(p[e], p[e + 8]);
#pragma unroll
            for (int e = 0; e < 4; ++e) u[e] = fold16(q8[e], q8[e + 4]);
#pragma unroll
            for (int e = 0; e < 4; ++e) { u[e] += dpp_f<0xB1>(u[e]); }
#pragma unroll
            for (int e = 0; e < 4; ++e) { u[e] += dpp_f<0x4E>(u[e]); }
#pragma unroll
            for (int e = 0; e < 4; ++e) { u[e] += dpp_f<0x141>(u[e]); }
#pragma unroll
            for (int e = 0; e < 4; ++e) { u[e] += dpp_f<0x140>(u[e]); }
            const float ml = fmaxf(fmaxf(u[0], u[1]), fmaxf(u[2], u[3]));
            const int mli = __float_as_int(ml);
            const float mx = fmaxf(fmaxf(__int_as_float(__builtin_amdgcn_readlane(mli, 0)), __int_as_float(__builtin_amdgcn_readlane(mli, 16))), fmaxf(__int_as_float(__builtin_amdgcn_readlane(mli, 32)), __int_as_float(__builtin_amdgcn_readlane(mli, 48))));
            float ex[4];
#pragma unroll
            for (int e = 0; e < 4; ++e) ex[e] = __expf(u[e] - mx);
            const float dl = (ex[0] + ex[1]) + (ex[2] + ex[3]);
            const int dli = __float_as_int(dl);
            const float den = (__int_as_float(__builtin_amdgcn_readlane(dli, 0)) + __int_as_float(__builtin_amdgcn_readlane(dli, 16))) + (__int_as_float(__builtin_amdgcn_readlane(dli, 32)) + __int_as_float(__builtin_amdgcn_readlane(dli, 48)));
            const int k4 = lane & 15;
            const float mine = k4 == 0 ? ex[0] : k4 == 1 ? ex[1] : k4 == 2 ? ex[2] : ex[3];
            if (k4 < 4) AFF[(size_t)m * 16 + 4 * (lane >> 4) + k4] = mine / den;
        }
    }
}

__device__ __forceinline__ void ph_select(KArgP a, int l, const Th& t) {
    const float* AFF = (const float*)(a->ws + WS_AFF);
    int* INV = (int*)(a->ws + WS_INV); int* SELT = (int*)(a->ws + WS_SELT); float* SELG = (float*)(a->ws + WS_SELG);
    const int RPE = l == 0 ? 4608 : 4096;
    const int nunits = l == 0 ? 512 : 256;
    const int lane = t.lane;
    const unsigned long long lt_mask = (lane == 0) ? 0ull : (~0ull >> (64 - lane));
    for (int unit = t.bid * 8 + t.wv; unit < nunits; unit += t.G * 8) {
        const int set = unit >> 4, e = unit & 15;
        const bool isctx = set >= 16; const int Tseq = isctx ? TC : TL, C = isctx ? 32 : 256, nj = Tseq >> 6;
        const int mbase = isctx ? MLAT + (set - 16) * TC : set * TL;
        const int rbase = e * RPE + (isctx ? 4096 + (set - 16) * 32 : set * 256);
        unsigned val[32];
#pragma unroll
        for (int j = 0; j < 32; ++j) val[j] = (j < nj) ? __float_as_uint(AFF[(size_t)(mbase + j * 64 + lane) * 16 + e]) : 0u;
        unsigned thr = 0u;
        for (int bit = 30; bit >= 0; --bit) {
            const unsigned cand = thr | (1u << bit);
            int cnt = 0;
#pragma unroll
            for (int j = 0; j < 32; ++j) cnt += (val[j] >= cand) ? 1 : 0;
            cnt = (int)wave_sum((float)cnt);
            if (cnt >= C) thr = cand;
        }
        int ngt = 0;
#pragma unroll
        for (int j = 0; j < 32; ++j) ngt += (val[j] > thr) ? 1 : 0;
#pragma unroll
        for (int o = 32; o > 0; o >>= 1) ngt += __shfl_xor(ngt, o);
        const int need = C - ngt;
        int base = 0, eqseen = 0;
#pragma unroll
        for (int j = 0; j < 32; ++j) {
            if (j < nj) {
                const bool gt = val[j] > thr, eq = val[j] == thr;
                const unsigned long long meq = __ballot(eq);
                const bool take = gt || (eq && (eqseen + __popcll(meq & lt_mask)) < need);
                const unsigned long long mt = __ballot(take);
                const int m = mbase + j * 64 + lane;
                int slot = -1;
                if (take) { slot = rbase + base + __popcll(mt & lt_mask); SELT[slot] = m; SELG[slot] = __uint_as_float(val[j]); }
                INV[(size_t)m * 16 + e] = slot;
                base += __popcll(mt); eqseen += __popcll(meq);
            }
        }
    }
}

__device__ __forceinline__ void ph_gather(KArgP a, int l, const Th& t) {
    const int* SELT = (const int*)(a->ws + WS_SELT);
    const unsigned char* H2 = a->ws + WS_S; unsigned char* XE = a->ws + WS_XA;
    const int nrows = 16 * (l == 0 ? 4608 : 4096);
    for (int r = t.bid * 8 + t.wv; r < nrows; r += t.G * 8) {
        const int tok = SELT[r];
        const u32x4* src = (const u32x4*)(H2 + (size_t)tok * 1024); u32x4* dst = (u32x4*)(XE + (size_t)r * 1024);
        dst[t.lane] = src[t.lane];
    }
}

__device__ __forceinline__ void ph_combine(KArgP a, int l, const Th& t) {
    const int* INV = (const int*)(a->ws + WS_INV); const bf16_t* YE = (const bf16_t*)(a->ws + WS_Y);
    const float* MOD = (const float*)(a->ws + WS_MOD);
    const bf16_t* XM = (const bf16_t*)(a->ws + WS_XM); bf16_t* XA = (bf16_t*)(a->ws + WS_XA); bf16_t* H = (bf16_t*)(a->ws + WS_S);
    const int Mrows = l == 0 ? MALL : MLAT;
    const int lane = t.lane;
    const int nwv = t.G * 8, R = (Mrows + nwv - 1) / nwv, r0 = (t.bid * 8 + t.wv) * R, r1 = (r0 + R < Mrows) ? r0 + R : Mrows;
    if (r0 < r1) {
        float g2v[16], b2v[16], gtv[16], sc1[16], sh1[16];
#pragma unroll
        for (int i = 0; i < 4; ++i) { const f32x4 g = *(const f32x4*)(a->in[I_LN2G] + l * 1024 + i * 256 + lane * 4), b = *(const f32x4*)(a->in[I_LN2B] + l * 1024 + i * 256 + lane * 4);
#pragma unroll
            for (int j = 0; j < 4; ++j) { g2v[4 * i + j] = g[j]; b2v[4 * i + j] = b[j]; gtv[4 * i + j] = 0.f; sc1[4 * i + j] = 0.f; sh1[4 * i + j] = 0.f; } }
        int s_cur = -1;
#define CB_INV(m_) (lane < 16 ? INV[(size_t)(m_) * 16 + lane] : -1)
#define CB_ISSUE(m_, inv_, x_, w_, wg_, rest_) do { unsigned long long vm_ = __ballot((inv_) >= 0); \
            _Pragma("unroll") for (int q = 0; q < 4; ++q) { const bool ok = vm_ != 0ull; const int e = ok ? (int)__builtin_ctzll(vm_) : 0; int R_ = __builtin_amdgcn_readlane((inv_), e); if (!ok || R_ < 0) R_ = 0; wg_[q] = ok ? 1.0f : 0.0f; if (ok) vm_ &= vm_ - 1ull; \
                const bf16_t* yr = YE + (size_t)R_ * 1024; _Pragma("unroll") for (int i = 0; i < 4; ++i) w_[q][i] = *(const u32x2*)(yr + i * 256 + lane * 4); } \
            rest_ = vm_; load_row16_bf16(XM + (size_t)(m_) * 1024, lane, x_); } while (0)
        int inv_c = CB_INV(r0), inv_n = CB_INV(r0 + 1 < r1 ? r0 + 1 : r0);
        float xC[16], wgC[4]; u32x2 wC[4][4]; unsigned long long restC;
        CB_ISSUE(r0, inv_c, xC, wC, wgC, restC);
        for (int m = r0; m < r1; ++m) {
            const int mn = m + 1 < r1 ? m + 1 : m, mnn = m + 2 < r1 ? m + 2 : mn;
            const int inv_nn = CB_INV(mnn);
            float xN[16], wgN[4]; u32x2 wN[4][4]; unsigned long long restN;
            CB_ISSUE(mn, inv_n, xN, wN, wgN, restN);
            const int s = m < MLAT ? (m >> 11) : 16;
            if (s != s_cur) { s_cur = s; const float* gt2 = MOD + ((size_t)l * 17 + s) * 6144 + 5120; const float* shp = MOD + ((size_t)17 + s) * 6144; const float* scp = shp + 1024;
#pragma unroll
                for (int i = 0; i < 4; ++i) { const f32x4 x = *(const f32x4*)(gt2 + i * 256 + lane * 4);
#pragma unroll
                    for (int j = 0; j < 4; ++j) gtv[4 * i + j] = x[j];
                    if (l == 0) { const f32x4 y = *(const f32x4*)(scp + i * 256 + lane * 4), z = *(const f32x4*)(shp + i * 256 + lane * 4);
#pragma unroll
                        for (int j = 0; j < 4; ++j) { sc1[4 * i + j] = 1.0f + y[j]; sh1[4 * i + j] = z[j]; } } } }
            float acc[16];
#pragma unroll
            for (int i = 0; i < 16; ++i) acc[i] = 0.f;
#pragma unroll
            for (int q = 0; q < 4; ++q)
#pragma unroll
                for (int i = 0; i < 4; ++i) { acc[4 * i] += wgC[q] * bflo(wC[q][i].x); acc[4 * i + 1] += wgC[q] * bfhi(wC[q][i].x); acc[4 * i + 2] += wgC[q] * bflo(wC[q][i].y); acc[4 * i + 3] += wgC[q] * bfhi(wC[q][i].y); }
            while (restC) {
                const int e = (int)__builtin_ctzll(restC); restC &= restC - 1ull; int R_ = __builtin_amdgcn_readlane(inv_c, e); if (R_ < 0) R_ = 0;
                const bf16_t* yr = YE + (size_t)R_ * 1024;
#pragma unroll
                for (int i = 0; i < 4; ++i) { const u32x2 w = *(const u32x2*)(yr + i * 256 + lane * 4); acc[4 * i] += bflo(w.x); acc[4 * i + 1] += bfhi(w.x); acc[4 * i + 2] += bflo(w.y); acc[4 * i + 3] += bfhi(w.y); }
            }
            float v[16];
#pragma unroll
            for (int i = 0; i < 16; ++i) v[i] = ALPHA * xC[i] + gtv[i] * acc[i];
            ln_rows1(v);
#pragma unroll
            for (int i = 0; i < 16; ++i) v[i] = v[i] * g2v[i] + b2v[i];
            if (l == 0) {
                store_row16_bf16(XA + (size_t)m * 1024, lane, v);
                ln_rows1(v);
#pragma unroll
                for (int i = 0; i < 16; ++i) v[i] = v[i] * sc1[i] + sh1[i];
                store_row16_bf16(H + (size_t)m * 1024, lane, v);
#pragma unroll
                for (int i = 0; i < 4; ++i) *(unsigned*)(a->ws + WS_HQ + (size_t)m * 1024 + i * 256 + lane * 4) = pk4_fp8(v[4 * i], v[4 * i + 1], v[4 * i + 2], v[4 * i + 3]);
            } else {
                store_row16(a->out + (size_t)m * 1024, lane, v);
            }
#pragma unroll
            for (int i = 0; i < 16; ++i) xC[i] = xN[i];
#pragma unroll
            for (int q = 0; q < 4; ++q) { wgC[q] = wgN[q];
#pragma unroll
                for (int i = 0; i < 4; ++i) wC[q][i] = wN[q][i]; }
            restC = restN; inv_c = inv_n; inv_n = inv_nn;
        }
#undef CB_INV
#undef CB_ISSUE
    }
}

constexpr int CVT_SPLIT = 17408;
__device__ __forceinline__ void ph_cvt_experts(KArgP a, int l, LAS unsigned char* lds, const Th& t, int tile_lo, int tile_hi, int wave_lo) {
    LAS unsigned char* T = lds + t.wv * (64 * 80);
    const int gw = t.bid * 8 + t.wv - wave_lo, nw = t.G * 8 - wave_lo;
    unsigned char* WE13 = a->ws + WS_WE13; unsigned char* WE2 = a->ws + WS_WE2;
    if (gw < 0 || nw <= 0) return;
    for (int tt = tile_lo + gw; tt < tile_hi; tt += nw) {
        const int e = tt / 1536, r = tt % 1536, which = r >> 9, ti = r & 511;
        if (which < 2) { const float* src = a->in[which == 0 ? I_EW1 : I_EW3] + ((size_t)(l * 16 + e)) * 1024 * 2048; const int kt = ti >> 5, n0 = (ti & 31) * 64;
            cvt_tile_fp8(src, 2048, kt * 64, n0, WE13 + (size_t)e * 4096 * 1024, 1024, cvt_row(2 + which, n0), kt * 64, T, t.lane, pg8::W13_SCALE); }
        else { const float* src = a->in[I_EW2] + ((size_t)(l * 16 + e)) * 2048 * 1024; const int kt = ti >> 4, n0 = (ti & 15) * 64;
            cvt_tile_fp8(src, 1024, kt * 64, n0, WE2 + (size_t)e * 1024 * 2048, 2048, n0, kt * 64, T, t.lane, pg8::W2_SCALE); }
    }
}

__global__ void __launch_bounds__(512, 2) mk_fwd(const Args args) {
    extern __shared__ __attribute__((aligned(16))) unsigned char smem[];
    LAS unsigned char* lds = (LAS unsigned char*)smem;
    volatile LAS unsigned* MISC = (volatile LAS unsigned*)(lds + LDS_MISC);
    if (threadIdx.x < 64) MISC[threadIdx.x] = 0u;
#ifdef MK_FENCE
    __builtin_amdgcn_fence(__ATOMIC_ACQUIRE, "agent"); asm volatile("s_waitcnt vmcnt(0)" ::: "memory");
#endif
    __syncthreads();
    const int lo = args.ph_lo, hi = args.ph_hi;
    XcdBarrier bar; bar.bar = nullptr; bar.x = 0; bar.st = MISC + 8;
    if (hi - lo > 1) bar = xcd_barrier_post((unsigned*)(kargs()->ws + WS_CTL) + CW_BAR, MISC + 8);
    unsigned long long tp_acc = 0, tp_t = 0;
#define TPSEL(k) ((MK_TMASK >> ((k) % NPH)) & 1)
#define IN(k) (lo <= (k) && (k) < hi && ((TPSEL(k) ? (void)(tp_t = __builtin_amdgcn_s_memrealtime()) : (void)0), true))
#define SEAM(k) do { if (lo <= (k) + 1 && (k) + 1 < hi) xcd_barrier(bar); if (TPSEL(k)) tp_acc += __builtin_amdgcn_s_memrealtime() - tp_t; } while (0)
    using namespace pg8;
    for (int l = 0; l < 2; ++l) {
        const int P = l * NPH;
        if (l == 0 && IN(P + 0)) { ph_prologue(kargs(), lds, mk_th()); SEAM(P + 0); }
        if (l == 0 && IN(P + 1)) { ph_lnmod0(kargs(), mk_th()); SEAM(P + 1); }
        if (IN(P + 2)) {
            KArgP a = kargs(); const Th t = mk_th(); const int Mrows = l == 0 ? MALL : MLAT;
            bf16_t* const H = (bf16_t*)(a->ws + WS_S); bf16_t* const Zr = (bf16_t*)(a->ws + WS_ZR); bf16_t* const Zs = (bf16_t*)(a->ws + WS_ZS); bf16_t* const Zg = (bf16_t*)(a->ws + WS_ZG);
            const bf16_t* Wt = (const bf16_t*)(a->ws + WS_WIN) + (size_t)l * NZ * 1024;
            { Gemm g{H, Wt, MALL, ZR_LD, 1024}; Order S; S.init(MALL / 256, ZR_LD / 256, t.G, t.bid); EpiZ E{Zr, Zs, Zg, 0, 0, 1.0f}; gemm_phase<EpiZ, Order>(lds, g, S, E); }
            { Gemm g{(const bf16_t*)(a->ws + WS_HQ), (const bf16_t*)(a->ws + WS_WIN8 + (size_t)l * 4096 * 1024), Mrows, NZ - ZR_LD, opaque_i(1024)}; Order S; S.init(Mrows / 256, (NZ - ZR_LD) / 256, t.G, t.bid);
              EpiZ E{Zr, Zs, Zg, 0, 14, 1.0f / WIN8_SCALE}; gemm_phase<EpiZ, Order, true>(lds, g, S, E); }
            SEAM(P + 2);
        }
        if (IN(P + 3)) { ph_sgu(kargs(), l, lds, mk_th()); ph_scan7(kargs(), l, lds, mk_th()); SEAM(P + 3); }
        if (IN(P + 4)) { ph_readout(kargs(), l, mk_th()); SEAM(P + 4); }
        if (IN(P + 5)) {
            KArgP a = kargs(); const Th t = mk_th(); const int Mrows = l == 0 ? MALL : MLAT;
            Gemm g{(const bf16_t*)(a->ws + WS_AG), (const bf16_t*)(a->ws + WS_G2) + (size_t)l * 1024 * 256, Mrows, 1024, opaque_i(256)}; Order S; S.init(Mrows / 256, 4, t.G, t.bid);
            EpiMulInPlace E{(bf16_t*)(a->ws + WS_Y)}; gemm_phase<EpiMulInPlace, Order>(lds, g, S, E);
            SEAM(P + 5);
        }
        if (IN(P + 6)) {
            KArgP a = kargs(); const Th t = mk_th(); const int Mrows = l == 0 ? MALL : MLAT;
            bf16_t* const Yf = (bf16_t*)(a->ws + WS_Y); bf16_t* const Mg = Yf + (size_t)MALL * 1024; const bf16_t* Zg = (const bf16_t*)(a->ws + WS_ZG);
            { Gemm g{Yf, (const bf16_t*)(a->ws + WS_WA) + (size_t)l * 1024 * 1024, Mrows, 1024, 1024}; Order S; S.init(Mrows / 256, 4, t.G, t.bid);
              EpiGate<false> E{Mg, Zg, 0}; gemm_phase<EpiGate<false>, Order>(lds, g, S, E); }
            { Gemm g{(const bf16_t*)(a->ws + WS_S), (const bf16_t*)(a->ws + WS_WB) + (size_t)l * 1024 * 1024, Mrows, 1024, 1024}; Order S; S.init(Mrows / 256, 4, t.G, t.bid);
              EpiGate<true> E{Mg, Zg, 1024}; gemm_phase<EpiGate<true>, Order>(lds, g, S, E); }
            SEAM(P + 6);
        }
        if (IN(P + 7)) {
            ph_cvt_experts(kargs(), l, lds, mk_th(), 0, CVT_SPLIT, 0);
            __syncthreads();
            KArgP a = kargs(); const Th t = mk_th(); const int Mrows = l == 0 ? MALL : MLAT;
            Gemm g{(const bf16_t*)(a->ws + WS_Y) + (size_t)MALL * 1024, (const bf16_t*)(a->ws + WS_WO) + (size_t)l * 1024 * 1024, Mrows, 1024, 1024}; Order S; S.init(Mrows / 256, 4, t.G, t.bid);
            EpiRes E{a->in[I_X], a->in[I_CTX], l == 0 ? (const bf16_t*)nullptr : (const bf16_t*)(a->ws + WS_XA), (bf16_t*)(a->ws + WS_XM),
                     (const float*)(a->ws + WS_MOD) + (size_t)l * 17 * 6144 + 2048};
            gemm_phase<EpiRes, Order>(lds, g, S, E);
            SEAM(P + 7);
        }
        if (IN(P + 8)) { ph_ln1(kargs(), l, lds, mk_th()); SEAM(P + 8); }
        if (IN(P + 9)) { ph_select(kargs(), l, mk_th());
            { const Th t9 = mk_th(); const int nsel = l == 0 ? 512 : 256; ph_cvt_experts(kargs(), l, lds, t9, CVT_SPLIT, 16 * 1536, (t9.G * 8 > 2 * nsel) ? nsel : 0); }
            SEAM(P + 9); }
        if (IN(P + 11)) {
            KArgP a = kargs(); const Th t = mk_th(); const int nMe = l == 0 ? 18 : 16;
            Gemm g{(const bf16_t*)(a->ws + WS_S), (const bf16_t*)(a->ws + WS_WE13), 16 * nMe * 256, 4096, opaque_i(1024), (const int*)(a->ws + WS_SELT)}; Order S; S.init(16 * nMe, 16, t.G, t.bid, nMe);
            EpiSwiGLU E{a->ws + WS_HID}; gemm_phase<EpiSwiGLU, Order, true, true>(lds, g, S, E);
            SEAM(P + 11);
        }
        if (IN(P + 12)) {
            KArgP a = kargs(); const Th t = mk_th(); const int nMe = l == 0 ? 18 : 16;
            Gemm g{(const bf16_t*)(a->ws + WS_HID), (const bf16_t*)(a->ws + WS_WE2), 16 * nMe * 256, 1024, opaque_i(2048)}; Order S; S.init(16 * nMe, 4, t.G, t.bid, nMe);
            EpiScaleRow E{(bf16_t*)(a->ws + WS_Y), (const float*)(a->ws + WS_SELG)}; gemm_phase<EpiScaleRow, Order, true, false>(lds, g, S, E);
            SEAM(P + 12);
        }
        if (IN(P + 13)) { ph_combine(kargs(), l, mk_th()); SEAM(P + 13); }
    }
#undef IN
#undef SEAM
    if (MK_TMASK != 0 && blockIdx.x == 0 && threadIdx.x == 0) { asm volatile("s_waitcnt vmcnt(0)" ::: "memory");
        if (MK_TMASK & 0x8000) tp_acc += *(volatile unsigned long long*)(args.ws + WS_CTL + 768 * 1024);
        const unsigned long long t0 = __builtin_amdgcn_s_memrealtime();
        while (__builtin_amdgcn_s_memrealtime() - t0 < MK_TAMP * tp_acc) __builtin_amdgcn_s_sleep(8); }
#ifdef MK_FENCE
    asm volatile("s_waitcnt vmcnt(0)" ::: "memory"); __builtin_amdgcn_fence(__ATOMIC_RELEASE, "agent"); asm volatile("s_waitcnt vmcnt(0)" ::: "memory");
#endif
}


#ifdef MK_DELAY
__global__ void mk_delay() { const unsigned long long t0 = __builtin_amdgcn_s_memrealtime(); while (__builtin_amdgcn_s_memrealtime() - t0 < 2000000ull) __builtin_amdgcn_s_sleep(32); }
#endif
#ifdef MK_DUMP
__global__ void __launch_bounds__(512) mk_dump(const Args args) {
    const unsigned char* ws = args.ws; float* out = args.out;
    const bf16_t* Zr = (const bf16_t*)(ws + WS_ZR); const bf16_t* Zs = (const bf16_t*)(ws + WS_ZS); const bf16_t* Zg = (const bf16_t*)(ws + WS_ZG);
    const bf16_t* Yf = (const bf16_t*)(ws + WS_Y); const bf16_t* Yb = Yf + (size_t)MALL * 1024; const bf16_t* YS = (const bf16_t*)(ws + WS_S);
    const float* BON = (const float*)(ws + WS_BON); const bf16_t* AG = (const bf16_t*)(ws + WS_AG); const float* MOD = (const float*)(ws + WS_MOD);
    for (size_t i = (size_t)blockIdx.x * 512 + threadIdx.x; i < (size_t)MLAT * 1024; i += (size_t)gridDim.x * 512) {
        const size_t m = i >> 10; const int c = (int)(i & 1023); float v = 0.f;
#if MK_DUMP == 1
        if (MK_DSEL & 1) v += bf2f(Zr[m * ZR_LD + c]);
        if (MK_DSEL & 2) v += bf2f(Zr[m * ZR_LD + 1024 + c]);
        if (MK_DSEL & 4) v += bf2f(Zr[m * ZR_LD + 2048 + c]);
        if (MK_DSEL & 8) v += bf2f(Zr[m * ZR_LD + 2560 + c]);
        if (MK_DSEL & 16) v += bf2f(Zs[m * 2048 + c]);
        if (MK_DSEL & 32) v += bf2f(Zs[m * 2048 + 1024 + c]);
        if (MK_DSEL & 64) v += bf2f(Zg[m * 2048 + c]);
        if (MK_DSEL & 128) v += bf2f(Zg[m * 2048 + 1024 + c]);
#elif MK_DUMP == 2
        v = bf2f(Yf[m * 1024 + c]) + bf2f(Yb[m * 1024 + c]);
#elif MK_DUMP == 3
        v = bf2f(YS[m * 1024 + c]);
#elif MK_DUMP == 4
        v = BON[m * 16 + (c & 15)] + bf2f(AG[m * 256 + (c & 255)]);
#elif MK_DUMP == 5
        v = bf2f(Yb[m * 1024 + c]);
#elif MK_DUMP == 6
        v = bf2f(Yf[m * 1024 + c]);
#elif MK_DUMP == 7
        v = bf2f(YS[m * 1024 + c]) + MOD[(i % (2 * 17 * 6144))];
#elif MK_DUMP == 8
        v = bf2f(((const bf16_t*)(ws + WS_WIN))[i % ((size_t)2 * NZ * 1024)]);
#endif
        out[i] = v;
    }
}
#endif
extern "C" void kernel_launch(void* const* d_in, const int* in_sizes, int n_in, void* d_out, int out_size, void* d_ws, size_t ws_size, hipStream_t stream) {
    static int grid = 0;
    if (grid == 0) {
        if (n_in != 33 || out_size != MLAT * D || ws_size < WS_END) { fprintf(stderr, "kernel_launch: unexpected problem (n_in %d out %d ws %zu)\n", n_in, out_size, ws_size); grid = -1; return; }
        int dev = 0, cus = 0, per_cu = 0;
        if (hipGetDevice(&dev) != hipSuccess || hipDeviceGetAttribute(&cus, hipDeviceAttributeMultiprocessorCount, dev) != hipSuccess) { grid = -1; return; }
        if (hipFuncSetAttribute((const void*)mk_fwd, hipFuncAttributeMaxDynamicSharedMemorySize, LDS_BYTES) != hipSuccess) { fprintf(stderr, "kernel_launch: hipFuncSetAttribute failed\n"); grid = -1; return; }
        if (hipOccupancyMaxActiveBlocksPerMultiprocessor(&per_cu, (const void*)mk_fwd, 512, LDS_BYTES) != hipSuccess || per_cu < 1) { fprintf(stderr, "kernel_launch: occupancy query says %d\n", per_cu); }
        (void)hipGetLastError();
        grid = cus > 0 ? cus : 256;
    }
    if (grid < 0) return;
    (void)hipMemsetAsync((char*)d_ws + WS_CTL, 0, CTL_ZERO_BYTES, stream);
    Args a{};
    for (int i = 0; i < 33; ++i) a.in[i] = (const float*)d_in[i];
    a.out = (float*)d_out; a.ws = (unsigned char*)d_ws;
#if MK_SINGLE
    a.ph_lo = 0; a.ph_hi = 2 * NPH;
    hipLaunchKernelGGL(mk_fwd, dim3(grid), dim3(512), LDS_BYTES, stream, a);
#else
#ifdef MK_DELAY
    hipLaunchKernelGGL(mk_delay, dim3(1), dim3(64), 0, stream);
#endif
    for (int k = 0; k < 2 * NPH; ++k) {
        if (k == NPH + 0 || k == NPH + 1 || k == 10 || k == NPH + 10) continue;
        if (k > MK_STOP) break;
        a.ph_lo = k; a.ph_hi = k + 1;
        hipLaunchKernelGGL(mk_fwd, dim3(grid), dim3(512), LDS_BYTES, stream, a);
#ifdef MK_TWICE
        if (k == 2) hipLaunchKernelGGL(mk_fwd, dim3(grid), dim3(512), LDS_BYTES, stream, a);
#endif
    }
#ifdef MK_DUMP
    hipLaunchKernelGGL(mk_dump, dim3(1024), dim3(512), 0, stream, a);
#endif
#endif
}
```
